# Optimizing an MI355X kernel written in HIP

```python
import math
import jax
import jax.numpy as jnp
from jax import lax
import numpy as np

D_MODEL = 1024
BATCH = 2
SEQ = 8192
DEPTH = 2
DEC_BATCH = 1
DEC_SEQ = 16384
PAST_LEN = 128

HEAD_DIM = 64
POOL_WIDTH = D_MODEL // 4
POOL_WINDOWS = (2, 4, 8, 16)
N_POOL_GROUPS = len(POOL_WINDOWS)
POOL_GROUP = POOL_WIDTH // N_POOL_GROUPS
RWKV_WIDTH = 3 * D_MODEL // 8
RWKV_HEADS = RWKV_WIDTH // HEAD_DIM
DECAY_LORA = 64
ICLR_LORA = 64
GATE_LORA = 128
ATT_WIDTH = 3 * D_MODEL // 8
ATT_HEADS = ATT_WIDTH // HEAD_DIM
DILATED_CONFIGS = ((128, 1), (512, 4), (2048, 16))
REL_BUCKETS = 32
REL_MAX_DISTANCE = 1024
MIX_WIDTH = POOL_WIDTH + RWKV_WIDTH + ATT_WIDTH
SPLIT_SIZES = (POOL_WIDTH, 3 * RWKV_WIDTH, DECAY_LORA, ICLR_LORA, GATE_LORA, 3 * ATT_WIDTH)
IN_WIDTH = sum(SPLIT_SIZES)
D_FF = 4 * D_MODEL
NORM_EPS = 1e-6
GN_EPS = 64e-5
NEG_INF = -1e30

kernel_name = 'hybrid_pool_rwkv7_dilated_encoder'


def rms_norm(x, gain):
    xf = x.astype(jnp.float32)
    y = xf * lax.rsqrt(jnp.mean(xf * xf, axis=-1, keepdims=True) + NORM_EPS)
    return (y * gain.astype(jnp.float32)).astype(x.dtype)


def split_columns(proj):
    parts, start = [], 0
    for size in SPLIT_SIZES:
        parts.append(proj[..., start:start + size])
        start += size
    return parts


def pool_mixer(u, pool_w, pool_scale):
    B, T, _ = u.shape
    uf = u.astype(jnp.float32)
    csum = jnp.concatenate([jnp.zeros((B, 1, POOL_WIDTH), jnp.float32), jnp.cumsum(uf, axis=1)], axis=1)
    pos = jnp.arange(T)
    pooled = []
    for g, win in enumerate(POOL_WINDOWS):
        lo = jnp.clip(pos - win // 2, 0, T)
        hi = jnp.clip(pos + win - win // 2, 0, T)
        cols = slice(g * POOL_GROUP, (g + 1) * POOL_GROUP)
        c = csum[:, :, cols]
        mean = (c[:, hi] - c[:, lo]) / (hi - lo).astype(jnp.float32)[None, :, None]
        pooled.append(mean - uf[:, :, cols])
    p = jnp.stack(pooled, axis=2)
    y = jnp.einsum('btgc,gcd->btgd', p, pool_w.astype(jnp.float32)).reshape(B, T, POOL_WIDTH)
    return (y * pool_scale.astype(jnp.float32)).astype(u.dtype)


def centred_short_conv(x, w):
    xp = jnp.pad(x, ((0, 0), (1, 1), (0, 0)))
    return xp[:, :-2] * w[0] + xp[:, 1:-1] * w[1] + xp[:, 2:] * w[2]


def rwkv7_step(S, inp):
    r, decay, k, v, a, b = inp
    sa = jnp.einsum('dbhvk,dbhk->dbhv', S, a)
    S = S * decay[..., None, :] + sa[..., :, None] * b[..., None, :] + v[..., :, None] * k[..., None, :]
    return S, jnp.einsum('dbhvk,dbhk->dbhv', S, r)


def bidirectional_rwkv7(rkv, w_lat, a_lat, g_lat, decay_w0, decay_up, iclr_a0, iclr_up, gate_up,
                        key_k, key_a, bonus_rk, gn_gain, gn_bias):
    B, T, _ = rkv.shape
    f32 = jnp.float32
    H, N = RWKV_HEADS, HEAD_DIM
    heads = lambda z: z.reshape(z.shape[:-1] + (H, N))
    r, k, v = jnp.split(rkv.astype(f32), 3, axis=-1)
    w = decay_w0.astype(f32)[:, None, None, :] + jnp.einsum('btr,drc->dbtc', jnp.tanh(w_lat.astype(f32)), decay_up.astype(f32))
    decay = jnp.exp(-jnp.exp(-jax.nn.softplus(-w) - 0.5))
    a = jax.nn.sigmoid(iclr_a0.astype(f32)[:, None, None, :]
                       + jnp.einsum('btr,drc->dbtc', a_lat.astype(f32), iclr_up.astype(f32)))
    g = jnp.einsum('btr,rc->btc', jax.nn.sigmoid(g_lat.astype(f32)), gate_up.astype(f32))
    kk = heads(k * key_k.astype(f32))
    kk = kk / jnp.maximum(jnp.sqrt(jnp.sum(kk * kk, axis=-1, keepdims=True)), 1e-12)
    k_eff = heads(k[None] * (1.0 + (a - 1.0) * key_a.astype(f32)))
    a_h = heads(a)
    shape = (2, B, T, H, N)
    r_h = jnp.broadcast_to(heads(r), shape)
    v_h = jnp.broadcast_to(heads(v), shape)
    kk_h = jnp.broadcast_to(kk, shape)

    def time_major(z):
        z = jnp.stack([z[0], jnp.flip(z[1], axis=1)])
        return jnp.moveaxis(z, 2, 0)

    xs = tuple(time_major(z) for z in (r_h, heads(decay), k_eff, v_h, -kk_h, kk_h * a_h))
    _, ys = lax.scan(rwkv7_step, jnp.zeros((2, B, H, N, N), f32), xs)
    ys = jnp.moveaxis(ys, 0, 2)
    y = ys[0] + jnp.flip(ys[1], axis=1)
    mu = jnp.mean(y, axis=-1, keepdims=True)
    var = jnp.mean(jnp.square(y - mu), axis=-1, keepdims=True)
    y = ((y - mu) * lax.rsqrt(var + GN_EPS)).reshape(B, T, RWKV_WIDTH) * gn_gain.astype(f32) + gn_bias.astype(f32)
    bonus = jnp.sum(r_h * k_eff * heads(bonus_rk.astype(f32)), axis=-1, keepdims=True) * v_h
    y = y + jnp.sum(bonus, axis=0).reshape(B, T, RWKV_WIDTH)
    return (y * g).astype(rkv.dtype)


def t5_relative_bucket(rel):
    nb = REL_BUCKETS // 2
    max_exact = nb // 2
    ret = (rel > 0).astype(jnp.int32) * nb
    n = jnp.abs(rel)
    nf = jnp.maximum(n, max_exact).astype(jnp.float32)
    large = max_exact + (jnp.log(nf / max_exact) / math.log(REL_MAX_DISTANCE / max_exact) * (nb - max_exact)).astype(jnp.int32)
    large = jnp.minimum(large, nb - 1)
    return ret + jnp.where(n < max_exact, n, large)


def dilated_branch(q, k, v, rel_bias, window, dilation):
    B, T, H, Dh = q.shape
    half = window // (2 * dilation)
    L = T // dilation
    nb = -(-L // half)
    Lp = nb * half

    def strided(z):
        z = z.reshape(B, L, dilation, H, Dh).transpose(0, 2, 1, 3, 4)
        return jnp.pad(z, ((0, 0), (0, 0), (0, Lp - L), (0, 0), (0, 0)))

    def band(z):
        zp = jnp.pad(z, ((0, 0), (0, 0), (half, half), (0, 0), (0, 0)))
        parts = [zp[:, :, s:s + Lp].reshape(B, dilation, nb, half, H, Dh) for s in (0, half, 2 * half)]
        return jnp.concatenate(parts, axis=3)

    qb = strided(q).reshape(B, dilation, nb, half, H, Dh)
    kb = band(strided(k))
    vb = band(strided(v))
    qi = jnp.arange(half)[:, None]
    kj = jnp.arange(3 * half)[None, :]
    rel = kj - half - qi
    kpos = jnp.arange(nb)[:, None, None] * half + kj[None] - half
    valid = (jnp.abs(rel) <= half)[None] & (kpos >= 0) & (kpos < L)
    bias = jnp.transpose(rel_bias.astype(jnp.float32)[t5_relative_bucket(rel * dilation)], (2, 0, 1))
    logits = jnp.einsum('brnqhd,brnkhd->brnhqk', qb, kb) * (Dh ** -0.5) + bias
    logits = jnp.where(valid[None, None, :, None], logits, NEG_INF)
    m = jnp.max(logits, axis=-1, keepdims=True)
    p = jnp.exp(logits - m)
    s = jnp.sum(p, axis=-1, keepdims=True)
    o = jnp.einsum('brnhqk,brnkhd->brnqhd', p, vb) / jnp.swapaxes(s, 3, 4)
    lse = jnp.swapaxes((m + jnp.log(s))[..., 0], 3, 4)
    o = o.reshape(B, dilation, Lp, H, Dh)[:, :, :L].transpose(0, 2, 1, 3, 4).reshape(B, T, H, Dh)
    lse = lse.reshape(B, dilation, Lp, H)[:, :, :L].transpose(0, 2, 1, 3).reshape(B, T, H)
    return o, lse


def dilated_attention(q, k, v, rel_bias):
    outs, lses = [], []
    for window, dilation in DILATED_CONFIGS:
        o, lse = dilated_branch(q, k, v, rel_bias, window, dilation)
        outs.append(o)
        lses.append(lse)
    alpha = jax.nn.softmax(jnp.stack(lses), axis=0)
    return jnp.sum(alpha[..., None] * jnp.stack(outs), axis=0)


def encoder_layer(x, layer_w, rel_bias):
    (n_mix_pre, n_mix_post, n_ffn_pre, n_ffn_post, w_in, w_out, pool_w, pool_scale, rwkv_conv,
     decay_w0, decay_up, iclr_a0, iclr_up, gate_up, key_k, key_a, bonus_rk, gn_gain, gn_bias,
     w_ff_in, w_ff_out) = layer_w
    B, T, _ = x.shape
    h = rms_norm(x, n_mix_pre)
    u_pool, rkv, w_lat, a_lat, g_lat, qkv = split_columns(h @ w_in)
    y_pool = pool_mixer(u_pool, pool_w, pool_scale)
    y_rwkv = bidirectional_rwkv7(centred_short_conv(rkv, rwkv_conv), w_lat, a_lat, g_lat, decay_w0, decay_up,
                                 iclr_a0, iclr_up, gate_up, key_k, key_a, bonus_rk, gn_gain, gn_bias)
    q, k, v = [z.astype(jnp.float32).reshape(B, T, ATT_HEADS, HEAD_DIM) for z in jnp.split(qkv, 3, axis=-1)]
    y_att = dilated_attention(q, k, v, rel_bias).reshape(B, T, ATT_WIDTH).astype(x.dtype)
    mixed = jnp.concatenate([y_pool, y_rwkv, y_att], axis=-1) @ w_out
    x = x + rms_norm(mixed, n_mix_post)
    h = rms_norm(x, n_ffn_pre)
    f = jnp.square(jax.nn.relu(h @ w_ff_in)) @ w_ff_out
    return x + rms_norm(f, n_ffn_post)


def setup_inputs(seed: int = 0) -> dict:
    key = jax.random.key(seed)
    ks = jax.random.split(key, 24)
    f32 = jnp.float32
    nrm = lambda k, shape, scale: scale * jax.random.normal(k, shape, f32)
    gain = lambda k, shape: 1.0 + 0.05 * jax.random.normal(k, shape, f32)
    RW = RWKV_WIDTH
    conv_base = jnp.array([0.25, 1.0, 0.25], f32)[None, :, None]
    return {
        'x_prompt': nrm(ks[0], (BATCH, SEQ, D_MODEL), 1.0),
        'x_sample': nrm(ks[1], (DEC_BATCH, DEC_SEQ, D_MODEL), 1.0),
        'norm_mix_pre': gain(ks[2], (DEPTH, D_MODEL)),
        'norm_mix_post': gain(ks[3], (DEPTH, D_MODEL)),
        'norm_ffn_pre': gain(ks[4], (DEPTH, D_MODEL)),
        'norm_ffn_post': gain(ks[5], (DEPTH, D_MODEL)),
        'w_in': nrm(ks[6], (DEPTH, D_MODEL, IN_WIDTH), D_MODEL ** -0.5),
        'w_out': nrm(ks[7], (DEPTH, MIX_WIDTH, D_MODEL), MIX_WIDTH ** -0.5),
        'pool_w': nrm(ks[8], (DEPTH, N_POOL_GROUPS, POOL_GROUP, POOL_GROUP), POOL_GROUP ** -0.5),
        'pool_scale': gain(ks[9], (DEPTH, POOL_WIDTH)),
        'rwkv_conv': conv_base + nrm(ks[10], (DEPTH, 3, 3 * RW), 0.05),
        'decay_w0': jax.random.uniform(ks[11], (DEPTH, 2, RW), f32, -6.0, -1.0),
        'decay_up': nrm(ks[12], (DEPTH, 2, DECAY_LORA, RW), 0.5 * DECAY_LORA ** -0.5),
        'iclr_a0': nrm(ks[13], (DEPTH, 2, RW), 0.5),
        'iclr_up': nrm(ks[14], (DEPTH, 2, ICLR_LORA, RW), 0.5 * ICLR_LORA ** -0.5),
        'gate_up': nrm(ks[15], (DEPTH, GATE_LORA, RW), GATE_LORA ** -0.5),
        'key_k': 0.85 + nrm(ks[16], (DEPTH, RW), 0.05),
        'key_a': gain(ks[17], (DEPTH, RW)),
        'bonus_rk': nrm(ks[18], (DEPTH, RW), 0.1),
        'gn_gain': gain(ks[19], (DEPTH, RW)),
        'gn_bias': nrm(ks[20], (DEPTH, RW), 0.02),
        'rel_bias': nrm(ks[21], (REL_BUCKETS, ATT_HEADS), 0.5),
        'w_ff_in': nrm(ks[22], (DEPTH, D_MODEL, D_FF), D_MODEL ** -0.5),
        'w_ff_out': nrm(ks[23], (DEPTH, D_FF, D_MODEL), D_FF ** -0.5),
    }


def reference(x_prompt, x_sample, norm_mix_pre, norm_mix_post, norm_ffn_pre, norm_ffn_post, w_in, w_out,
              pool_w, pool_scale, rwkv_conv, decay_w0, decay_up, iclr_a0, iclr_up, gate_up, key_k, key_a,
              bonus_rk, gn_gain, gn_bias, rel_bias, w_ff_in, w_ff_out):
    layer_stacks = (norm_mix_pre, norm_mix_post, norm_ffn_pre, norm_ffn_post, w_in, w_out, pool_w, pool_scale,
                    rwkv_conv, decay_w0, decay_up, iclr_a0, iclr_up, gate_up, key_k, key_a, bonus_rk,
                    gn_gain, gn_bias, w_ff_in, w_ff_out)

    def run_trunk(x):
        for l in range(DEPTH):
            x = encoder_layer(x, [w[l] for w in layer_stacks], rel_bias)
        return x

    y_prompt = run_trunk(x_prompt)
    y_sample = run_trunk(x_sample)
    return (y_prompt, y_sample)
```

```cpp
#include <hip/hip_runtime.h>
#include <cstdio>
#include <cstdint>
#ifndef PHM
#define PHM 0xFFFF
#endif
#ifndef MK_N_LAUNCHES
#define MK_N_LAUNCHES 1
#endif
namespace pg8 {
#define PG8_LAS __attribute__((address_space(3)))
typedef unsigned short bf16_t;
typedef short bf16x8 __attribute__((ext_vector_type(8)));
typedef float f32x4 __attribute__((ext_vector_type(4)));
typedef unsigned u32x4 __attribute__((ext_vector_type(4)));
constexpr int BM = 256, BK = 64, HALF = 128, HTB = HALF * BK * 2  , STAGE_BYTES = 8 * HTB, NXCD = 8, WGM = 8;

__host__ __device__ __forceinline__ int lds_byte(int r, int c) { const int st = (r >> 4) * 2 + (c >> 5), rr = r & 15, cc = c & 31, ob = rr * 64 + cc * 2; return st * 1024 + (ob ^ (((ob >> 9) & 1) << 5)); }
__host__ __device__ __forceinline__ void stage_rc(int b, int& R, int& C) { const int st = b / 1024, sb = b % 1024, swz = sb ^ (((sb >> 9) & 1) << 5); R = (st >> 1) * 16 + swz / 64; C = (st & 1) * 32 + (swz % 64) / 2; }
__host__ __device__ __forceinline__ int perm32(int rho) { const int n = rho >> 4, i = rho & 15; return 8 * (i >> 2) + 4 * n + (i & 3); }

struct Unit { int pm, pn; };
struct Gemm { const bf16_t* A; const bf16_t* Bt; int M, N, K; };

struct StaticOrder {
    int nM, nN, nwg, G, c;
    __host__ __device__ void init(int M, int N, int G_, int c_) { nM = M / BM; nN = N / BM; nwg = nM * nN; G = G_; c = c_; }
    __host__ __device__ bool next(int i, Unit& u) const {
        const long L = (long)i * G + c; if (L >= nwg) return false;
        int wgid = (int)L; { const int q = nwg / NXCD, r = nwg % NXCD, xcd = wgid % NXCD, off = wgid / NXCD; wgid = (xcd < r ? xcd * (q + 1) : r * (q + 1) + (xcd - r) * q) + off; }
        const int nig = WGM * nN, gid = wgid / nig, fm = gid * WGM, gsz = (nM - fm) < WGM ? (nM - fm) : WGM;
        u.pm = fm + ((wgid % nig) % gsz); u.pn = (wgid % nig) / gsz; return true;
    }
    __device__ __forceinline__ void a_ready(const Unit&) const {}
    __device__ __forceinline__ void done(const Unit&) const {}
};

__device__ __forceinline__ unsigned cvt_pk_bf16(float lo, float hi) { unsigned r; asm volatile("v_cvt_pk_bf16_f32 %0, %1, %2" : "=v"(r) : "v"(lo), "v"(hi)); return r; }
template <int ACT> struct EpiBf16 {
    static constexpr bool PERM = true, AFTER_DRAIN = false;
    bf16_t* O; int ldc;
    __device__ __forceinline__ void operator()(const f32x4 (&acc)[2][2][4][2], const Unit& u, int wr, int wc, int fr, int fq) const {
        const int row0 = u.pm * BM + wr * 64 + fr; const int col0 = u.pn * BM + wc * 32 + 8 * fq;
#pragma unroll
        for (int ai = 0; ai < 2; ++ai)
#pragma unroll
            for (int m = 0; m < 4; ++m) { bf16_t* rowp = O + (size_t)(row0 + ai * HALF + m * 16) * ldc + col0;
#pragma unroll
                for (int bj = 0; bj < 2; ++bj) { f32x4 v0 = acc[ai][bj][m][0], v1 = acc[ai][bj][m][1];
                    if (ACT == 2) {
#pragma unroll
                        for (int e = 0; e < 4; ++e) { float a = fmaxf(v0[e], 0.f), b = fmaxf(v1[e], 0.f); v0[e] = a * a; v1[e] = b * b; } }
                    u32x4 w; w.x = cvt_pk_bf16(v0[0], v0[1]); w.y = cvt_pk_bf16(v0[2], v0[3]); w.z = cvt_pk_bf16(v1[0], v1[1]); w.w = cvt_pk_bf16(v1[2], v1[3]);
                    *(u32x4*)(rowp + bj * HALF) = w; } }
    }
};
struct EpiRoute {
    static constexpr bool PERM = true, AFTER_DRAIN = false;
    bf16_t* PY; bf16_t* PX;
    __device__ __forceinline__ void operator()(const f32x4 (&acc)[2][2][4][2], const Unit& u, int wr, int wc, int fr, int fq) const {
        const int row0 = u.pm * BM + wr * 64 + fr;
#pragma unroll
        for (int bj = 0; bj < 2; ++bj) {
            const int g0 = u.pn * BM + bj * HALF; bf16_t* base = (g0 < 1408) ? (PY + g0) : (PX + (g0 - 1408));
            base += wc * 32 + 8 * fq;
#pragma unroll
            for (int ai = 0; ai < 2; ++ai)
#pragma unroll
                for (int m = 0; m < 4; ++m) { const f32x4 v0 = acc[ai][bj][m][0], v1 = acc[ai][bj][m][1];
                    u32x4 w; w.x = cvt_pk_bf16(v0[0], v0[1]); w.y = cvt_pk_bf16(v0[2], v0[3]); w.z = cvt_pk_bf16(v1[0], v1[1]); w.w = cvt_pk_bf16(v1[2], v1[3]);
                    *(u32x4*)(base + (size_t)(row0 + ai * HALF + m * 16) * 1408) = w; } }
    }
};
template <class Epi, class Sched, bool ALIGN_EPI = false, bool SP2 = false>
__device__ __forceinline__ void gemm_phase(PG8_LAS unsigned char* lds, const Gemm g, const Sched& S, const Epi& E, const int tid) {
    const int wid = __builtin_amdgcn_readfirstlane(tid >> 6), lane = tid & 63, wr = wid >> 2, wc = wid & 3, fr = lane & 15, fq = lane >> 4;
    const int K = g.K, nt = K / BK;
    unsigned voffA[2], voffB[2];
#pragma unroll
    for (int i = 0; i < 2; ++i) { int R, C; stage_rc(tid * 16 + i * 8192, R, C); const int Rb = Epi::PERM ? ((R & ~31) + perm32(R & 31)) : R;
        voffA[i] = (unsigned)(R * K + C) * 2u; voffB[i] = (unsigned)(Rb * K + C) * 2u; }
    const size_t kstep = (size_t)(BK * 2);
    const size_t hstep = (size_t)HALF * K * 2;
    const size_t tstep = 2 * hstep;
    const unsigned ldsw = (unsigned)wid * 1024u;
    const int aoff = lds_byte(wr * 64 + fr, fq * 8), boff = lds_byte(wc * 32 + fr, fq * 8);
#define PG8_SA(b, h) (((b) * 2 + (h)) * HTB)
#define PG8_SB(b, h) ((4 + (b) * 2 + (h)) * HTB)
#define PG8_STAGE(bufoff, gbase, voff) do { _Pragma("unroll") for (int _i = 0; _i < 2; ++_i) \
        __builtin_amdgcn_global_load_lds((const unsigned*)((const char*)(gbase) + (voff)[_i]), (PG8_LAS unsigned*)(lds + (bufoff) + ldsw + _i * 8192), 16, 0, 0); } while (0)
#define PG8_LDA(dst, b, h) do { _Pragma("unroll") for (int m = 0; m < 4; ++m) _Pragma("unroll") for (int k = 0; k < 2; ++k) dst[m][k] = *(const PG8_LAS bf16x8*)(lds + PG8_SA(b, h) + aoff + m * 2048 + k * 1024); } while (0)
#define PG8_LDB(dst, b, h) do { _Pragma("unroll") for (int n = 0; n < 2; ++n) _Pragma("unroll") for (int k = 0; k < 2; ++k) dst[n][k] = *(const PG8_LAS bf16x8*)(lds + PG8_SB(b, h) + boff + n * 2048 + k * 1024); } while (0)
#define PG8_MMA(ai, bj, At, Bt) do { __builtin_amdgcn_s_setprio(1); _Pragma("unroll") for (int m = 0; m < 4; ++m) _Pragma("unroll") for (int n = 0; n < 2; ++n) _Pragma("unroll") for (int k = 0; k < 2; ++k) \
        acc[ai][bj][m][n] = __builtin_amdgcn_mfma_f32_16x16x32_bf16(Bt[n][k], At[m][k], acc[ai][bj][m][n], 0, 0, 0); __builtin_amdgcn_s_setprio(0); } while (0)
#define PG8_WAIT_V(n) asm volatile("s_waitcnt vmcnt(" #n ")" ::: "memory")
#define PG8_WAIT_L(n) asm volatile("s_waitcnt lgkmcnt(" #n ")" ::: "memory")
#define PG8_BAR __builtin_amdgcn_s_barrier()
#define PG8_SCHED __builtin_amdgcn_sched_barrier(0)
    Unit cur, nxt; int ui = 0;
    if (!S.next(0, cur)) return;
    f32x4 acc[2][2][4][2];
#pragma unroll
    for (int a = 0; a < 2; ++a)
#pragma unroll
        for (int b = 0; b < 2; ++b)
#pragma unroll
            for (int m = 0; m < 4; ++m)
#pragma unroll
                for (int n = 0; n < 2; ++n) acc[a][b][m][n] = (f32x4){0.f, 0.f, 0.f, 0.f};
    bf16x8 At[4][2], B0[2][2], B1[2][2];
    const char* cA = (const char*)g.A + (size_t)cur.pm * tstep; const char* cB = (const char*)g.Bt + (size_t)cur.pn * tstep;
    S.a_ready(cur);
    if constexpr (SP2) {
        PG8_STAGE(PG8_SB(0, 0), cB, voffB); PG8_STAGE(PG8_SB(0, 1), cB + hstep, voffB); PG8_STAGE(PG8_SA(0, 0), cA, voffA); PG8_STAGE(PG8_SA(0, 1), cA + hstep, voffA);
        if (wr == 1) PG8_BAR;
        PG8_WAIT_V(2); PG8_BAR;
        PG8_STAGE(PG8_SB(1, 0), cB + kstep, voffB); PG8_STAGE(PG8_SA(1, 0), cA + kstep, voffA); PG8_STAGE(PG8_SB(1, 1), cB + hstep + kstep, voffB);
        PG8_WAIT_V(6); PG8_BAR;
    } else {
        PG8_STAGE(PG8_SB(0, 0), cB, voffB); PG8_STAGE(PG8_SA(0, 0), cA, voffA); PG8_STAGE(PG8_SB(0, 1), cB + hstep, voffB); PG8_STAGE(PG8_SA(0, 1), cA + hstep, voffA);
        if (wr == 1) PG8_BAR;
        PG8_WAIT_V(4); PG8_BAR;
        PG8_STAGE(PG8_SB(1, 0), cB + kstep, voffB); PG8_STAGE(PG8_SA(1, 0), cA + kstep, voffA); PG8_STAGE(PG8_SB(1, 1), cB + hstep + kstep, voffB);
        PG8_WAIT_V(6); PG8_BAR;
    }
    for (;;) {
        const bool has_next = S.next(ui + 1, nxt);
        const char* nA = has_next ? (const char*)g.A + (size_t)nxt.pm * tstep : cA; const char* nB = has_next ? (const char*)g.Bt + (size_t)nxt.pn * tstep : cB;
        for (int t = 0; t < nt; t += 2) {
            const bool last = (t == nt - 2);
            const char* a1 = cA + (size_t)(t + 1) * kstep;
            const char* a2 = last ? nA : cA + (size_t)(t + 2) * kstep; const char* b2 = last ? nB : cB + (size_t)(t + 2) * kstep;
            const char* a3 = a2 + kstep; const char* b3 = b2 + kstep;
            if (last && has_next) S.a_ready(nxt);
            if constexpr (SP2) {
            PG8_LDB(B0, 0, 0); PG8_LDB(B1, 0, 1); PG8_SCHED; PG8_LDA(At, 0, 0); PG8_STAGE(PG8_SA(1, 1), a1 + hstep, voffA);
            PG8_WAIT_V(8); PG8_WAIT_L(0); PG8_BAR; PG8_MMA(0, 0, At, B0); PG8_MMA(0, 1, At, B1); PG8_BAR; PG8_SCHED;
            PG8_LDA(At, 0, 1); PG8_STAGE(PG8_SB(0, 0), b2, voffB); PG8_STAGE(PG8_SB(0, 1), b2 + hstep, voffB); PG8_STAGE(PG8_SA(0, 0), a2, voffA);
            PG8_WAIT_V(8); PG8_WAIT_L(0); PG8_BAR; PG8_MMA(1, 0, At, B0); PG8_MMA(1, 1, At, B1); PG8_BAR; PG8_SCHED;
            PG8_LDB(B0, 1, 0); PG8_LDB(B1, 1, 1); PG8_SCHED; PG8_LDA(At, 1, 0); PG8_STAGE(PG8_SA(0, 1), a2 + hstep, voffA);
            PG8_WAIT_V(8); PG8_WAIT_L(0); PG8_BAR; PG8_MMA(0, 0, At, B0); PG8_MMA(0, 1, At, B1); PG8_BAR; PG8_SCHED;
            PG8_LDA(At, 1, 1); PG8_STAGE(PG8_SB(1, 0), b3, voffB); PG8_STAGE(PG8_SB(1, 1), b3 + hstep, voffB); PG8_STAGE(PG8_SA(1, 0), a3, voffA);
            PG8_WAIT_V(8); PG8_WAIT_L(0); PG8_BAR; PG8_MMA(1, 0, At, B0); PG8_MMA(1, 1, At, B1); PG8_BAR; PG8_SCHED;
            } else {
            PG8_LDB(B0, 0, 0); PG8_SCHED; PG8_LDA(At, 0, 0); PG8_STAGE(PG8_SA(1, 1), a1 + hstep, voffA);
            PG8_WAIT_L(8); PG8_BAR; PG8_WAIT_L(0); PG8_MMA(0, 0, At, B0); PG8_BAR; PG8_SCHED;
            PG8_LDB(B1, 0, 1); PG8_STAGE(PG8_SB(0, 0), b2, voffB);
            PG8_BAR; PG8_WAIT_L(0); PG8_MMA(0, 1, At, B1); PG8_BAR;
            PG8_LDA(At, 0, 1); PG8_STAGE(PG8_SA(0, 0), a2, voffA);
            PG8_BAR; PG8_WAIT_L(0); PG8_MMA(1, 0, At, B0); PG8_BAR; PG8_SCHED;
            PG8_STAGE(PG8_SB(0, 1), b2 + hstep, voffB);
            PG8_WAIT_V(6); PG8_BAR; PG8_MMA(1, 1, At, B1); PG8_BAR;
            PG8_LDB(B0, 1, 0); PG8_SCHED; PG8_LDA(At, 1, 0); PG8_STAGE(PG8_SA(0, 1), a2 + hstep, voffA);
            PG8_WAIT_L(8); PG8_BAR; PG8_WAIT_L(0); PG8_MMA(0, 0, At, B0); PG8_BAR; PG8_SCHED;
            PG8_LDB(B1, 1, 1); PG8_STAGE(PG8_SB(1, 0), b3, voffB);
            PG8_BAR; PG8_WAIT_L(0); PG8_MMA(0, 1, At, B1); PG8_BAR;
            PG8_LDA(At, 1, 1); PG8_STAGE(PG8_SA(1, 0), a3, voffA);
            PG8_BAR; PG8_WAIT_L(0); PG8_MMA(1, 0, At, B0); PG8_BAR; PG8_SCHED;
            PG8_STAGE(PG8_SB(1, 1), b3 + hstep, voffB);
            PG8_WAIT_V(6); PG8_BAR; PG8_MMA(1, 1, At, B1); PG8_BAR;
            }
        }
        if constexpr (ALIGN_EPI) { if (wr == 0) PG8_BAR; }
        if constexpr (!Epi::AFTER_DRAIN) { E(acc, cur, wr, wc, fr, fq); S.done(cur); }
        if (!has_next) break;
#pragma unroll
        for (int a = 0; a < 2; ++a)
#pragma unroll
            for (int b = 0; b < 2; ++b)
#pragma unroll
                for (int m = 0; m < 4; ++m)
#pragma unroll
                    for (int n = 0; n < 2; ++n) acc[a][b][m][n] = (f32x4){0.f, 0.f, 0.f, 0.f};
        cur = nxt; cA = nA; cB = nB; ++ui;
        if constexpr (ALIGN_EPI) { if (wr == 1) PG8_BAR; }
    }
    PG8_WAIT_V(0);
    if constexpr (!ALIGN_EPI) { if (wr == 0) PG8_BAR; }
    PG8_BAR;
    if constexpr (Epi::AFTER_DRAIN) { E.fused(acc, cur, wr, wc, fr, fq, lds, wid, lane); S.done(cur); }
#undef PG8_SA
#undef PG8_SB
#undef PG8_STAGE
#undef PG8_LDA
#undef PG8_LDB
#undef PG8_MMA
#undef PG8_WAIT_V
#undef PG8_WAIT_L
#undef PG8_BAR
#undef PG8_SCHED
}
}
#define GAS __attribute__((address_space(1)))
#define LAS __attribute__((address_space(3)))
typedef unsigned short bf16;
typedef unsigned v4u __attribute__((ext_vector_type(4)));
typedef float f32x4 __attribute__((ext_vector_type(4)));
typedef short bf16x8 __attribute__((ext_vector_type(8)));
typedef GAS unsigned gu32;
typedef GAS unsigned long long gu64;
#define RLX_AGENT __ATOMIC_RELAXED, __HIP_MEMORY_SCOPE_AGENT
#define LDS_WAIT() asm volatile("s_waitcnt lgkmcnt(0)" ::: "memory")
#define VM_WAIT() asm volatile("s_waitcnt vmcnt(0)" ::: "memory")
__device__ __forceinline__ unsigned long long rt() { return __builtin_amdgcn_s_memrealtime(); }
__device__ __forceinline__ unsigned f2bf(float f) { unsigned u = __builtin_bit_cast(unsigned, f); return (u + 0x7fffu + ((u >> 16) & 1u)) >> 16; }
__device__ __forceinline__ unsigned pk2(float lo, float hi) { return f2bf(lo) | (f2bf(hi) << 16); }

#define XB_TMO      128
#define XB_XCNT(j)  (256  + 64 * (j))
#define XB_XSUB(j)  (1280 + 64 * (j))
#define XB_XGEN(j)  (2304 + 64 * (j))
#define XB_TOP      3328
#define XB_TOPGEN   3392
#define XCD_BAR_WORDS 3456
#define XB_SPIN_CAP (1u << 18)

__device__ __forceinline__ unsigned xb_ld(unsigned* p)              { return __hip_atomic_load(p, __ATOMIC_RELAXED, __HIP_MEMORY_SCOPE_AGENT); }
__device__ __forceinline__ unsigned xb_add(unsigned* p, unsigned v) { return __hip_atomic_fetch_add(p, v, __ATOMIC_RELAXED, __HIP_MEMORY_SCOPE_AGENT); }
__device__ __forceinline__ unsigned xb_xcc_id() { return (unsigned)__builtin_amdgcn_s_getreg((3 << 11) | 20) & 0xFu; }
#define XB_SPIN(cond, bar) do { unsigned _sp = 0; while (cond) { __builtin_amdgcn_s_sleep(1); \
    if ((++_sp & 255u) == 0u) { if (xb_ld(&(bar)[XB_TMO])) break; if (_sp > XB_SPIN_CAP) { atomicAdd(&(bar)[XB_TMO], 1u); break; } } } } while (0)

struct XcdBarrier {
    unsigned* bar; unsigned x;
    volatile LAS unsigned* st;
};

__device__ __forceinline__ XcdBarrier xcd_barrier_post(unsigned* bar, volatile LAS unsigned* st) {
    XcdBarrier b; b.bar = bar; b.x = xb_xcc_id(); b.st = st;
    if (threadIdx.x == 0) (void)xb_add(&bar[XB_XCNT(b.x)], 1u);
    return b;
}
__device__ __forceinline__ void xcd_barrier_complete(unsigned* bar, unsigned x, unsigned& nloc, unsigned& nx) {
    const unsigned G = gridDim.x * gridDim.y * gridDim.z;
    unsigned sum, cnt, mine, sp = 0u;
    for (;;) {
        sum = 0u; cnt = 0u; mine = 0u;
#pragma unroll
        for (unsigned j = 0; j < 16; ++j) { const unsigned c = xb_ld(&bar[XB_XCNT(j)]); sum += c; cnt += (c > 0u) ? 1u : 0u; mine = (j == x) ? c : mine; }
        if (sum == G) break;
        __builtin_amdgcn_s_sleep(1);
        if ((++sp & 255u) == 0u) { if (xb_ld(&bar[XB_TMO])) break; if (sp > XB_SPIN_CAP) { atomicAdd(&bar[XB_TMO], 1u); break; } }
    }
    nloc = mine > 0u ? mine : 1u; nx = cnt > 0u ? cnt : 1u;
}

__device__ __forceinline__ void xcd_barrier(const XcdBarrier& b) {
    asm volatile("s_waitcnt vmcnt(0)" ::: "memory");
    __syncthreads();
    if (threadIdx.x == 0) {
        unsigned* bar = b.bar;
        __builtin_amdgcn_s_waitcnt(0);
        unsigned nloc = b.st[0], nx = b.st[1];
        if (nloc == 0u) { xcd_barrier_complete(bar, b.x, nloc, nx); b.st[0] = nloc; b.st[1] = nx; }
        const unsigned old = xb_add(&bar[XB_XSUB(b.x)], 1u);
        const unsigned gen = old / nloc;
        if (old + 1u == (gen + 1u) * nloc) {
            __builtin_amdgcn_fence(__ATOMIC_RELEASE, "agent");
            asm volatile("s_waitcnt vmcnt(0)" ::: "memory");
            const unsigned og = xb_add(&bar[XB_TOP], 1u);
            const unsigned tg = og / nx;
            if (og + 1u == (tg + 1u) * nx) xb_add(&bar[XB_TOPGEN], 1u);
            else XB_SPIN(xb_ld(&bar[XB_TOPGEN]) == tg, bar);
            __builtin_amdgcn_fence(__ATOMIC_ACQUIRE, "agent");
            xb_add(&bar[XB_XGEN(b.x)], 1u);
            asm volatile("s_waitcnt vmcnt(0)" ::: "memory");
        } else {
            XB_SPIN(xb_ld(&bar[XB_XGEN(b.x)]) == gen, bar);
            __builtin_amdgcn_fence(__ATOMIC_ACQUIRE, "agent");
            asm volatile("s_waitcnt vmcnt(0)" ::: "memory");
        }
    }
    __syncthreads();
}
constexpr int NWAVES = 8;
constexpr int D = 1024, MH = 16384, NIN = 2816, FF = 4096, RW = 384, NH = 6, PXW = 1408;
constexpr float NORM_EPS = 1e-6f, GN_EPS = 64e-5f, LOG2E = 1.4426950408889634f, LN2 = 0.6931471805599453f;
enum { I_XP = 0, I_XS, I_NMPRE, I_NMPOST, I_NFPRE, I_NFPOST, I_WIN, I_WOUT, I_POOLW, I_POOLS, I_CONV, I_DW0, I_DUP, I_IA0, I_IUP, I_GUP, I_KK, I_KA, I_BRK, I_GNG, I_GNB, I_RELB, I_WFI, I_WFO };
constexpr size_t MiB = 1u << 20;
constexpr size_t WS_CTL = 0, CTL_ZERO_BYTES = 1 * MiB;
constexpr size_t WS_SMALL = 1 * MiB;
constexpr size_t WS_W = 2 * MiB, W_LAYER = 47 * MiB / 2;
constexpr size_t W_IN = 0, W_OUT = 11 * MiB / 2, W_FFI = 15 * MiB / 2, W_FFO = 31 * MiB / 2;
constexpr size_t WS_XN = 51 * MiB, WS_MIX = 83 * MiB, WS_PX = 115 * MiB, WS_PY = 159 * MiB, WS_FREE = 203 * MiB, WS_END = 256 * MiB;
constexpr size_t WS_H = 115 * MiB;
constexpr size_t WS_F1 = 159 * MiB;
constexpr size_t WS_OB = 203 * MiB, WS_LSE = 239 * MiB;
constexpr size_t WS_GP = 159 * MiB, WS_H0T = 183 * MiB, WS_RY = 207 * MiB, WS_Y0 = 231 * MiB, WS_HC = 51 * MiB, WS_DC = 75 * MiB, WS_BON = 76 * MiB;
constexpr int CW_TMO = 0, CW_CODE = 1, CW_BAR = 4096;
constexpr int RING_OFF = 0, RING_BYTES = 131072, LDSCTL_OFF = RING_BYTES, MISC_OFF = LDSCTL_OFF + 320, LDS_BYTES = 147456;
typedef float f32x16 __attribute__((ext_vector_type(16)));
typedef unsigned v2u __attribute__((ext_vector_type(2)));
typedef float f32x2_t __attribute__((ext_vector_type(2))); typedef __bf16 bf16x2_t __attribute__((ext_vector_type(2)));
__device__ __forceinline__ unsigned cvtpk(float lo, float hi) { f32x2_t v = {lo, hi}; bf16x2_t b = __builtin_convertvector(v, bf16x2_t); return __builtin_bit_cast(unsigned, b); }
__device__ __forceinline__ float bf2f(unsigned u) { return __builtin_bit_cast(float, u << 16); }
__device__ __forceinline__ float bflo(unsigned w) { return __builtin_bit_cast(float, w << 16); }
__device__ __forceinline__ float bfhi(unsigned w) { return __builtin_bit_cast(float, w & 0xffff0000u); }
__device__ __forceinline__ f32x16 mfma32(bf16x8 a, bf16x8 b, f32x16 c) { return __builtin_amdgcn_mfma_f32_32x32x16_bf16(a, b, c, 0, 0, 0); }
__device__ __forceinline__ f32x4 mfma16(bf16x8 a, bf16x8 b, f32x4 c) { return __builtin_amdgcn_mfma_f32_16x16x32_bf16(a, b, c, 0, 0, 0); }
__device__ __forceinline__ int crow(int i, int hh) { return (i & 3) + 8 * (i >> 2) + 4 * hh; }
__device__ __forceinline__ bf16x8 pack8(const f32x16& x, int s) {
    v4u p; p.x = cvtpk(x[8 * s], x[8 * s + 1]); p.y = cvtpk(x[8 * s + 2], x[8 * s + 3]); p.z = cvtpk(x[8 * s + 4], x[8 * s + 5]); p.w = cvtpk(x[8 * s + 6], x[8 * s + 7]);
    return __builtin_bit_cast(bf16x8, p);
}
__device__ __forceinline__ float sigmoidf_(float x) { return 1.0f / (1.0f + __expf(-x)); }
__device__ __forceinline__ float wave_sum(float v) {
#pragma unroll
    for (int o = 1; o < 64; o <<= 1) v += __shfl_xor(v, o);
    return v;
}

struct Frame {
    LAS unsigned char* lds;
    volatile LAS unsigned* MISC;
    gu32* ctl;
    int tid, lane, wave, G, vcu;
    float* out; unsigned char* ws;
};
#define WSP(T, off) ((T*)(F.ws + (off)))
struct Args { const float* in[24]; float* out; unsigned char* ws; int ph_lo, ph_hi, li, pad; };
#define KARG const Args& KA
#define INP(i) (KA.in[i])

__device__ __forceinline__ void transpose_item(const float* W, int ldw, int K, bf16* WT, int n0, int srccol0, int k0, LAS float* scr, int lane) {
#pragma unroll 8
    for (int i = 0; i < 32; ++i) { const int kk = 2 * i + (lane >> 5); scr[kk * 33 + (lane & 31)] = W[(size_t)(k0 + kk) * ldw + srccol0 + (lane & 31)]; }
    LDS_WAIT(); asm volatile("" ::: "memory");
    const int c = lane & 7;
#pragma unroll
    for (int j = 0; j < 4; ++j) { const int n = (lane >> 3) + 8 * j; const LAS float* s = scr + (8 * c) * 33 + n;
        v4u o; o.x = pk2(s[0 * 33], s[1 * 33]); o.y = pk2(s[2 * 33], s[3 * 33]); o.z = pk2(s[4 * 33], s[5 * 33]); o.w = pk2(s[6 * 33], s[7 * 33]);
        *(GAS v4u*)(WT + (size_t)(n0 + n) * K + k0 + 8 * c) = o; }
    LDS_WAIT(); asm volatile("" ::: "memory");
}
__device__ __forceinline__ int win_src(int n) { return n < 256 ? n : (n < 1408 ? 1664 + (n - 256) : (n < 2560 ? 256 + (n - 1408) : 1408 + (n - 2560))); }
__device__ __forceinline__ void phase_weights(KARG, Frame& F) {
    LAS float* scr = (LAS float*)(F.lds + RING_OFF + F.wave * 16384);
    const int gw = F.vcu * NWAVES + F.wave, NGW = F.G * NWAVES;
    constexpr int I_IN = (D / 64) * (NIN / 32), I_OUT = (D / 64) * (D / 32), I_FI = (D / 64) * (FF / 32), I_FO = (FF / 64) * (D / 32), I_G = (128 / 64) * (RW / 32);
    constexpr int PER_L = I_IN + I_OUT + I_FI + I_FO + I_G;
    for (int it = gw; it < 2 * PER_L; it += NGW) {
        const int l = it / PER_L; int r = it % PER_L;
        unsigned char* wl = F.ws + WS_W + (size_t)l * W_LAYER;
        if (r < I_IN) { const int nb = r % (NIN / 32), kb = r / (NIN / 32); transpose_item(KA.in[I_WIN] + (size_t)l * D * NIN, NIN, D, (bf16*)(wl + W_IN), 32 * nb, win_src(32 * nb), 64 * kb, scr, F.lane); continue; } r -= I_IN;
        if (r < I_OUT) { const int nb = r % (D / 32), kb = r / (D / 32); transpose_item(KA.in[I_WOUT] + (size_t)l * D * D, D, D, (bf16*)(wl + W_OUT), 32 * nb, 32 * nb, 64 * kb, scr, F.lane); continue; } r -= I_OUT;
        if (r < I_FI) { const int nb = r % (FF / 32), kb = r / (FF / 32); transpose_item(KA.in[I_WFI] + (size_t)l * D * FF, FF, D, (bf16*)(wl + W_FFI), 32 * nb, 32 * nb, 64 * kb, scr, F.lane); continue; } r -= I_FI;
        if (r < I_FO) { const int nb = r % (D / 32), kb = r / (D / 32); transpose_item(KA.in[I_WFO] + (size_t)l * FF * D, D, FF, (bf16*)(wl + W_FFO), 32 * nb, 32 * nb, 64 * kb, scr, F.lane); continue; } r -= I_FO;
        { const int nb = r % (RW / 32), kb = r / (RW / 32); transpose_item(KA.in[I_GUP] + (size_t)l * 128 * RW, RW, 128, WSP(bf16, WS_SMALL) + (size_t)l * RW * 128, 32 * nb, 32 * nb, 64 * kb, scr, F.lane); }
    }
}
__device__ __forceinline__ void phase_xn_init(KARG, Frame& F, int hf) {
    const int gw = F.vcu * NWAVES + F.wave, NGW = F.G * NWAVES;
    const float* X = KA.in[hf ? I_XS : I_XP]; const GAS f32x4* gp = (const GAS f32x4*)KA.in[I_NMPRE] + F.lane;
    f32x4 g[4];
#pragma unroll
    for (int j = 0; j < 4; ++j) g[j] = gp[64 * j];
    for (int m = gw; m < MH; m += NGW) {
        const GAS f32x4* xr = (const GAS f32x4*)(X + (size_t)m * D) + F.lane; f32x4 v[4]; float s = 0.f;
#pragma unroll
        for (int j = 0; j < 4; ++j) { v[j] = xr[64 * j]; s += (v[j].x * v[j].x + v[j].y * v[j].y) + (v[j].z * v[j].z + v[j].w * v[j].w); }
        const float rstd = 1.0f / sqrtf(wave_sum(s) * (1.f / D) + NORM_EPS);
        GAS v2u* o8 = (GAS v2u*)(WSP(bf16, WS_XN) + (size_t)m * D) + F.lane;
#pragma unroll
        for (int j = 0; j < 4; ++j) { v2u w; w.x = pk2(v[j].x * rstd * g[j].x, v[j].y * rstd * g[j].y); w.y = pk2(v[j].z * rstd * g[j].z, v[j].w * rstd * g[j].w); o8[64 * j] = w; }
    }
}
__device__ __forceinline__ void phase_rowpass(KARG, Frame& F, int hf, const bf16* Fm, const float* base, const float* gpost, const float* gnext) {
    const int gw = F.vcu * NWAVES + F.wave, NGW = F.G * NWAVES;
    f32x4 gp[4], gn[4];
#pragma unroll
    for (int j = 0; j < 4; ++j) { gp[j] = ((const GAS f32x4*)gpost + F.lane)[64 * j]; gn[j] = gnext ? ((const GAS f32x4*)gnext + F.lane)[64 * j] : (f32x4){0.f, 0.f, 0.f, 0.f}; }
    float* out = F.out + (size_t)hf * MH * D;
    for (int m = gw; m < MH; m += NGW) {
        const GAS v2u* fr = (const GAS v2u*)(Fm + (size_t)m * D) + F.lane; const GAS f32x4* xr = (const GAS f32x4*)(base + (size_t)m * D) + F.lane;
        f32x4 f[4], x[4]; float s = 0.f;
#pragma unroll
        for (int j = 0; j < 4; ++j) { const v2u w = fr[64 * j]; x[j] = xr[64 * j]; f[j] = (f32x4){bflo(w.x), bfhi(w.x), bflo(w.y), bfhi(w.y)}; s += (f[j].x * f[j].x + f[j].y * f[j].y) + (f[j].z * f[j].z + f[j].w * f[j].w); }
        const float rstd = 1.0f / sqrtf(wave_sum(s) * (1.f / D) + NORM_EPS); float s2 = 0.f;
        GAS f32x4* orow = (GAS f32x4*)(out + (size_t)m * D) + F.lane;
#pragma unroll
        for (int j = 0; j < 4; ++j) { x[j] = x[j] + f[j] * rstd * gp[j]; orow[64 * j] = x[j]; s2 += (x[j].x * x[j].x + x[j].y * x[j].y) + (x[j].z * x[j].z + x[j].w * x[j].w); }
        if (gnext) {
            const float r2 = 1.0f / sqrtf(wave_sum(s2) * (1.f / D) + NORM_EPS);
            GAS v2u* o8 = (GAS v2u*)(WSP(bf16, WS_XN) + (size_t)m * D) + F.lane;
#pragma unroll
            for (int j = 0; j < 4; ++j) { v2u w; w.x = pk2(x[j].x * r2 * gn[j].x, x[j].y * r2 * gn[j].y); w.y = pk2(x[j].z * r2 * gn[j].z, x[j].w * r2 * gn[j].w); o8[64 * j] = w; }
        }
    }
}
__device__ __forceinline__ void pool_tile(KARG, Frame& F, int hf, int l, int tile) {
    LAS float* U = (LAS float*)(F.lds + RING_OFF);
    LAS float* Pd = U + 48 * 256;
    const bf16* PY = WSP(bf16, WS_PY); bf16* MIX = WSP(bf16, WS_MIX);
    const int T = hf ? 16384 : 8192; const int r0 = tile * 32; const int sbase = hf ? 0 : (r0 & ~8191); const int t0 = r0 - sbase;
    __syncthreads();
    for (int i = F.tid; i < 48 * 32; i += 512) { const int rr = i >> 5, c8 = (i & 31) * 8; const int t = t0 - 8 + rr;
        if (t >= 0 && t < T) { const v4u w = *(const GAS v4u*)(PY + (size_t)(sbase + t) * PXW + c8); LAS float* u = U + rr * 256 + c8;
            u[0] = bflo(w.x); u[1] = bfhi(w.x); u[2] = bflo(w.y); u[3] = bfhi(w.y); u[4] = bflo(w.z); u[5] = bfhi(w.z); u[6] = bflo(w.w); u[7] = bfhi(w.w); } }
    __syncthreads();
    { const int ch = F.tid & 255, g = ch >> 6, win = 2 << g, hw = win >> 1;
      for (int tt = F.tid >> 8; tt < 32; tt += 2) { const int t = t0 + tt; int lo = t - hw; if (lo < 0) lo = 0; int hi = t + win - hw; if (hi > T) hi = T;
          float s = 0.f; for (int q = lo; q < hi; ++q) s += U[(q - t0 + 8) * 256 + ch];
          Pd[tt * 256 + ch] = s / (float)(hi - lo) - U[(tt + 8) * 256 + ch]; } }
    __syncthreads();
    { const int d = F.tid & 63, g = (F.tid >> 6) & 3, tg = F.tid >> 8;
      const float* pw = KA.in[I_POOLW] + (size_t)l * 4 * 64 * 64 + g * 4096 + d; const float sc = KA.in[I_POOLS][l * 256 + g * 64 + d];
      float acc[16];
#pragma unroll
      for (int i = 0; i < 16; ++i) acc[i] = 0.f;
      for (int c = 0; c < 64; ++c) { const float w = pw[c * 64];
#pragma unroll
          for (int i = 0; i < 16; ++i) acc[i] += Pd[(tg * 16 + i) * 256 + g * 64 + c] * w; }
#pragma unroll
      for (int i = 0; i < 16; ++i) MIX[(size_t)(r0 + tg * 16 + i) * D + g * 64 + d] = (bf16)f2bf(acc[i] * sc); }
}
constexpr int BT_STRIDE = 192;
__device__ __forceinline__ void attn_bias_table(KARG, Frame& F, LAS float* bt) {
    const float* rb = KA.in[I_RELB];
    for (int i = F.tid; i < 18 * BT_STRIDE; i += 512) { const int bh = i / BT_STRIDE, o = i % BT_STRIDE, b = bh / 6, h = bh % 6; const int rel = o - 96; float val = 0.f;
        if (rel >= -64 && rel <= 64) { const int rp = rel * (1 << (2 * b)); int ret = rp > 0 ? 16 : 0; const int n = rp < 0 ? -rp : rp;
            if (n < 8) ret += n; else { const float nf = (float)n; int large = 8 + (int)(logf(nf / 8.0f) / logf(128.0f) * 8.0f); if (large > 15) large = 15; ret += large; }
            val = rb[ret * 6 + h] * LOG2E; }
        bt[i] = val; }
}
__device__ __forceinline__ void attn_unit(Frame& F, int hf, int uidx, const LAS float* btab) {
    const int lane = F.lane, c31 = lane & 31, hh = lane >> 5;
    const int T = hf ? 16384 : 8192, nblk = T >> 6, nseq = hf ? 1 : 2;
    const int qt = uidx & 1; int g = uidx >> 1; const int blk = g % nblk; g /= nblk; const int s = g % nseq; g /= nseq; const int h = g % 6, b = g / 6;
    const int dsh = 2 * b, L = T >> dsh, nbs = L >> 6, r = blk / nbs, n = blk % nbs, row0 = s * 8192 + r;
    const bf16* PY = WSP(bf16, WS_PY);
    bf16x8 idf[2];
#pragma unroll
    for (int p = 0; p < 2; ++p)
#pragma unroll
        for (int e = 0; e < 8; ++e) idf[p][e] = (c31 - 16 * p - 8 * hh == e) ? (short)0x3F80 : (short)0;
    const int qi = 32 * qt + c31; const int qrow = row0 + ((64 * n + qi) << dsh);
    bf16x8 qf[4];
#pragma unroll
    for (int ks = 0; ks < 4; ++ks) qf[ks] = *(const GAS bf16x8*)(PY + (size_t)qrow * PXW + 256 + h * 64 + 8 * hh + 16 * ks);
    f32x16 sacc[5];
#pragma unroll
    for (int k5 = 0; k5 < 5; ++k5) { int kp = 64 * (n - 1) + 32 * (qt + k5) + c31; kp = kp < 0 ? 0 : (kp > L - 1 ? L - 1 : kp);
        const bf16* kptr = PY + (size_t)(row0 + (kp << dsh)) * PXW + 640 + h * 64 + 8 * hh; f32x16 a = {};
#pragma unroll
        for (int ks = 0; ks < 4; ++ks) a = mfma32(*(const GAS bf16x8*)(kptr + 16 * ks), qf[ks], a);
        sacc[k5] = a; }
    const LAS float* bt = btab + (b * 6 + h) * BT_STRIDE + 32 - qi;
    const float SC = 0.125f * LOG2E; float m = -3.0e38f;
#pragma unroll
    for (int k5 = 0; k5 < 5; ++k5)
#pragma unroll
        for (int i = 0; i < 16; ++i) { const int j = 32 * (qt + k5) + crow(i, hh); const int rel = j - 64 - qi, kp = 64 * (n - 1) + j;
            const bool valid = (rel >= -64) && (rel <= 64) && (kp >= 0) && (kp < L);
            float t = sacc[k5][i] * SC + bt[j]; t = valid ? t : -1.0e30f; sacc[k5][i] = t; m = fmaxf(m, t); }
    m = fmaxf(m, __shfl_xor(m, 32)); float lsum = 0.f;
#pragma unroll
    for (int k5 = 0; k5 < 5; ++k5)
#pragma unroll
        for (int i = 0; i < 16; ++i) { const float p = exp2f(sacc[k5][i] - m); sacc[k5][i] = p; lsum += p; }
    lsum += __shfl_xor(lsum, 32); const float inv = 1.0f / lsum;
    f32x16 o[2] = {};
#pragma unroll
    for (int k5 = 0; k5 < 5; ++k5) { int kp = 64 * (n - 1) + 32 * (qt + k5) + c31; kp = kp < 0 ? 0 : (kp > L - 1 ? L - 1 : kp);
        const bf16* vptr = PY + (size_t)(row0 + (kp << dsh)) * PXW + 1024 + h * 64 + 8 * hh; bf16x8 vf[4];
#pragma unroll
        for (int ks = 0; ks < 4; ++ks) vf[ks] = *(const GAS bf16x8*)(vptr + 16 * ks);
#pragma unroll
        for (int i = 0; i < 16; ++i) sacc[k5][i] *= inv;
#pragma unroll
        for (int dt = 0; dt < 2; ++dt) { f32x16 vt = {}; vt = mfma32(vf[2 * dt], idf[0], vt); vt = mfma32(vf[2 * dt + 1], idf[1], vt);
#pragma unroll
            for (int s2 = 0; s2 < 2; ++s2) o[dt] = mfma32(pack8(sacc[k5], s2), pack8(vt, s2), o[dt]); } }
    bf16* OB = WSP(bf16, WS_OB) + (size_t)b * MH * RW; float* LSE = WSP(float, WS_LSE) + (size_t)b * MH * NH;
#pragma unroll
    for (int dt = 0; dt < 2; ++dt)
#pragma unroll
        for (int i = 0; i < 16; ++i) { const int orow = row0 + ((64 * n + 32 * qt + crow(i, hh)) << dsh); OB[(size_t)orow * RW + h * 64 + 32 * dt + c31] = (bf16)f2bf(o[dt][i]); }
    if (hh == 0) LSE[(size_t)qrow * NH + h] = (m + log2f(lsum)) * LN2;
}
__device__ __forceinline__ void phase_pool_attn(KARG, Frame& F, int hf, int l) {
    for (int t = F.vcu; t < MH / 32; t += F.G) pool_tile(KA, F, hf, l, t);
    __syncthreads();
    LAS float* bt = (LAS float*)(F.lds + RING_OFF);
    attn_bias_table(KA, F, bt);
    __syncthreads();
    const int gw = F.vcu * NWAVES + F.wave, NGW = F.G * NWAVES;
    for (int u = gw; u < 9216; u += NGW) attn_unit(F, hf, u, bt);
}
__device__ __forceinline__ void phase_attn_merge(Frame& F) {
    const bf16* OB = WSP(bf16, WS_OB); const float* LSE = WSP(float, WS_LSE); bf16* MIX = WSP(bf16, WS_MIX);
    const int gt = F.vcu * 512 + F.tid, NT = F.G * 512;
    for (int it = gt; it < MH * 48; it += NT) { const int row = it / 48, cg = it % 48, h = cg >> 3;
        float ls[3], mx = -3.0e38f;
#pragma unroll
        for (int b = 0; b < 3; ++b) { ls[b] = LSE[((size_t)b * MH + row) * NH + h]; mx = fmaxf(mx, ls[b]); }
        float al[3], sum = 0.f;
#pragma unroll
        for (int b = 0; b < 3; ++b) { al[b] = __expf(ls[b] - mx); sum += al[b]; }
        const float inv = 1.0f / sum; float acc[8];
#pragma unroll
        for (int e = 0; e < 8; ++e) acc[e] = 0.f;
#pragma unroll
        for (int b = 0; b < 3; ++b) { const v4u w = *(const GAS v4u*)(OB + ((size_t)b * MH + row) * RW + cg * 8); const float a = al[b] * inv;
            acc[0] += a * bflo(w.x); acc[1] += a * bfhi(w.x); acc[2] += a * bflo(w.y); acc[3] += a * bfhi(w.y); acc[4] += a * bflo(w.z); acc[5] += a * bfhi(w.z); acc[6] += a * bflo(w.w); acc[7] += a * bfhi(w.w); }
        v4u o; o.x = pk2(acc[0], acc[1]); o.y = pk2(acc[2], acc[3]); o.z = pk2(acc[4], acc[5]); o.w = pk2(acc[6], acc[7]);
        *(GAS v4u*)(MIX + (size_t)row * D + 640 + cg * 8) = o; }
}
constexpr int LB = 72;
constexpr int LF = 65;
__device__ __forceinline__ float ldsbf(const LAS bf16* p) { return bf2f((unsigned)*p); }
__device__ __forceinline__ void passA_unit(KARG, Frame& F, int hf, int l, int unit) {
    const int tid = F.tid, t = tid >> 3, cg = tid & 7, c0 = cg * 8;
    const int ci = unit / 6, h = unit % 6; const int rr0 = ci * 64; const int T = hf ? 16384 : 8192; const int sbase = hf ? 0 : (rr0 & ~8191);
    const int tl = rr0 - sbase + t;
    const bf16* PX = WSP(bf16, WS_PX);
    LAS bf16* mAt = (LAS bf16*)(F.lds + RING_OFF); LAS bf16* mBt = mAt + 64 * LB; LAS bf16* mKt = mBt + 64 * LB; LAS bf16* mRt = mKt + 64 * LB; LAS bf16* mV = mRt + 64 * LB;
    LAS bf16* mLak = mV + 64 * LB; LAS bf16* mLrb = mLak + 64 * LB; LAS bf16* mLrk = mLrb + 64 * LB;
    LAS float* fA = (LAS float*)(F.lds + RING_OFF + 73728);
    LAS float* fB = fA + 64 * LF;
    LAS float* fC = fB + 64 * LF;
    LAS float* sDC = fC + 64 * LF;
    float cr[8], ck[8], cv[8];
    { const float* cw = KA.in[I_CONV] + (size_t)l * 3 * 1152;
#pragma unroll
      for (int e = 0; e < 8; ++e) { cr[e] = 0.f; ck[e] = 0.f; cv[e] = 0.f; }
#pragma unroll
      for (int tap = 0; tap < 3; ++tap) { const int tq = tl + tap - 1; if (tq >= 0 && tq < T) { const bf16* row = PX + (size_t)(sbase + tq) * PXW + h * 64 + c0;
          const v4u wr_ = *(const GAS v4u*)(row), wk_ = *(const GAS v4u*)(row + 384), wv_ = *(const GAS v4u*)(row + 768); const float* w = cw + tap * 1152 + h * 64 + c0;
          const unsigned ur[4] = {wr_.x, wr_.y, wr_.z, wr_.w}, uk[4] = {wk_.x, wk_.y, wk_.z, wk_.w}, uv[4] = {wv_.x, wv_.y, wv_.z, wv_.w};
#pragma unroll
          for (int e = 0; e < 8; ++e) { const float xr = (e & 1) ? bfhi(ur[e >> 1]) : bflo(ur[e >> 1]), xk = (e & 1) ? bfhi(uk[e >> 1]) : bflo(uk[e >> 1]), xv = (e & 1) ? bfhi(uv[e >> 1]) : bflo(uv[e >> 1]);
              cr[e] += xr * w[e]; ck[e] += xk * w[384 + e]; cv[e] += xv * w[768 + e]; } } } }
    float kkv[8];
    { float ss = 0.f; const float* kkw = KA.in[I_KK] + l * RW + h * 64 + c0;
#pragma unroll
      for (int e = 0; e < 8; ++e) { kkv[e] = ck[e] * kkw[e]; ss += kkv[e] * kkv[e]; }
      ss += __shfl_xor(ss, 1); ss += __shfl_xor(ss, 2); ss += __shfl_xor(ss, 4);
      const float inv = 1.0f / fmaxf(sqrtf(ss), 1e-12f);
#pragma unroll
      for (int e = 0; e < 8; ++e) kkv[e] *= inv; }
    float bonus = 0.f;
    for (int d = 0; d < 2; ++d) {
        const int tau = d ? 63 - t : t; const size_t inst = ((size_t)ci * 6 + h) * 2 + d;
        __syncthreads();
        { const bf16* row = PX + (size_t)(rr0 + t) * PXW + 1152 + c0; const v4u ww = *(const GAS v4u*)(row), wa = *(const GAS v4u*)(row + 64);
          const unsigned uw[4] = {ww.x, ww.y, ww.z, ww.w}, ua[4] = {wa.x, wa.y, wa.z, wa.w};
#pragma unroll
          for (int e = 0; e < 8; ++e) { fA[t * LF + c0 + e] = tanhf((e & 1) ? bfhi(uw[e >> 1]) : bflo(uw[e >> 1])); fB[t * LF + c0 + e] = (e & 1) ? bfhi(ua[e >> 1]) : bflo(ua[e >> 1]); } }
        __syncthreads();
        float w_[8], ic[8];
        { const float* w0 = KA.in[I_DW0] + (size_t)(l * 2 + d) * RW + h * 64 + c0; const float* a0 = KA.in[I_IA0] + (size_t)(l * 2 + d) * RW + h * 64 + c0;
          const float* du = KA.in[I_DUP] + (size_t)(l * 2 + d) * 64 * RW + h * 64 + c0; const float* iu = KA.in[I_IUP] + (size_t)(l * 2 + d) * 64 * RW + h * 64 + c0;
#pragma unroll
          for (int e = 0; e < 8; ++e) { w_[e] = w0[e]; ic[e] = a0[e]; }
          for (int r = 0; r < 64; ++r) { const float aw = fA[t * LF + r], aa = fB[t * LF + r]; const f32x4 d0 = *(const GAS f32x4*)(du + (size_t)r * RW), d1 = *(const GAS f32x4*)(du + (size_t)r * RW + 4), i0 = *(const GAS f32x4*)(iu + (size_t)r * RW), i1 = *(const GAS f32x4*)(iu + (size_t)r * RW + 4);
#pragma unroll
              for (int e = 0; e < 4; ++e) { w_[e] += aw * d0[e]; w_[4 + e] += aw * d1[e]; ic[e] += aa * i0[e]; ic[4 + e] += aa * i1[e]; } } }
        float logd[8];
#pragma unroll
        for (int e = 0; e < 8; ++e) { logd[e] = -0.6065306597126334f * sigmoidf_(w_[e]); ic[e] = sigmoidf_(ic[e]); fC[tau * LF + c0 + e] = logd[e]; }
        __syncthreads();
        if (tid < 64) { float cum = 0.f; for (int q = 0; q < 64; ++q) { cum += fC[q * LF + tid]; fC[q * LF + tid] = cum; } }
        __syncthreads();
        { const float* ka = KA.in[I_KA] + l * RW + h * 64 + c0; const float* brk = KA.in[I_BRK] + l * RW + h * 64 + c0;
          float at[8], bt_[8], kt[8], rt[8]; float bs = 0.f;
#pragma unroll
          for (int e = 0; e < 8; ++e) { const float cum = fC[tau * LF + c0 + e], cumx = cum - logd[e]; const float keff = ck[e] * (1.0f + (ic[e] - 1.0f) * ka[e]);
              bs += cr[e] * keff * brk[e];
              const float en = __expf(-cum);
              at[e] = -kkv[e] * __expf(cumx); bt_[e] = kkv[e] * ic[e] * en; kt[e] = keff * en; rt[e] = cr[e] * __expf(cum); }
          bs += __shfl_xor(bs, 1); bs += __shfl_xor(bs, 2); bs += __shfl_xor(bs, 4); bonus += bs;
          v4u o;
          o.x = pk2(at[0], at[1]); o.y = pk2(at[2], at[3]); o.z = pk2(at[4], at[5]); o.w = pk2(at[6], at[7]); *(LAS v4u*)(mAt + tau * LB + c0) = o;
          o.x = pk2(bt_[0], bt_[1]); o.y = pk2(bt_[2], bt_[3]); o.z = pk2(bt_[4], bt_[5]); o.w = pk2(bt_[6], bt_[7]); *(LAS v4u*)(mBt + tau * LB + c0) = o;
          o.x = pk2(kt[0], kt[1]); o.y = pk2(kt[2], kt[3]); o.z = pk2(kt[4], kt[5]); o.w = pk2(kt[6], kt[7]); *(LAS v4u*)(mKt + tau * LB + c0) = o;
          o.x = pk2(rt[0], rt[1]); o.y = pk2(rt[2], rt[3]); o.z = pk2(rt[4], rt[5]); o.w = pk2(rt[6], rt[7]); *(LAS v4u*)(mRt + tau * LB + c0) = o;
          o.x = pk2(cv[0], cv[1]); o.y = pk2(cv[2], cv[3]); o.z = pk2(cv[4], cv[5]); o.w = pk2(cv[6], cv[7]); *(LAS v4u*)(mV + tau * LB + c0) = o;
          if (t == 0) {
#pragma unroll
              for (int e = 0; e < 8; ++e) { const float dc = __expf(fC[63 * LF + c0 + e]); sDC[c0 + e] = dc; WSP(float, WS_DC)[inst * 64 + c0 + e] = dc; } } }
        __syncthreads();
        const int i = t;
        { float a1[8], a2[8], a3[8], a4[8];
#pragma unroll
          for (int e = 0; e < 8; ++e) { a1[e] = 0.f; a2[e] = 0.f; a3[e] = 0.f; a4[e] = 0.f; }
          for (int c = 0; c < 64; ++c) { const float xa = ldsbf(mAt + i * LB + c), xr = ldsbf(mRt + i * LB + c);
#pragma unroll
              for (int e = 0; e < 8; ++e) { const float yb = ldsbf(mBt + (c0 + e) * LB + c), yk = ldsbf(mKt + (c0 + e) * LB + c); a1[e] += xa * yb; a2[e] += xa * yk; a3[e] += xr * yb; a4[e] += xr * yk; } }
          __syncthreads();
#pragma unroll
          for (int e = 0; e < 8; ++e) { const int j = c0 + e; fA[i * LF + j] = (j < i) ? a1[e] : 0.f;
              mLak[i * LB + j] = (bf16)f2bf((j < i) ? a2[e] : 0.f); mLrb[i * LB + j] = (bf16)f2bf((j <= i) ? a3[e] : 0.f); mLrk[i * LB + j] = (bf16)f2bf((j <= i) ? a4[e] : 0.f); } }
        __syncthreads();
        if (tid < 64) { const int r_ = tid;
            for (int j = 63; j >= 0; --j) { float acc = (j == r_) ? 1.f : 0.f; for (int s = j + 1; s <= r_; ++s) acc += fB[r_ * LF + s] * fA[s * LF + j]; fB[r_ * LF + j] = (j <= r_) ? acc : 0.f; } }
        __syncthreads();
        float x1[8], wv[8], u0[8];
#pragma unroll
        for (int e = 0; e < 8; ++e) { x1[e] = 0.f; wv[e] = 0.f; u0[e] = 0.f; }
        for (int s = 0; s < 64; ++s) { const float la = ldsbf(mLak + i * LB + s), tt_ = fB[i * LF + s];
#pragma unroll
            for (int e = 0; e < 8; ++e) { x1[e] += la * ldsbf(mV + s * LB + c0 + e); wv[e] += tt_ * ldsbf(mAt + s * LB + c0 + e); } }
        __syncthreads();
#pragma unroll
        for (int e = 0; e < 8; ++e) { mLak[i * LB + c0 + e] = (bf16)f2bf(x1[e]); mAt[i * LB + c0 + e] = (bf16)f2bf(wv[e]); }
        __syncthreads();
        for (int s = 0; s < 64; ++s) { const float tt_ = fB[i * LF + s];
#pragma unroll
            for (int e = 0; e < 8; ++e) u0[e] += tt_ * ldsbf(mLak + s * LB + c0 + e); }
        __syncthreads();
#pragma unroll
        for (int e = 0; e < 8; ++e) mLak[i * LB + c0 + e] = (bf16)f2bf(u0[e]);
        __syncthreads();
        { float ry[8], y0[8], gp[8], h0[8];
#pragma unroll
          for (int e = 0; e < 8; ++e) { ry[e] = ldsbf(mRt + i * LB + c0 + e); y0[e] = 0.f; gp[e] = 0.f; h0[e] = 0.f; }
          for (int s = 0; s < 64; ++s) { const float lb = ldsbf(mLrb + i * LB + s), lk = ldsbf(mLrk + i * LB + s), bb = ldsbf(mBt + s * LB + i), kb = ldsbf(mKt + s * LB + i);
#pragma unroll
              for (int e = 0; e < 8; ++e) { const float w = ldsbf(mAt + s * LB + c0 + e), u = ldsbf(mLak + s * LB + c0 + e), v = ldsbf(mV + s * LB + c0 + e);
                  ry[e] += lb * w; y0[e] += lb * u + lk * v; gp[e] += bb * w; h0[e] += bb * u + kb * v; } }
          const int treal = d ? 63 - i : i; const float dc = sDC[i];
          v4u o; o.x = pk2(ry[0], ry[1]); o.y = pk2(ry[2], ry[3]); o.z = pk2(ry[4], ry[5]); o.w = pk2(ry[6], ry[7]); *(GAS v4u*)(WSP(bf16, WS_RY) + inst * 4096 + treal * 64 + c0) = o;
          o.x = pk2(y0[0], y0[1]); o.y = pk2(y0[2], y0[3]); o.z = pk2(y0[4], y0[5]); o.w = pk2(y0[6], y0[7]); *(GAS v4u*)(WSP(bf16, WS_Y0) + inst * 4096 + treal * 64 + c0) = o;
          o.x = pk2(gp[0] * dc, gp[1] * dc); o.y = pk2(gp[2] * dc, gp[3] * dc); o.z = pk2(gp[4] * dc, gp[5] * dc); o.w = pk2(gp[6] * dc, gp[7] * dc); *(GAS v4u*)(WSP(bf16, WS_GP) + inst * 4096 + i * 64 + c0) = o;
#pragma unroll
          for (int e = 0; e < 8; ++e) WSP(bf16, WS_H0T)[inst * 4096 + (c0 + e) * 64 + i] = (bf16)f2bf(h0[e] * dc); }
    }
    if (cg == 0) WSP(float, WS_BON)[(size_t)unit * 64 + t] = bonus;
}
__device__ __forceinline__ void phase_passA(KARG, Frame& F, int hf, int l) {
    for (int u = F.vcu; u < (MH / 64) * 6; u += F.G) passA_unit(KA, F, hf, l, u);
}
__device__ __forceinline__ void phase_passB(Frame& F, int hf) {
    const int nchain = hf ? 12 : 24, nck = hf ? 256 : 128;
    const int unit = F.vcu * NWAVES + F.wave;
    const int uu = (F.wave) * F.G + F.vcu;
    if (uu >= nchain * 4) return; (void)unit;
    const int chain = uu >> 2, cgp = uu & 3; const int d = chain & 1, h = (chain >> 1) % 6, s = (chain >> 1) / 6;
    const int lane = F.lane, c16 = lane & 15, q = lane >> 4, v = 16 * cgp + c16;
    f32x4 hacc[4];
#pragma unroll
    for (int m = 0; m < 4; ++m) hacc[m] = (f32x4){0.f, 0.f, 0.f, 0.f};
    const bf16* GP = WSP(bf16, WS_GP); const bf16* H0T = WSP(bf16, WS_H0T); const float* DC = WSP(float, WS_DC); bf16* HC = WSP(bf16, WS_HC);
    v2u ga[4][2][2]; v2u h0[4]; f32x4 dc[4];
#define PB_LOAD(GA, H0_, DC_, STEP) do { const int cl_ = d ? nck - 1 - (STEP) : (STEP); const size_t in_ = ((size_t)(s * nck + cl_) * 6 + h) * 2 + d; \
        _Pragma("unroll") for (int mo = 0; mo < 4; ++mo) { const bf16* gr = GP + in_ * 4096 + (16 * mo + c16) * 64 + 4 * q; \
            _Pragma("unroll") for (int ks = 0; ks < 2; ++ks) { GA[mo][ks][0] = *(const GAS v2u*)(gr + 32 * ks); GA[mo][ks][1] = *(const GAS v2u*)(gr + 32 * ks + 16); } \
            H0_[mo] = *(const GAS v2u*)(H0T + in_ * 4096 + v * 64 + 16 * mo + 4 * q); DC_[mo] = *(const GAS f32x4*)(DC + in_ * 64 + 16 * mo + 4 * q); } } while (0)
    PB_LOAD(ga, h0, dc, 0);
    for (int step = 0; step < nck; ++step) {
        const int cl = d ? nck - 1 - step : step; const size_t inst = ((size_t)(s * nck + cl) * 6 + h) * 2 + d;
        v2u gan[4][2][2]; v2u h0n[4]; f32x4 dcn[4];
        { const int sn = (step + 1 < nck) ? step + 1 : step; PB_LOAD(gan, h0n, dcn, sn); }
        v2u hb[4];
#pragma unroll
        for (int m = 0; m < 4; ++m) { hb[m].x = cvtpk(hacc[m][0], hacc[m][1]); hb[m].y = cvtpk(hacc[m][2], hacc[m][3]); *(GAS v2u*)(HC + inst * 4096 + v * 64 + 16 * m + 4 * q) = hb[m]; }
        bf16x8 bfr[2];
#pragma unroll
        for (int ks = 0; ks < 2; ++ks) { v4u t4; t4.x = hb[2 * ks].x; t4.y = hb[2 * ks].y; t4.z = hb[2 * ks + 1].x; t4.w = hb[2 * ks + 1].y; bfr[ks] = __builtin_bit_cast(bf16x8, t4); }
#pragma unroll
        for (int mo = 0; mo < 4; ++mo) { f32x4 cin;
            cin[0] = dc[mo][0] * hacc[mo][0] + bflo(h0[mo].x); cin[1] = dc[mo][1] * hacc[mo][1] + bfhi(h0[mo].x); cin[2] = dc[mo][2] * hacc[mo][2] + bflo(h0[mo].y); cin[3] = dc[mo][3] * hacc[mo][3] + bfhi(h0[mo].y);
#pragma unroll
            for (int ks = 0; ks < 2; ++ks) { v4u a4; a4.x = ga[mo][ks][0].x; a4.y = ga[mo][ks][0].y; a4.z = ga[mo][ks][1].x; a4.w = ga[mo][ks][1].y; cin = mfma16(__builtin_bit_cast(bf16x8, a4), bfr[ks], cin); }
            hacc[mo] = cin; }
#pragma unroll
        for (int mo = 0; mo < 4; ++mo) { h0[mo] = h0n[mo]; dc[mo] = dcn[mo];
#pragma unroll
            for (int ks = 0; ks < 2; ++ks) { ga[mo][ks][0] = gan[mo][ks][0]; ga[mo][ks][1] = gan[mo][ks][1]; } }
    }
#undef PB_LOAD
}
__device__ __forceinline__ void passC_unit(KARG, Frame& F, int hf, int l, int unit) {
    const int lane = F.lane, c31 = lane & 31, hh = lane >> 5; const int ci = unit / 6, h = unit % 6; const int rr0 = ci * 64;
    const int T = hf ? 16384 : 8192; const int sbase = hf ? 0 : (rr0 & ~8191);
    const bf16* PX = WSP(bf16, WS_PX); const bf16* RY = WSP(bf16, WS_RY); const bf16* Y0 = WSP(bf16, WS_Y0); const bf16* HC = WSP(bf16, WS_HC);
    f32x16 acc[2][2];
#pragma unroll
    for (int mt = 0; mt < 2; ++mt)
#pragma unroll
        for (int nt = 0; nt < 2; ++nt) { f32x16 a;
#pragma unroll
            for (int g = 0; g < 4; ++g) { float s4[4] = {0.f, 0.f, 0.f, 0.f};
#pragma unroll
                for (int d = 0; d < 2; ++d) { const size_t inst = ((size_t)ci * 6 + h) * 2 + d; const v2u w = *(const GAS v2u*)(Y0 + inst * 4096 + (32 * nt + c31) * 64 + 32 * mt + 8 * g + 4 * hh);
                    s4[0] += bflo(w.x); s4[1] += bfhi(w.x); s4[2] += bflo(w.y); s4[3] += bfhi(w.y); }
                a[4 * g] = s4[0]; a[4 * g + 1] = s4[1]; a[4 * g + 2] = s4[2]; a[4 * g + 3] = s4[3]; }
            acc[mt][nt] = a; }
#pragma unroll
    for (int d = 0; d < 2; ++d) { const size_t inst = ((size_t)ci * 6 + h) * 2 + d;
#pragma unroll
        for (int ks = 0; ks < 4; ++ks) { bf16x8 af[2], bf_[2];
#pragma unroll
            for (int x = 0; x < 2; ++x) { af[x] = *(const GAS bf16x8*)(HC + inst * 4096 + (32 * x + c31) * 64 + 16 * ks + 8 * hh); bf_[x] = *(const GAS bf16x8*)(RY + inst * 4096 + (32 * x + c31) * 64 + 16 * ks + 8 * hh); }
#pragma unroll
            for (int mt = 0; mt < 2; ++mt)
#pragma unroll
                for (int nt = 0; nt < 2; ++nt) acc[mt][nt] = mfma32(af[mt], bf_[nt], acc[mt][nt]); } }
    f32x16 gacc[2][2] = {};
    { const bf16* GUT = WSP(bf16, WS_SMALL) + (size_t)l * RW * 128;
#pragma unroll
      for (int ks = 0; ks < 8; ++ks) { bf16x8 af[2], bf_[2];
#pragma unroll
          for (int x = 0; x < 2; ++x) { af[x] = *(const GAS bf16x8*)(GUT + (size_t)(h * 64 + 32 * x + c31) * 128 + 16 * ks + 8 * hh);
              const v4u w = *(const GAS v4u*)(PX + (size_t)(rr0 + 32 * x + c31) * PXW + 1280 + 16 * ks + 8 * hh); v4u o;
              o.x = cvtpk(sigmoidf_(bflo(w.x)), sigmoidf_(bfhi(w.x))); o.y = cvtpk(sigmoidf_(bflo(w.y)), sigmoidf_(bfhi(w.y))); o.z = cvtpk(sigmoidf_(bflo(w.z)), sigmoidf_(bfhi(w.z))); o.w = cvtpk(sigmoidf_(bflo(w.w)), sigmoidf_(bfhi(w.w)));
              bf_[x] = __builtin_bit_cast(bf16x8, o); }
#pragma unroll
          for (int mt = 0; mt < 2; ++mt)
#pragma unroll
              for (int nt = 0; nt < 2; ++nt) gacc[mt][nt] = mfma32(af[mt], bf_[nt], gacc[mt][nt]); } }
    const float* gng = KA.in[I_GNG] + l * RW + h * 64; const float* gnb = KA.in[I_GNB] + l * RW + h * 64; const float* cw = KA.in[I_CONV] + (size_t)l * 3 * 1152 + 768 + h * 64;
    bf16* MIX = WSP(bf16, WS_MIX);
#pragma unroll
    for (int nt = 0; nt < 2; ++nt) { const int t = 32 * nt + c31; const int tl = rr0 - sbase + t;
        float s1 = 0.f;
#pragma unroll
        for (int mt = 0; mt < 2; ++mt)
#pragma unroll
            for (int i = 0; i < 16; ++i) s1 += acc[mt][nt][i];
        s1 += __shfl_xor(s1, 32); const float mu = s1 * (1.0f / 64.0f); float s2 = 0.f;
#pragma unroll
        for (int mt = 0; mt < 2; ++mt)
#pragma unroll
            for (int i = 0; i < 16; ++i) { const float dlt = acc[mt][nt][i] - mu; s2 += dlt * dlt; }
        s2 += __shfl_xor(s2, 32); const float rstd = 1.0f / sqrtf(s2 * (1.0f / 64.0f) + GN_EPS);
        const float bon = WSP(float, WS_BON)[(size_t)unit * 64 + t];
#pragma unroll
        for (int mt = 0; mt < 2; ++mt)
#pragma unroll
            for (int g = 0; g < 4; ++g) { const int j0 = 32 * mt + 8 * g + 4 * hh; float vv[4] = {0.f, 0.f, 0.f, 0.f};
#pragma unroll
                for (int tap = 0; tap < 3; ++tap) { const int tq = tl + tap - 1; if (tq >= 0 && tq < T) { const v2u w = *(const GAS v2u*)(PX + (size_t)(sbase + tq) * PXW + 768 + h * 64 + j0); const f32x4 cwv = *(const GAS f32x4*)(cw + tap * 1152 + j0);
                    vv[0] += bflo(w.x) * cwv[0]; vv[1] += bfhi(w.x) * cwv[1]; vv[2] += bflo(w.y) * cwv[2]; vv[3] += bfhi(w.y) * cwv[3]; } }
                const f32x4 gg = *(const GAS f32x4*)(gng + j0), gb = *(const GAS f32x4*)(gnb + j0); float o4[4];
#pragma unroll
                for (int e = 0; e < 4; ++e) { const float y = (acc[mt][nt][4 * g + e] - mu) * rstd * gg[e] + gb[e] + bon * vv[e]; o4[e] = y * gacc[mt][nt][4 * g + e]; }
                v2u o; o.x = pk2(o4[0], o4[1]); o.y = pk2(o4[2], o4[3]); *(GAS v2u*)(MIX + (size_t)(rr0 + t) * D + 256 + h * 64 + j0) = o; } }
}
__device__ __forceinline__ void phase_passC(KARG, Frame& F, int hf, int l) {
    const int gw = F.vcu * NWAVES + F.wave, NGW = F.G * NWAVES;
    for (int u = gw; u < (MH / 64) * 6; u += NGW) passC_unit(KA, F, hf, l, u);
}
constexpr int NPHASE = 47;
__global__ void __launch_bounds__(NWAVES * 64, 2) mega_fwd(Args args) {
    const Args& KA = args;
    extern __shared__ __attribute__((aligned(16))) unsigned char lds[];
    Frame F;
    F.lds = (LAS unsigned char*)lds; F.MISC = (volatile LAS unsigned*)(F.lds + MISC_OFF);
    F.tid = threadIdx.x; F.lane = F.tid & 63; F.wave = __builtin_amdgcn_readfirstlane(F.tid >> 6);
    F.G = gridDim.x; { const int bx = blockIdx.x; F.vcu = (F.G % 8 == 0) ? (bx % 8) * (F.G / 8) + bx / 8 : bx; }
    F.ws = args.ws; F.ctl = (gu32*)(args.ws + WS_CTL); F.out = args.out;
    for (int u = F.tid; u < (LDS_BYTES - LDSCTL_OFF) / 4; u += NWAVES * 64) ((LAS unsigned*)(F.lds + LDSCTL_OFF))[u] = 0u;
    __syncthreads();
    XcdBarrier bar; bar.bar = (unsigned*)(F.ctl + CW_BAR) + args.li * XCD_BAR_WORDS; bar.x = 0; bar.st = nullptr;
    const bool multi = (args.ph_hi - args.ph_lo) > 1;
    if (multi) bar = xcd_barrier_post((unsigned*)(F.ctl + CW_BAR) + args.li * XCD_BAR_WORDS, F.MISC + 8);
    for (int p = args.ph_lo; p < args.ph_hi; ++p) {
        { int tv = threadIdx.x; asm volatile("" : "+v"(tv)); F.tid = tv; F.lane = tv & 63; F.wave = __builtin_amdgcn_readfirstlane(tv >> 6); }
        if (p == 0) { if ((PHM >> 11) & 1) phase_weights(args, F); }
        else {
            const int qq = p - 1, hf = qq / 23, r = qq % 23;
            if (r == 0) { if ((PHM >> 12) & 1) phase_xn_init(args, F, hf); }
            else {
                const int l = (r - 1) / 11, k = (r - 1) % 11;
                unsigned char* wl = F.ws + WS_W + (size_t)l * W_LAYER;
                switch (k) {
                case 0: if ((PHM >> 0) & 1) { pg8::Gemm g{WSP(bf16, WS_XN), (const bf16*)(wl + W_IN), MH, NIN, D}; pg8::StaticOrder S; S.init(MH, NIN, F.G, (int)blockIdx.x);
                          pg8::EpiRoute E{WSP(bf16, WS_PY), WSP(bf16, WS_PX)}; pg8::gemm_phase<pg8::EpiRoute, pg8::StaticOrder, true, true>(F.lds + RING_OFF, g, S, E, F.tid); } break;
                case 1: if ((PHM >> 1) & 1) phase_pool_attn(args, F, hf, l); break;
                case 2: if ((PHM >> 2) & 1) phase_attn_merge(F); break;
                case 3: if ((PHM >> 3) & 1) phase_passA(args, F, hf, l); break;
                case 4: if ((PHM >> 4) & 1) phase_passB(F, hf); break;
                case 5: if ((PHM >> 5) & 1) phase_passC(args, F, hf, l); break;
                case 6: if ((PHM >> 6) & 1) { pg8::Gemm g{WSP(bf16, WS_MIX), (const bf16*)(wl + W_OUT), MH, D, D}; pg8::StaticOrder S; S.init(MH, D, F.G, (int)blockIdx.x);
                          pg8::EpiBf16<0> E{WSP(bf16, WS_F1), D}; pg8::gemm_phase<pg8::EpiBf16<0>, pg8::StaticOrder, true, true>(F.lds + RING_OFF, g, S, E, F.tid); } break;
                case 7: if ((PHM >> 7) & 1) { const float* base = (l == 0) ? KA.in[hf ? I_XS : I_XP] : (F.out + (size_t)hf * MH * D);
                          phase_rowpass(args, F, hf, WSP(bf16, WS_F1), base, KA.in[I_NMPOST] + l * D, KA.in[I_NFPRE] + l * D); } break;
                case 8: if ((PHM >> 8) & 1) { pg8::Gemm g{WSP(bf16, WS_XN), (const bf16*)(wl + W_FFI), MH, FF, D}; pg8::StaticOrder S; S.init(MH, FF, F.G, (int)blockIdx.x);
                          pg8::EpiBf16<2> E{WSP(bf16, WS_H), FF}; pg8::gemm_phase<pg8::EpiBf16<2>, pg8::StaticOrder, true, true>(F.lds + RING_OFF, g, S, E, F.tid); } break;
                case 9: if ((PHM >> 9) & 1) { pg8::Gemm g{WSP(bf16, WS_H), (const bf16*)(wl + W_FFO), MH, D, FF}; pg8::StaticOrder S; S.init(MH, D, F.G, (int)blockIdx.x);
                          pg8::EpiBf16<0> E{WSP(bf16, WS_XN), D}; pg8::gemm_phase<pg8::EpiBf16<0>, pg8::StaticOrder, true, true>(F.lds + RING_OFF, g, S, E, F.tid); } break;
                default: if ((PHM >> 10) & 1) { phase_rowpass(args, F, hf, WSP(bf16, WS_XN), F.out + (size_t)hf * MH * D, KA.in[I_NFPOST] + l * D, (l == 0) ? (KA.in[I_NMPRE] + D) : nullptr); } break;
                }
            }
        }
        if (p + 1 < args.ph_hi) xcd_barrier(bar);
    }
}

extern "C" void kernel_launch(void* const* d_in, const int* in_sizes, int n_in, void* d_out, int out_size, void* d_ws, size_t ws_size, hipStream_t stream) {
    static int grid = 0;
    if (grid == 0) {
        if (n_in != 24 || out_size != 2 * MH * D || ws_size < WS_END) { fprintf(stderr, "kernel_launch: unexpected problem shape (n_in %d out %d ws %zu)\n", n_in, out_size, ws_size); grid = -1; return; }
        int dev = 0, cus = 0;
        if (hipGetDevice(&dev) != hipSuccess || hipDeviceGetAttribute(&cus, hipDeviceAttributeMultiprocessorCount, dev) != hipSuccess) { grid = -1; return; }
        if (hipFuncSetAttribute((const void*)mega_fwd, hipFuncAttributeMaxDynamicSharedMemorySize, LDS_BYTES) != hipSuccess) { fprintf(stderr, "kernel_launch: hipFuncSetAttribute failed\n"); grid = -1; return; }
        int per_cu = 0; (void)hipOccupancyMaxActiveBlocksPerMultiprocessor(&per_cu, (const void*)mega_fwd, NWAVES * 64, LDS_BYTES); (void)hipGetLastError();
        grid = cus;
    }
    if (grid < 0) return;
    (void)hipMemsetAsync((char*)d_ws + WS_CTL, 0, CTL_ZERO_BYTES, stream);
    Args a{};
    for (int i = 0; i < 24; ++i) a.in[i] = (const float*)d_in[i];
    a.out = (float*)d_out; a.ws = (unsigned char*)d_ws;
#if MK_N_LAUNCHES == 1
    a.ph_lo = 0; a.ph_hi = NPHASE; a.li = 0;
    hipLaunchKernelGGL(mega_fwd, dim3(grid), dim3(NWAVES * 64), LDS_BYTES, stream, a);
#else
    for (int p = 0; p < NPHASE; ++p) { a.ph_lo = p; a.ph_hi = p + 1; a.li = 0; hipLaunchKernelGGL(mega_fwd, dim3(grid), dim3(NWAVES * 64), LDS_BYTES, stream, a); }
#endif
}
```

```cpp
#include <hip/hip_runtime.h>
#include <cstdio>
#include <cstdint>
#ifndef REPK
#define REPK -1
#endif
#ifndef PHM
#define PHM 0xFFFF
#endif
#ifndef MK_N_LAUNCHES
#define MK_N_LAUNCHES 1
#endif
namespace pg8 {
#define PG8_LAS __attribute__((address_space(3)))
typedef unsigned short bf16_t;
typedef short bf16x8 __attribute__((ext_vector_type(8)));
typedef float f32x4 __attribute__((ext_vector_type(4)));
typedef unsigned u32x4 __attribute__((ext_vector_type(4)));
constexpr int BM = 256, BK = 64, HALF = 128, HTB = HALF * BK * 2  , STAGE_BYTES = 8 * HTB, NXCD = 8, WGM = 8;

__host__ __device__ __forceinline__ int lds_byte(int r, int c) { const int st = (r >> 4) * 2 + (c >> 5), rr = r & 15, cc = c & 31, ob = rr * 64 + cc * 2; return st * 1024 + (ob ^ (((ob >> 9) & 1) << 5)); }
__host__ __device__ __forceinline__ void stage_rc(int b, int& R, int& C) { const int st = b / 1024, sb = b % 1024, swz = sb ^ (((sb >> 9) & 1) << 5); R = (st >> 1) * 16 + swz / 64; C = (st & 1) * 32 + (swz % 64) / 2; }
__host__ __device__ __forceinline__ int perm32(int rho) { const int n = rho >> 4, i = rho & 15; return 8 * (i >> 2) + 4 * n + (i & 3); }

struct Unit { int pm, pn; };
struct Gemm { const bf16_t* A; const bf16_t* Bt; int M, N, K; };

struct StaticOrder {
    int nM, nN, nwg, G, c;
    __host__ __device__ void init(int M, int N, int G_, int c_) { nM = M / BM; nN = N / BM; nwg = nM * nN; G = G_; c = c_; }
    __host__ __device__ bool next(int i, Unit& u) const {
        const long L = (long)i * G + c; if (L >= nwg) return false;
        int wgid = (int)L; { const int q = nwg / NXCD, r = nwg % NXCD, xcd = wgid % NXCD, off = wgid / NXCD; wgid = (xcd < r ? xcd * (q + 1) : r * (q + 1) + (xcd - r) * q) + off; }
        const int nig = WGM * nN, gid = wgid / nig, fm = gid * WGM, gsz = (nM - fm) < WGM ? (nM - fm) : WGM;
        u.pm = fm + ((wgid % nig) % gsz); u.pn = (wgid % nig) / gsz; return true;
    }
    __device__ __forceinline__ void a_ready(const Unit&) const {}
    __device__ __forceinline__ void done(const Unit&) const {}
};

__device__ __forceinline__ unsigned cvt_pk_bf16(float lo, float hi) { unsigned r; asm volatile("v_cvt_pk_bf16_f32 %0, %1, %2" : "=v"(r) : "v"(lo), "v"(hi)); return r; }
template <int ACT> struct EpiBf16 {
    static constexpr bool PERM = true, AFTER_DRAIN = false;
    bf16_t* O; int ldc;
    __device__ __forceinline__ void operator()(const f32x4 (&acc)[2][2][4][2], const Unit& u, int wr, int wc, int fr, int fq) const {
        const int row0 = u.pm * BM + wr * 64 + fr; const int col0 = u.pn * BM + wc * 32 + 8 * fq;
#pragma unroll
        for (int ai = 0; ai < 2; ++ai)
#pragma unroll
            for (int m = 0; m < 4; ++m) { bf16_t* rowp = O + (size_t)(row0 + ai * HALF + m * 16) * ldc + col0;
#pragma unroll
                for (int bj = 0; bj < 2; ++bj) { f32x4 v0 = acc[ai][bj][m][0], v1 = acc[ai][bj][m][1];
                    if (ACT == 2) {
#pragma unroll
                        for (int e = 0; e < 4; ++e) { float a = fmaxf(v0[e], 0.f), b = fmaxf(v1[e], 0.f); v0[e] = a * a; v1[e] = b * b; } }
                    u32x4 w; w.x = cvt_pk_bf16(v0[0], v0[1]); w.y = cvt_pk_bf16(v0[2], v0[3]); w.z = cvt_pk_bf16(v1[0], v1[1]); w.w = cvt_pk_bf16(v1[2], v1[3]);
                    *(u32x4*)(rowp + bj * HALF) = w; } }
    }
};
struct EpiGen {
    static constexpr bool PERM = true, AFTER_DRAIN = false;
    bf16_t* O0; bf16_t* O1; int split, ld0, ld1, act;
    __device__ __forceinline__ void operator()(const f32x4 (&acc)[2][2][4][2], const Unit& u, int wr, int wc, int fr, int fq) const {
        const int row0 = u.pm * BM + wr * 64 + fr;
#pragma unroll
        for (int bj = 0; bj < 2; ++bj) {
            const int g0 = u.pn * BM + bj * HALF; const bool lo = g0 < split; bf16_t* base = lo ? (O0 + g0) : (O1 + (g0 - split)); const int ld = lo ? ld0 : ld1;
            base += wc * 32 + 8 * fq;
#pragma unroll
            for (int ai = 0; ai < 2; ++ai)
#pragma unroll
                for (int m = 0; m < 4; ++m) { f32x4 v0 = acc[ai][bj][m][0], v1 = acc[ai][bj][m][1];
                    if (act) {
#pragma unroll
                        for (int e = 0; e < 4; ++e) { const float a = fmaxf(v0[e], 0.f), b = fmaxf(v1[e], 0.f); v0[e] = a * a; v1[e] = b * b; } }
                    u32x4 w; w.x = cvt_pk_bf16(v0[0], v0[1]); w.y = cvt_pk_bf16(v0[2], v0[3]); w.z = cvt_pk_bf16(v1[0], v1[1]); w.w = cvt_pk_bf16(v1[2], v1[3]);
                    *(u32x4*)(base + (size_t)(row0 + ai * HALF + m * 16) * ld) = w; } }
    }
};
struct EpiRoute {
    static constexpr bool PERM = true, AFTER_DRAIN = false;
    bf16_t* PY; bf16_t* PX;
    __device__ __forceinline__ void operator()(const f32x4 (&acc)[2][2][4][2], const Unit& u, int wr, int wc, int fr, int fq) const {
        const int row0 = u.pm * BM + wr * 64 + fr;
#pragma unroll
        for (int bj = 0; bj < 2; ++bj) {
            const int g0 = u.pn * BM + bj * HALF; bf16_t* base = (g0 < 1408) ? (PY + g0) : (PX + (g0 - 1408));
            base += wc * 32 + 8 * fq;
#pragma unroll
            for (int ai = 0; ai < 2; ++ai)
#pragma unroll
                for (int m = 0; m < 4; ++m) { const f32x4 v0 = acc[ai][bj][m][0], v1 = acc[ai][bj][m][1];
                    u32x4 w; w.x = cvt_pk_bf16(v0[0], v0[1]); w.y = cvt_pk_bf16(v0[2], v0[3]); w.z = cvt_pk_bf16(v1[0], v1[1]); w.w = cvt_pk_bf16(v1[2], v1[3]);
                    *(u32x4*)(base + (size_t)(row0 + ai * HALF + m * 16) * 1408) = w; } }
    }
};
template <class Epi, class Sched, bool ALIGN_EPI = false, bool SP2 = false>
__device__ __forceinline__ void gemm_phase(PG8_LAS unsigned char* lds, const Gemm g, const Sched& S, const Epi& E, const int tid) {
    const int wid = __builtin_amdgcn_readfirstlane(tid >> 6), lane = tid & 63, wr = wid >> 2, wc = wid & 3, fr = lane & 15, fq = lane >> 4;
    const int K = g.K, nt = K / BK;
    unsigned voffA[2], voffB[2];
#pragma unroll
    for (int i = 0; i < 2; ++i) { int R, C; stage_rc(tid * 16 + i * 8192, R, C); const int Rb = Epi::PERM ? ((R & ~31) + perm32(R & 31)) : R;
        voffA[i] = (unsigned)(R * K + C) * 2u; voffB[i] = (unsigned)(Rb * K + C) * 2u; }
    const size_t kstep = (size_t)(BK * 2);
    const size_t hstep = (size_t)HALF * K * 2;
    const size_t tstep = 2 * hstep;
    const unsigned ldsw = (unsigned)wid * 1024u;
    const int aoff = lds_byte(wr * 64 + fr, fq * 8), boff = lds_byte(wc * 32 + fr, fq * 8);
#define PG8_SA(b, h) (((b) * 2 + (h)) * HTB)
#define PG8_SB(b, h) ((4 + (b) * 2 + (h)) * HTB)
#define PG8_STAGE(bufoff, gbase, voff) do { _Pragma("unroll") for (int _i = 0; _i < 2; ++_i) \
        __builtin_amdgcn_global_load_lds((const unsigned*)((const char*)(gbase) + (voff)[_i]), (PG8_LAS unsigned*)(lds + (bufoff) + ldsw + _i * 8192), 16, 0, 0); } while (0)
#define PG8_LDA(dst, b, h) do { _Pragma("unroll") for (int m = 0; m < 4; ++m) _Pragma("unroll") for (int k = 0; k < 2; ++k) dst[m][k] = *(const PG8_LAS bf16x8*)(lds + PG8_SA(b, h) + aoff + m * 2048 + k * 1024); } while (0)
#define PG8_LDB(dst, b, h) do { _Pragma("unroll") for (int n = 0; n < 2; ++n) _Pragma("unroll") for (int k = 0; k < 2; ++k) dst[n][k] = *(const PG8_LAS bf16x8*)(lds + PG8_SB(b, h) + boff + n * 2048 + k * 1024); } while (0)
#define PG8_MMA(ai, bj, At, Bt) do { __builtin_amdgcn_s_setprio(1); _Pragma("unroll") for (int m = 0; m < 4; ++m) _Pragma("unroll") for (int n = 0; n < 2; ++n) _Pragma("unroll") for (int k = 0; k < 2; ++k) \
        acc[ai][bj][m][n] = __builtin_amdgcn_mfma_f32_16x16x32_bf16(Bt[n][k], At[m][k], acc[ai][bj][m][n], 0, 0, 0); __builtin_amdgcn_s_setprio(0); } while (0)
#define PG8_WAIT_V(n) asm volatile("s_waitcnt vmcnt(" #n ")" ::: "memory")
#define PG8_WAIT_L(n) asm volatile("s_waitcnt lgkmcnt(" #n ")" ::: "memory")
#define PG8_BAR __builtin_amdgcn_s_barrier()
#define PG8_SCHED __builtin_amdgcn_sched_barrier(0)
    Unit cur, nxt; int ui = 0;
    if (!S.next(0, cur)) return;
    f32x4 acc[2][2][4][2];
#pragma unroll
    for (int a = 0; a < 2; ++a)
#pragma unroll
        for (int b = 0; b < 2; ++b)
#pragma unroll
            for (int m = 0; m < 4; ++m)
#pragma unroll
                for (int n = 0; n < 2; ++n) acc[a][b][m][n] = (f32x4){0.f, 0.f, 0.f, 0.f};
    bf16x8 At[4][2], B0[2][2], B1[2][2];
    const char* cA = (const char*)g.A + (size_t)cur.pm * tstep; const char* cB = (const char*)g.Bt + (size_t)cur.pn * tstep;
    S.a_ready(cur);
    if constexpr (SP2) {
        PG8_STAGE(PG8_SB(0, 0), cB, voffB); PG8_STAGE(PG8_SB(0, 1), cB + hstep, voffB); PG8_STAGE(PG8_SA(0, 0), cA, voffA); PG8_STAGE(PG8_SA(0, 1), cA + hstep, voffA);
        if (wr == 1) PG8_BAR;
        PG8_WAIT_V(2); PG8_BAR;
        PG8_STAGE(PG8_SB(1, 0), cB + kstep, voffB); PG8_STAGE(PG8_SA(1, 0), cA + kstep, voffA); PG8_STAGE(PG8_SB(1, 1), cB + hstep + kstep, voffB);
        PG8_WAIT_V(6); PG8_BAR;
    } else {
        PG8_STAGE(PG8_SB(0, 0), cB, voffB); PG8_STAGE(PG8_SA(0, 0), cA, voffA); PG8_STAGE(PG8_SB(0, 1), cB + hstep, voffB); PG8_STAGE(PG8_SA(0, 1), cA + hstep, voffA);
        if (wr == 1) PG8_BAR;
        PG8_WAIT_V(4); PG8_BAR;
        PG8_STAGE(PG8_SB(1, 0), cB + kstep, voffB); PG8_STAGE(PG8_SA(1, 0), cA + kstep, voffA); PG8_STAGE(PG8_SB(1, 1), cB + hstep + kstep, voffB);
        PG8_WAIT_V(6); PG8_BAR;
    }
    for (;;) {
        const bool has_next = S.next(ui + 1, nxt);
        const char* nA = has_next ? (const char*)g.A + (size_t)nxt.pm * tstep : cA; const char* nB = has_next ? (const char*)g.Bt + (size_t)nxt.pn * tstep : cB;
        for (int t = 0; t < nt; t += 2) {
            const bool last = (t == nt - 2);
            const char* a1 = cA + (size_t)(t + 1) * kstep;
            const char* a2 = last ? nA : cA + (size_t)(t + 2) * kstep; const char* b2 = last ? nB : cB + (size_t)(t + 2) * kstep;
            const char* a3 = a2 + kstep; const char* b3 = b2 + kstep;
            if (last && has_next) S.a_ready(nxt);
            if constexpr (SP2) {
            PG8_LDB(B0, 0, 0); PG8_LDB(B1, 0, 1); PG8_SCHED; PG8_LDA(At, 0, 0); PG8_STAGE(PG8_SA(1, 1), a1 + hstep, voffA);
            PG8_WAIT_V(8); PG8_WAIT_L(0); PG8_BAR; PG8_MMA(0, 0, At, B0); PG8_MMA(0, 1, At, B1); PG8_BAR; PG8_SCHED;
            PG8_LDA(At, 0, 1); PG8_STAGE(PG8_SB(0, 0), b2, voffB); PG8_STAGE(PG8_SB(0, 1), b2 + hstep, voffB); PG8_STAGE(PG8_SA(0, 0), a2, voffA);
            PG8_WAIT_V(8); PG8_WAIT_L(0); PG8_BAR; PG8_MMA(1, 0, At, B0); PG8_MMA(1, 1, At, B1); PG8_BAR; PG8_SCHED;
            PG8_LDB(B0, 1, 0); PG8_LDB(B1, 1, 1); PG8_SCHED; PG8_LDA(At, 1, 0); PG8_STAGE(PG8_SA(0, 1), a2 + hstep, voffA);
            PG8_WAIT_V(8); PG8_WAIT_L(0); PG8_BAR; PG8_MMA(0, 0, At, B0); PG8_MMA(0, 1, At, B1); PG8_BAR; PG8_SCHED;
            PG8_LDA(At, 1, 1); PG8_STAGE(PG8_SB(1, 0), b3, voffB); PG8_STAGE(PG8_SB(1, 1), b3 + hstep, voffB); PG8_STAGE(PG8_SA(1, 0), a3, voffA);
            PG8_WAIT_V(8); PG8_WAIT_L(0); PG8_BAR; PG8_MMA(1, 0, At, B0); PG8_MMA(1, 1, At, B1); PG8_BAR; PG8_SCHED;
            } else {
            PG8_LDB(B0, 0, 0); PG8_SCHED; PG8_LDA(At, 0, 0); PG8_STAGE(PG8_SA(1, 1), a1 + hstep, voffA);
            PG8_WAIT_L(8); PG8_BAR; PG8_WAIT_L(0); PG8_MMA(0, 0, At, B0); PG8_BAR; PG8_SCHED;
            PG8_LDB(B1, 0, 1); PG8_STAGE(PG8_SB(0, 0), b2, voffB);
            PG8_BAR; PG8_WAIT_L(0); PG8_MMA(0, 1, At, B1); PG8_BAR;
            PG8_LDA(At, 0, 1); PG8_STAGE(PG8_SA(0, 0), a2, voffA);
            PG8_BAR; PG8_WAIT_L(0); PG8_MMA(1, 0, At, B0); PG8_BAR; PG8_SCHED;
            PG8_STAGE(PG8_SB(0, 1), b2 + hstep, voffB);
            PG8_WAIT_V(6); PG8_BAR; PG8_MMA(1, 1, At, B1); PG8_BAR;
            PG8_LDB(B0, 1, 0); PG8_SCHED; PG8_LDA(At, 1, 0); PG8_STAGE(PG8_SA(0, 1), a2 + hstep, voffA);
            PG8_WAIT_L(8); PG8_BAR; PG8_WAIT_L(0); PG8_MMA(0, 0, At, B0); PG8_BAR; PG8_SCHED;
            PG8_LDB(B1, 1, 1); PG8_STAGE(PG8_SB(1, 0), b3, voffB);
            PG8_BAR; PG8_WAIT_L(0); PG8_MMA(0, 1, At, B1); PG8_BAR;
            PG8_LDA(At, 1, 1); PG8_STAGE(PG8_SA(1, 0), a3, voffA);
            PG8_BAR; PG8_WAIT_L(0); PG8_MMA(1, 0, At, B0); PG8_BAR; PG8_SCHED;
            PG8_STAGE(PG8_SB(1, 1), b3 + hstep, voffB);
            PG8_WAIT_V(6); PG8_BAR; PG8_MMA(1, 1, At, B1); PG8_BAR;
            }
        }
        if constexpr (ALIGN_EPI) { if (wr == 0) PG8_BAR; }
        if constexpr (!Epi::AFTER_DRAIN) { E(acc, cur, wr, wc, fr, fq); S.done(cur); }
        if (!has_next) break;
#pragma unroll
        for (int a = 0; a < 2; ++a)
#pragma unroll
            for (int b = 0; b < 2; ++b)
#pragma unroll
                for (int m = 0; m < 4; ++m)
#pragma unroll
                    for (int n = 0; n < 2; ++n) acc[a][b][m][n] = (f32x4){0.f, 0.f, 0.f, 0.f};
        cur = nxt; cA = nA; cB = nB; ++ui;
        if constexpr (ALIGN_EPI) { if (wr == 1) PG8_BAR; }
    }
    PG8_WAIT_V(0);
    if constexpr (!ALIGN_EPI) { if (wr == 0) PG8_BAR; }
    PG8_BAR;
    if constexpr (Epi::AFTER_DRAIN) { E.fused(acc, cur, wr, wc, fr, fq, lds, wid, lane); S.done(cur); }
#undef PG8_SA
#undef PG8_SB
#undef PG8_STAGE
#undef PG8_LDA
#undef PG8_LDB
#undef PG8_MMA
#undef PG8_WAIT_V
#undef PG8_WAIT_L
#undef PG8_BAR
#undef PG8_SCHED
}
}
#define GAS __attribute__((address_space(1)))
#define LAS __attribute__((address_space(3)))
typedef unsigned short bf16;
typedef unsigned v4u __attribute__((ext_vector_type(4)));
typedef float f32x4 __attribute__((ext_vector_type(4)));
typedef short bf16x8 __attribute__((ext_vector_type(8)));
typedef GAS unsigned gu32;
typedef GAS unsigned long long gu64;
#define RLX_AGENT __ATOMIC_RELAXED, __HIP_MEMORY_SCOPE_AGENT
#define LDS_WAIT() asm volatile("s_waitcnt lgkmcnt(0)" ::: "memory")
#define VM_WAIT() asm volatile("s_waitcnt vmcnt(0)" ::: "memory")
__device__ __forceinline__ unsigned long long rt() { return __builtin_amdgcn_s_memrealtime(); }
__device__ __forceinline__ unsigned f2bf(float f) { unsigned u = __builtin_bit_cast(unsigned, f); return (u + 0x7fffu + ((u >> 16) & 1u)) >> 16; }
__device__ __forceinline__ unsigned pk2(float lo, float hi) { return f2bf(lo) | (f2bf(hi) << 16); }

#define XB_TMO      128
#define XB_XCNT(j)  (256  + 64 * (j))
#define XB_XSUB(j)  (1280 + 64 * (j))
#define XB_XGEN(j)  (2304 + 64 * (j))
#define XB_TOP      3328
#define XB_TOPGEN   3392
#define XCD_BAR_WORDS 3456
#define XB_SPIN_CAP (1u << 18)

__device__ __forceinline__ unsigned xb_ld(unsigned* p)              { return __hip_atomic_load(p, __ATOMIC_RELAXED, __HIP_MEMORY_SCOPE_AGENT); }
__device__ __forceinline__ unsigned xb_add(unsigned* p, unsigned v) { return __hip_atomic_fetch_add(p, v, __ATOMIC_RELAXED, __HIP_MEMORY_SCOPE_AGENT); }
__device__ __forceinline__ unsigned xb_xcc_id() { return (unsigned)__builtin_amdgcn_s_getreg((3 << 11) | 20) & 0xFu; }
#define XB_SPIN(cond, bar) do { unsigned _sp = 0; while (cond) { __builtin_amdgcn_s_sleep(1); \
    if ((++_sp & 255u) == 0u) { if (xb_ld(&(bar)[XB_TMO])) break; if (_sp > XB_SPIN_CAP) { atomicAdd(&(bar)[XB_TMO], 1u); break; } } } } while (0)

struct XcdBarrier {
    unsigned* bar; unsigned x;
    volatile LAS unsigned* st;
};

__device__ __forceinline__ XcdBarrier xcd_barrier_post(unsigned* bar, volatile LAS unsigned* st) {
    XcdBarrier b; b.bar = bar; b.x = xb_xcc_id(); b.st = st;
    if (threadIdx.x == 0) (void)xb_add(&bar[XB_XCNT(b.x)], 1u);
    return b;
}
__device__ __forceinline__ void xcd_barrier_complete(unsigned* bar, unsigned x, unsigned& nloc, unsigned& nx) {
    const unsigned G = gridDim.x * gridDim.y * gridDim.z;
    unsigned sum, cnt, mine, sp = 0u;
    for (;;) {
        sum = 0u; cnt = 0u; mine = 0u;
#pragma unroll
        for (unsigned j = 0; j < 16; ++j) { const unsigned c = xb_ld(&bar[XB_XCNT(j)]); sum += c; cnt += (c > 0u) ? 1u : 0u; mine = (j == x) ? c : mine; }
        if (sum == G) break;
        __builtin_amdgcn_s_sleep(1);
        if ((++sp & 255u) == 0u) { if (xb_ld(&bar[XB_TMO])) break; if (sp > XB_SPIN_CAP) { atomicAdd(&bar[XB_TMO], 1u); break; } }
    }
    nloc = mine > 0u ? mine : 1u; nx = cnt > 0u ? cnt : 1u;
}

__device__ __forceinline__ void xcd_barrier(const XcdBarrier& b) {
    asm volatile("s_waitcnt vmcnt(0)" ::: "memory");
    __syncthreads();
    if (threadIdx.x == 0) {
        unsigned* bar = b.bar;
        __builtin_amdgcn_s_waitcnt(0);
        unsigned nloc = b.st[0], nx = b.st[1];
        if (nloc == 0u) { xcd_barrier_complete(bar, b.x, nloc, nx); b.st[0] = nloc; b.st[1] = nx; }
        const unsigned old = xb_add(&bar[XB_XSUB(b.x)], 1u);
        const unsigned gen = old / nloc;
        if (old + 1u == (gen + 1u) * nloc) {
            __builtin_amdgcn_fence(__ATOMIC_RELEASE, "agent");
            asm volatile("s_waitcnt vmcnt(0)" ::: "memory");
            const unsigned og = xb_add(&bar[XB_TOP], 1u);
            const unsigned tg = og / nx;
            if (og + 1u == (tg + 1u) * nx) xb_add(&bar[XB_TOPGEN], 1u);
            else XB_SPIN(xb_ld(&bar[XB_TOPGEN]) == tg, bar);
            __builtin_amdgcn_fence(__ATOMIC_ACQUIRE, "agent");
            xb_add(&bar[XB_XGEN(b.x)], 1u);
            asm volatile("s_waitcnt vmcnt(0)" ::: "memory");
        } else {
            XB_SPIN(xb_ld(&bar[XB_XGEN(b.x)]) == gen, bar);
            __builtin_amdgcn_fence(__ATOMIC_ACQUIRE, "agent");
            asm volatile("s_waitcnt vmcnt(0)" ::: "memory");
        }
    }
    __syncthreads();
}
constexpr int NWAVES = 8;
constexpr int D = 1024, MH = 16384, NIN = 2816, FF = 4096, RW = 384, NH = 6, PXW = 1408;
constexpr float NORM_EPS = 1e-6f, GN_EPS = 64e-5f, LOG2E = 1.4426950408889634f, LN2 = 0.6931471805599453f;
enum { I_XP = 0, I_XS, I_NMPRE, I_NMPOST, I_NFPRE, I_NFPOST, I_WIN, I_WOUT, I_POOLW, I_POOLS, I_CONV, I_DW0, I_DUP, I_IA0, I_IUP, I_GUP, I_KK, I_KA, I_BRK, I_GNG, I_GNB, I_RELB, I_WFI, I_WFO };
constexpr size_t MiB = 1u << 20;
constexpr size_t WS_CTL = 0, CTL_ZERO_BYTES = 1 * MiB;
constexpr size_t WS_SMALL = 1 * MiB;
constexpr size_t WS_W = 2 * MiB, W_LAYER = 47 * MiB / 2;
constexpr size_t W_IN = 0, W_OUT = 11 * MiB / 2, W_FFI = 15 * MiB / 2, W_FFO = 31 * MiB / 2;
constexpr size_t WS_XN = 51 * MiB, WS_MIX = 83 * MiB, WS_PX = 115 * MiB, WS_PY = 159 * MiB, WS_FREE = 203 * MiB, WS_END = 256 * MiB;
constexpr size_t WS_H = 115 * MiB;
constexpr size_t WS_F1 = 159 * MiB;
constexpr size_t WS_OB = 203 * MiB, WS_LSE = 239 * MiB;
constexpr size_t WS_GP = 159 * MiB, WS_H0T = 183 * MiB, WS_RY = 207 * MiB, WS_Y0 = 231 * MiB, WS_HC = 51 * MiB, WS_DC = 75 * MiB, WS_BON = 76 * MiB;
constexpr int CW_TMO = 0, CW_CODE = 1, CW_BAR = 4096;
constexpr int RING_OFF = 0, RING_BYTES = 131072, LDSCTL_OFF = RING_BYTES, MISC_OFF = LDSCTL_OFF + 320, LDS_BYTES = 147456;
typedef float f32x16 __attribute__((ext_vector_type(16)));
typedef unsigned v2u __attribute__((ext_vector_type(2)));
typedef float f32x2_t __attribute__((ext_vector_type(2))); typedef __bf16 bf16x2_t __attribute__((ext_vector_type(2)));
__device__ __forceinline__ unsigned cvtpk(float lo, float hi) { f32x2_t v = {lo, hi}; bf16x2_t b = __builtin_convertvector(v, bf16x2_t); return __builtin_bit_cast(unsigned, b); }
__device__ __forceinline__ float bf2f(unsigned u) { return __builtin_bit_cast(float, u << 16); }
__device__ __forceinline__ float bflo(unsigned w) { return __builtin_bit_cast(float, w << 16); }
__device__ __forceinline__ float bfhi(unsigned w) { return __builtin_bit_cast(float, w & 0xffff0000u); }
__device__ __forceinline__ f32x16 mfma32(bf16x8 a, bf16x8 b, f32x16 c) { return __builtin_amdgcn_mfma_f32_32x32x16_bf16(a, b, c, 0, 0, 0); }
__device__ __forceinline__ f32x4 mfma16(bf16x8 a, bf16x8 b, f32x4 c) { return __builtin_amdgcn_mfma_f32_16x16x32_bf16(a, b, c, 0, 0, 0); }
__device__ __forceinline__ int crow(int i, int hh) { return (i & 3) + 8 * (i >> 2) + 4 * hh; }
__device__ __forceinline__ bf16x8 pack8(const f32x16& x, int s) {
    v4u p; p.x = cvtpk(x[8 * s], x[8 * s + 1]); p.y = cvtpk(x[8 * s + 2], x[8 * s + 3]); p.z = cvtpk(x[8 * s + 4], x[8 * s + 5]); p.w = cvtpk(x[8 * s + 6], x[8 * s + 7]);
    return __builtin_bit_cast(bf16x8, p);
}
__device__ __forceinline__ float sigmoidf_(float x) { return 1.0f / (1.0f + __expf(-x)); }
__device__ __forceinline__ float shx(float v, int m, int lane) { return __builtin_bit_cast(float, __builtin_amdgcn_ds_bpermute((lane ^ m) << 2, __builtin_bit_cast(int, v))); }
__device__ __forceinline__ float wave_sum(float v, int lane) {
#pragma unroll
    for (int o = 1; o < 64; o <<= 1) v += shx(v, o, lane);
    return v;
}

struct Frame {
    LAS unsigned char* lds;
    volatile LAS unsigned* MISC;
    gu32* ctl;
    int tid, lane, wave, G, vcu;
    float* out; unsigned char* ws;
};
#define WSP(T, off) ((T*)(F.ws + (off)))
struct Args { const float* in[24]; float* out; unsigned char* ws; int ph_lo, ph_hi, li, pad; };
#define KARG const Args& KA
#define INP(i) (KA.in[i])

__device__ __forceinline__ void transpose_item(const float* W, int ldw, int K, bf16* WT, int n0, int srccol0, int k0, LAS float* scr, int lane) {
#pragma unroll 8
    for (int i = 0; i < 32; ++i) { const int kk = 2 * i + (lane >> 5); scr[kk * 33 + (lane & 31)] = W[(size_t)(k0 + kk) * ldw + srccol0 + (lane & 31)]; }
    LDS_WAIT(); asm volatile("" ::: "memory");
    const int c = lane & 7;
#pragma unroll
    for (int j = 0; j < 4; ++j) { const int n = (lane >> 3) + 8 * j; const LAS float* s = scr + (8 * c) * 33 + n;
        v4u o; o.x = pk2(s[0 * 33], s[1 * 33]); o.y = pk2(s[2 * 33], s[3 * 33]); o.z = pk2(s[4 * 33], s[5 * 33]); o.w = pk2(s[6 * 33], s[7 * 33]);
        *(GAS v4u*)(WT + (size_t)(n0 + n) * K + k0 + 8 * c) = o; }
    LDS_WAIT(); asm volatile("" ::: "memory");
}
__device__ __forceinline__ int win_src(int n) { return n < 256 ? n : (n < 1408 ? 1664 + (n - 256) : (n < 2560 ? 256 + (n - 1408) : 1408 + (n - 2560))); }
__device__ __forceinline__ void phase_weights(KARG, Frame& F) {
    LAS float* scr = (LAS float*)(F.lds + RING_OFF + F.wave * 16384);
    const int gw = F.vcu * NWAVES + F.wave, NGW = F.G * NWAVES;
    constexpr int I_IN = (D / 64) * (NIN / 32), I_OUT = (D / 64) * (D / 32), I_FI = (D / 64) * (FF / 32), I_FO = (FF / 64) * (D / 32), I_G = (128 / 64) * (RW / 32);
    constexpr int PER_L = I_IN + I_OUT + I_FI + I_FO + I_G;
    for (int it = gw; it < 2 * PER_L; it += NGW) {
        const int l = it / PER_L; int r = it % PER_L;
        unsigned char* wl = F.ws + WS_W + (size_t)l * W_LAYER;
        if (r < I_IN) { const int nb = r % (NIN / 32), kb = r / (NIN / 32); transpose_item(KA.in[I_WIN] + (size_t)l * D * NIN, NIN, D, (bf16*)(wl + W_IN), 32 * nb, win_src(32 * nb), 64 * kb, scr, F.lane); continue; } r -= I_IN;
        if (r < I_OUT) { const int nb = r % (D / 32), kb = r / (D / 32); transpose_item(KA.in[I_WOUT] + (size_t)l * D * D, D, D, (bf16*)(wl + W_OUT), 32 * nb, 32 * nb, 64 * kb, scr, F.lane); continue; } r -= I_OUT;
        if (r < I_FI) { const int nb = r % (FF / 32), kb = r / (FF / 32); transpose_item(KA.in[I_WFI] + (size_t)l * D * FF, FF, D, (bf16*)(wl + W_FFI), 32 * nb, 32 * nb, 64 * kb, scr, F.lane); continue; } r -= I_FI;
        if (r < I_FO) { const int nb = r % (D / 32), kb = r / (D / 32); transpose_item(KA.in[I_WFO] + (size_t)l * FF * D, D, FF, (bf16*)(wl + W_FFO), 32 * nb, 32 * nb, 64 * kb, scr, F.lane); continue; } r -= I_FO;
        { const int nb = r % (RW / 32), kb = r / (RW / 32); transpose_item(KA.in[I_GUP] + (size_t)l * 128 * RW, RW, 128, WSP(bf16, WS_SMALL) + (size_t)l * RW * 128, 32 * nb, 32 * nb, 64 * kb, scr, F.lane); }
    }
}
__device__ __forceinline__ void phase_xn_init(KARG, Frame& F, int hf) {
    const int gw = F.vcu * NWAVES + F.wave, NGW = F.G * NWAVES;
    const float* X = KA.in[hf ? I_XS : I_XP]; const GAS f32x4* gp = (const GAS f32x4*)KA.in[I_NMPRE] + F.lane;
    f32x4 g[4];
#pragma unroll
    for (int j = 0; j < 4; ++j) g[j] = gp[64 * j];
    for (int m = gw; m < MH; m += NGW) {
        const GAS f32x4* xr = (const GAS f32x4*)(X + (size_t)m * D) + F.lane; f32x4 v[4]; float s = 0.f;
#pragma unroll
        for (int j = 0; j < 4; ++j) { v[j] = xr[64 * j]; s += (v[j].x * v[j].x + v[j].y * v[j].y) + (v[j].z * v[j].z + v[j].w * v[j].w); }
        const float rstd = 1.0f / sqrtf(wave_sum(s, F.lane) * (1.f / D) + NORM_EPS);
        GAS v2u* o8 = (GAS v2u*)(WSP(bf16, WS_XN) + (size_t)m * D) + F.lane;
#pragma unroll
        for (int j = 0; j < 4; ++j) { v2u w; w.x = pk2(v[j].x * rstd * g[j].x, v[j].y * rstd * g[j].y); w.y = pk2(v[j].z * rstd * g[j].z, v[j].w * rstd * g[j].w); o8[64 * j] = w; }
    }
}
__device__ __forceinline__ void phase_rowpass(KARG, Frame& F, int hf, const bf16* Fm, const float* base, const float* gpost, const float* gnext) {
    const int gw = F.vcu * NWAVES + F.wave, NGW = F.G * NWAVES;
    f32x4 gp[4], gn[4];
#pragma unroll
    for (int j = 0; j < 4; ++j) { gp[j] = ((const GAS f32x4*)gpost + F.lane)[64 * j]; gn[j] = gnext ? ((const GAS f32x4*)gnext + F.lane)[64 * j] : (f32x4){0.f, 0.f, 0.f, 0.f}; }
    float* out = F.out + (size_t)hf * MH * D;
    for (int m = gw; m < MH; m += NGW) {
        const GAS v2u* fr = (const GAS v2u*)(Fm + (size_t)m * D) + F.lane; const GAS f32x4* xr = (const GAS f32x4*)(base + (size_t)m * D) + F.lane;
        f32x4 f[4], x[4]; float s = 0.f;
#pragma unroll
        for (int j = 0; j < 4; ++j) { const v2u w = fr[64 * j]; x[j] = xr[64 * j]; f[j] = (f32x4){bflo(w.x), bfhi(w.x), bflo(w.y), bfhi(w.y)}; s += (f[j].x * f[j].x + f[j].y * f[j].y) + (f[j].z * f[j].z + f[j].w * f[j].w); }
        const float rstd = 1.0f / sqrtf(wave_sum(s, F.lane) * (1.f / D) + NORM_EPS); float s2 = 0.f;
        GAS f32x4* orow = (GAS f32x4*)(out + (size_t)m * D) + F.lane;
#pragma unroll
        for (int j = 0; j < 4; ++j) { x[j] = x[j] + f[j] * rstd * gp[j]; orow[64 * j] = x[j]; s2 += (x[j].x * x[j].x + x[j].y * x[j].y) + (x[j].z * x[j].z + x[j].w * x[j].w); }
        if (gnext) {
            const float r2 = 1.0f / sqrtf(wave_sum(s2, F.lane) * (1.f / D) + NORM_EPS);
            GAS v2u* o8 = (GAS v2u*)(WSP(bf16, WS_XN) + (size_t)m * D) + F.lane;
#pragma unroll
            for (int j = 0; j < 4; ++j) { v2u w; w.x = pk2(x[j].x * r2 * gn[j].x, x[j].y * r2 * gn[j].y); w.y = pk2(x[j].z * r2 * gn[j].z, x[j].w * r2 * gn[j].w); o8[64 * j] = w; }
        }
    }
}
__device__ __forceinline__ void pool_tile(KARG, Frame& F, int hf, int l, int tile) {
    LAS float* U = (LAS float*)(F.lds + RING_OFF);
    LAS float* Pd = U + 48 * 256;
    const bf16* PY = WSP(bf16, WS_PY); bf16* MIX = WSP(bf16, WS_MIX);
    const int T = hf ? 16384 : 8192; const int r0 = tile * 32; const int sbase = hf ? 0 : (r0 & ~8191); const int t0 = r0 - sbase;
    __syncthreads();
    for (int i = F.tid; i < 48 * 32; i += 512) { const int rr = i >> 5, c8 = (i & 31) * 8; const int t = t0 - 8 + rr;
        if (t >= 0 && t < T) { const v4u w = *(const GAS v4u*)(PY + (size_t)(sbase + t) * PXW + c8); LAS float* u = U + rr * 256 + c8;
            u[0] = bflo(w.x); u[1] = bfhi(w.x); u[2] = bflo(w.y); u[3] = bfhi(w.y); u[4] = bflo(w.z); u[5] = bfhi(w.z); u[6] = bflo(w.w); u[7] = bfhi(w.w); } }
    __syncthreads();
    { const int ch = F.tid & 255, g = ch >> 6, win = 2 << g, hw = win >> 1;
      for (int tt = F.tid >> 8; tt < 32; tt += 2) { const int t = t0 + tt; int lo = t - hw; if (lo < 0) lo = 0; int hi = t + win - hw; if (hi > T) hi = T;
          float s = 0.f; for (int q = lo; q < hi; ++q) s += U[(q - t0 + 8) * 256 + ch];
          Pd[tt * 256 + ch] = s / (float)(hi - lo) - U[(tt + 8) * 256 + ch]; } }
    __syncthreads();
    { const int d = F.tid & 63, g = (F.tid >> 6) & 3, tg = F.tid >> 8;
      const float* pw = KA.in[I_POOLW] + (size_t)l * 4 * 64 * 64 + g * 4096 + d; const float sc = KA.in[I_POOLS][l * 256 + g * 64 + d];
      float acc[16];
#pragma unroll
      for (int i = 0; i < 16; ++i) acc[i] = 0.f;
      for (int c = 0; c < 64; ++c) { const float w = pw[c * 64];
#pragma unroll
          for (int i = 0; i < 16; ++i) acc[i] += Pd[(tg * 16 + i) * 256 + g * 64 + c] * w; }
#pragma unroll
      for (int i = 0; i < 16; ++i) MIX[(size_t)(r0 + tg * 16 + i) * D + g * 64 + d] = (bf16)f2bf(acc[i] * sc); }
}
constexpr int BT_STRIDE = 192;
__device__ __forceinline__ void attn_bias_table(KARG, Frame& F, LAS float* bt) {
    const float* rb = KA.in[I_RELB];
    for (int i = F.tid; i < 18 * BT_STRIDE; i += 512) { const int bh = i / BT_STRIDE, o = i % BT_STRIDE, b = bh / 6, h = bh % 6; const int rel = o - 96; float val = 0.f;
        if (rel >= -64 && rel <= 64) { const int rp = rel * (1 << (2 * b)); int ret = rp > 0 ? 16 : 0; const int n = rp < 0 ? -rp : rp;
            if (n < 8) ret += n; else { const float nf = (float)n; int large = 8 + (int)(logf(nf / 8.0f) / logf(128.0f) * 8.0f); if (large > 15) large = 15; ret += large; }
            val = rb[ret * 6 + h] * LOG2E; }
        bt[i] = val; }
}
__device__ __forceinline__ void attn_unit(Frame& F, int hf, int uidx, const LAS float* btab) {
    const int lane = F.lane, c31 = lane & 31, hh = lane >> 5;
    const int T = hf ? 16384 : 8192, nblk = T >> 6, nseq = hf ? 1 : 2;
    const int qt = uidx & 1; int g = uidx >> 1; const int blk = g % nblk; g /= nblk; const int s = g % nseq; g /= nseq; const int h = g % 6, b = g / 6;
    const int dsh = 2 * b, L = T >> dsh, nbs = L >> 6, r = blk / nbs, n = blk % nbs, row0 = s * 8192 + r;
    const bf16* PY = WSP(bf16, WS_PY);
    bf16x8 idf[2];
#pragma unroll
    for (int p = 0; p < 2; ++p)
#pragma unroll
        for (int e = 0; e < 8; ++e) idf[p][e] = (c31 - 16 * p - 8 * hh == e) ? (short)0x3F80 : (short)0;
    const int qi = 32 * qt + c31; const int qrow = row0 + ((64 * n + qi) << dsh);
    bf16x8 qf[4];
#pragma unroll
    for (int ks = 0; ks < 4; ++ks) qf[ks] = *(const GAS bf16x8*)(PY + (size_t)qrow * PXW + 256 + h * 64 + 8 * hh + 16 * ks);
    f32x16 sacc[5];
#pragma unroll
    for (int k5 = 0; k5 < 5; ++k5) { int kp = 64 * (n - 1) + 32 * (qt + k5) + c31; kp = kp < 0 ? 0 : (kp > L - 1 ? L - 1 : kp);
        const bf16* kptr = PY + (size_t)(row0 + (kp << dsh)) * PXW + 640 + h * 64 + 8 * hh; f32x16 a = {};
#pragma unroll
        for (int ks = 0; ks < 4; ++ks) a = mfma32(*(const GAS bf16x8*)(kptr + 16 * ks), qf[ks], a);
        sacc[k5] = a; }
    const LAS float* bt = btab + (b * 6 + h) * BT_STRIDE + 32 - qi;
    const float SC = 0.125f * LOG2E; float m = -3.0e38f;
#pragma unroll
    for (int k5 = 0; k5 < 5; ++k5)
#pragma unroll
        for (int i = 0; i < 16; ++i) { const int j = 32 * (qt + k5) + crow(i, hh); const int rel = j - 64 - qi, kp = 64 * (n - 1) + j;
            const bool valid = (rel >= -64) && (rel <= 64) && (kp >= 0) && (kp < L);
            float t = sacc[k5][i] * SC + bt[j]; t = valid ? t : -1.0e30f; sacc[k5][i] = t; m = fmaxf(m, t); }
    m = fmaxf(m, shx(m, 32, lane)); float lsum = 0.f;
#pragma unroll
    for (int k5 = 0; k5 < 5; ++k5)
#pragma unroll
        for (int i = 0; i < 16; ++i) { const float p = exp2f(sacc[k5][i] - m); sacc[k5][i] = p; lsum += p; }
    lsum += shx(lsum, 32, lane); const float inv = 1.0f / lsum;
    f32x16 o[2] = {};
#pragma unroll
    for (int k5 = 0; k5 < 5; ++k5) { int kp = 64 * (n - 1) + 32 * (qt + k5) + c31; kp = kp < 0 ? 0 : (kp > L - 1 ? L - 1 : kp);
        const bf16* vptr = PY + (size_t)(row0 + (kp << dsh)) * PXW + 1024 + h * 64 + 8 * hh; bf16x8 vf[4];
#pragma unroll
        for (int ks = 0; ks < 4; ++ks) vf[ks] = *(const GAS bf16x8*)(vptr + 16 * ks);
#pragma unroll
        for (int i = 0; i < 16; ++i) sacc[k5][i] *= inv;
#pragma unroll
        for (int dt = 0; dt < 2; ++dt) { f32x16 vt = {}; vt = mfma32(vf[2 * dt], idf[0], vt); vt = mfma32(vf[2 * dt + 1], idf[1], vt);
#pragma unroll
            for (int s2 = 0; s2 < 2; ++s2) o[dt] = mfma32(pack8(sacc[k5], s2), pack8(vt, s2), o[dt]); } }
    bf16* OB = WSP(bf16, WS_OB) + (size_t)b * MH * RW; float* LSE = WSP(float, WS_LSE) + (size_t)b * MH * NH;
#pragma unroll
    for (int dt = 0; dt < 2; ++dt)
#pragma unroll
        for (int i = 0; i < 16; ++i) { const int orow = row0 + ((64 * n + 32 * qt + crow(i, hh)) << dsh); OB[(size_t)orow * RW + h * 64 + 32 * dt + c31] = (bf16)f2bf(o[dt][i]); }
    if (hh == 0) LSE[(size_t)qrow * NH + h] = (m + log2f(lsum)) * LN2;
}
__device__ __forceinline__ void phase_pool_attn(KARG, Frame& F, int hf, int l) {
    for (int t = F.vcu; t < MH / 32; t += F.G) pool_tile(KA, F, hf, l, t);
    __syncthreads();
    LAS float* bt = (LAS float*)(F.lds + RING_OFF);
    attn_bias_table(KA, F, bt);
    __syncthreads();
    const int gw = F.vcu * NWAVES + F.wave, NGW = F.G * NWAVES;
    for (int u = gw; u < 9216; u += NGW) attn_unit(F, hf, u, bt);
}
__device__ __forceinline__ void phase_attn_merge(Frame& F) {
    const bf16* OB = WSP(bf16, WS_OB); const float* LSE = WSP(float, WS_LSE); bf16* MIX = WSP(bf16, WS_MIX);
    const int gt = F.vcu * 512 + F.tid, NT = F.G * 512;
    for (int it = gt; it < MH * 48; it += NT) { const int row = it / 48, cg = it % 48, h = cg >> 3;
        float ls[3], mx = -3.0e38f;
#pragma unroll
        for (int b = 0; b < 3; ++b) { ls[b] = LSE[((size_t)b * MH + row) * NH + h]; mx = fmaxf(mx, ls[b]); }
        float al[3], sum = 0.f;
#pragma unroll
        for (int b = 0; b < 3; ++b) { al[b] = __expf(ls[b] - mx); sum += al[b]; }
        const float inv = 1.0f / sum; float acc[8];
#pragma unroll
        for (int e = 0; e < 8; ++e) acc[e] = 0.f;
#pragma unroll
        for (int b = 0; b < 3; ++b) { const v4u w = *(const GAS v4u*)(OB + ((size_t)b * MH + row) * RW + cg * 8); const float a = al[b] * inv;
            acc[0] += a * bflo(w.x); acc[1] += a * bfhi(w.x); acc[2] += a * bflo(w.y); acc[3] += a * bfhi(w.y); acc[4] += a * bflo(w.z); acc[5] += a * bfhi(w.z); acc[6] += a * bflo(w.w); acc[7] += a * bfhi(w.w); }
        v4u o; o.x = pk2(acc[0], acc[1]); o.y = pk2(acc[2], acc[3]); o.z = pk2(acc[4], acc[5]); o.w = pk2(acc[6], acc[7]);
        *(GAS v4u*)(MIX + (size_t)row * D + 640 + cg * 8) = o; }
}
constexpr int LB = 72;
constexpr int LS = 40;
constexpr int LF = 65;
constexpr int MATB = 64 * LB * 2;
template <int KS> __device__ __forceinline__ f32x4 mm16(const LAS bf16* A, int lda, const LAS bf16* BT, int ldb, int mi, int nj, int lane, f32x4 acc) {
    const LAS bf16* ap = A + (16 * mi + (lane & 15)) * lda + 8 * (lane >> 4); const LAS bf16* bp = BT + (16 * nj + (lane & 15)) * ldb + 8 * (lane >> 4);
#pragma unroll
    for (int ks = 0; ks < KS; ++ks) acc = mfma16(*(const LAS bf16x8*)(ap + 32 * ks), *(const LAS bf16x8*)(bp + 32 * ks), acc);
    return acc;
}
template <int N, int S, int J> __device__ __forceinline__ void rl_fma(float& acc, const float (&Tr)[32], const float (&vL)[32]) {
    if constexpr (N == 4) { unsigned t0, t1, t2, t3;
        asm volatile("v_readlane_b32 %1, %5, %13\n\tv_readlane_b32 %2, %6, %13\n\tv_readlane_b32 %3, %7, %13\n\tv_readlane_b32 %4, %8, %13\n\tv_fmac_f32 %0, %1, %9\n\tv_fmac_f32 %0, %2, %10\n\tv_fmac_f32 %0, %3, %11\n\tv_fmac_f32 %0, %4, %12"
                     : "+v"(acc), "=&s"(t0), "=&s"(t1), "=&s"(t2), "=&s"(t3) : "v"(vL[S]), "v"(vL[S + 1]), "v"(vL[S + 2]), "v"(vL[S + 3]), "v"(Tr[S]), "v"(Tr[S + 1]), "v"(Tr[S + 2]), "v"(Tr[S + 3]), "n"(J)); }
    else if constexpr (N == 3) { unsigned t0, t1, t2;
        asm volatile("v_readlane_b32 %1, %4, %10\n\tv_readlane_b32 %2, %5, %10\n\tv_readlane_b32 %3, %6, %10\n\tv_fmac_f32 %0, %1, %7\n\tv_fmac_f32 %0, %2, %8\n\tv_fmac_f32 %0, %3, %9"
                     : "+v"(acc), "=&s"(t0), "=&s"(t1), "=&s"(t2) : "v"(vL[S]), "v"(vL[S + 1]), "v"(vL[S + 2]), "v"(Tr[S]), "v"(Tr[S + 1]), "v"(Tr[S + 2]), "n"(J)); }
    else if constexpr (N == 2) { unsigned t0, t1;
        asm volatile("v_readlane_b32 %1, %3, %7\n\tv_readlane_b32 %2, %4, %7\n\ts_nop 0\n\tv_fmac_f32 %0, %1, %5\n\tv_fmac_f32 %0, %2, %6"
                     : "+v"(acc), "=&s"(t0), "=&s"(t1) : "v"(vL[S]), "v"(vL[S + 1]), "v"(Tr[S]), "v"(Tr[S + 1]), "n"(J)); }
    else if constexpr (N == 1) { unsigned t0;
        asm volatile("v_readlane_b32 %1, %2, %4\n\ts_nop 1\n\tv_fmac_f32 %0, %1, %3" : "+v"(acc), "=&s"(t0) : "v"(vL[S]), "v"(Tr[S]), "n"(J)); }
}
template <int S, int J> __device__ __forceinline__ void rl_fma_all(float& acc, const float (&Tr)[32], const float (&vL)[32]) {
    constexpr int REM = 32 - S;
    if constexpr (REM >= 4) { rl_fma<4, S, J>(acc, Tr, vL); rl_fma_all<S + 4, J>(acc, Tr, vL); }
    else if constexpr (REM > 0) { rl_fma<REM, S, J>(acc, Tr, vL); }
}
template <int J> struct SolveStep {
    static __device__ __forceinline__ void run(float (&Tr)[32], const float (&vL)[32], int r_) {
        float acc = (J == r_) ? 1.f : 0.f;
        rl_fma_all<J + 1, J>(acc, Tr, vL);
        Tr[J] = (J <= r_) ? acc : 0.f;
        SolveStep<J - 1>::run(Tr, vL, r_);
    }
};
template <> struct SolveStep<-1> { static __device__ __forceinline__ void run(float (&)[32], const float (&)[32], int) {} };
__device__ __forceinline__ v2u pk4(const f32x4 v) { v2u o; o.x = cvtpk(v[0], v[1]); o.y = cvtpk(v[2], v[3]); return o; }
__device__ __forceinline__ void passA_unit(KARG, Frame& F, int hf, int l, int unit) {
    int tid = F.tid; asm volatile("" : "+v"(tid)); int t = tid >> 3, cg = tid & 7, c0 = cg * 8;
    const int ci = unit / 6, h = unit % 6; const int rr0 = ci * 64; const int T = hf ? 16384 : 8192; const int sbase = hf ? 0 : (rr0 & ~8191);
    int tl = rr0 - sbase + t;
    const bf16* PX = WSP(bf16, WS_PX);
    LAS unsigned char* L0 = F.lds + RING_OFF;
#define MAT(i) ((LAS bf16*)(L0 + (i) * MATB))
    LAS bf16* mAt = MAT(0); LAS bf16* mBt = MAT(1); LAS bf16* mKt = MAT(2); LAS bf16* mRt = MAT(3); LAS bf16* mAtT = MAT(4); LAS bf16* mBtT = MAT(5); LAS bf16* mKtT = MAT(6); LAS bf16* mVT = MAT(7);
    LAS bf16* mLak = MAT(8); LAS bf16* mLrb = MAT(9); LAS bf16* mLrk = MAT(10); LAS bf16* mT = MAT(11); LAS bf16* mX1T = MAT(12); LAS bf16* mWT = MAT(13); LAS bf16* mU0T = MAT(8);
    LAS float* fA = (LAS float*)(L0 + 8 * MATB);
    LAS float* fB = fA + 64 * LF;
    LAS float* fC = fB + 64 * LF;
    LAS float* sLs = (LAS float*)(L0 + 12 * MATB);
    LAS bf16* sL21 = (LAS bf16*)(L0 + 12 * MATB + 8448);
    LAS bf16* sT11T = sL21 + 32 * LS;
    LAS bf16* sQT = sT11T + 32 * LS;
    LAS float* sDC = (LAS float*)(L0 + 14 * MATB);
    float bonus = 0.f;
    for (int d = 0; d < 2; ++d) {
        asm volatile("" : "+v"(tid)); t = tid >> 3; cg = tid & 7; c0 = cg * 8; tl = rr0 - sbase + t;
        const int lane = tid & 63, wave = __builtin_amdgcn_readfirstlane(tid >> 6);
        const int tau = d ? 63 - t : t; const size_t inst = ((size_t)ci * 6 + h) * 2 + d;
    float cr[8], ck[8], cv[8];
    { const float* cw = KA.in[I_CONV] + (size_t)l * 3 * 1152;
#pragma unroll
      for (int e = 0; e < 8; ++e) { cr[e] = 0.f; ck[e] = 0.f; cv[e] = 0.f; }
#pragma unroll
      for (int tap = 0; tap < 3; ++tap) { const int tq = tl + tap - 1; if (tq >= 0 && tq < T) { const bf16* row = PX + (size_t)(sbase + tq) * PXW + h * 64 + c0;
          const v4u wr_ = *(const GAS v4u*)(row), wk_ = *(const GAS v4u*)(row + 384), wv_ = *(const GAS v4u*)(row + 768); const float* w = cw + tap * 1152 + h * 64 + c0;
          const unsigned ur[4] = {wr_.x, wr_.y, wr_.z, wr_.w}, uk[4] = {wk_.x, wk_.y, wk_.z, wk_.w}, uv[4] = {wv_.x, wv_.y, wv_.z, wv_.w};
#pragma unroll
          for (int e = 0; e < 8; ++e) { const float xr = (e & 1) ? bfhi(ur[e >> 1]) : bflo(ur[e >> 1]), xk = (e & 1) ? bfhi(uk[e >> 1]) : bflo(uk[e >> 1]), xv = (e & 1) ? bfhi(uv[e >> 1]) : bflo(uv[e >> 1]);
              cr[e] += xr * w[e]; ck[e] += xk * w[384 + e]; cv[e] += xv * w[768 + e]; } } } }
    float kkv[8];
    { float ss = 0.f; const float* kkw = KA.in[I_KK] + l * RW + h * 64 + c0;
#pragma unroll
      for (int e = 0; e < 8; ++e) { kkv[e] = ck[e] * kkw[e]; ss += kkv[e] * kkv[e]; }
      ss += shx(ss, 1, lane); ss += shx(ss, 2, lane); ss += shx(ss, 4, lane);
      const float inv = 1.0f / fmaxf(sqrtf(ss), 1e-12f);
#pragma unroll
      for (int e = 0; e < 8; ++e) kkv[e] *= inv; }
        __syncthreads();
        { const bf16* row = PX + (size_t)(rr0 + t) * PXW + 1152 + c0; const v4u ww = *(const GAS v4u*)(row), wa = *(const GAS v4u*)(row + 64);
          const unsigned uw[4] = {ww.x, ww.y, ww.z, ww.w}, ua[4] = {wa.x, wa.y, wa.z, wa.w};
#pragma unroll
          for (int e = 0; e < 8; ++e) { fA[t * LF + c0 + e] = tanhf((e & 1) ? bfhi(uw[e >> 1]) : bflo(uw[e >> 1])); fB[t * LF + c0 + e] = (e & 1) ? bfhi(ua[e >> 1]) : bflo(ua[e >> 1]); } }
        __syncthreads();
        float w_[8], ic[8];
        { const float* w0 = KA.in[I_DW0] + (size_t)(l * 2 + d) * RW + h * 64 + c0; const float* a0 = KA.in[I_IA0] + (size_t)(l * 2 + d) * RW + h * 64 + c0;
          const float* du = KA.in[I_DUP] + (size_t)(l * 2 + d) * 64 * RW + h * 64 + c0; const float* iu = KA.in[I_IUP] + (size_t)(l * 2 + d) * 64 * RW + h * 64 + c0;
#pragma unroll
          for (int e = 0; e < 8; ++e) { w_[e] = w0[e]; ic[e] = a0[e]; }
          for (int r = 0; r < 64; ++r) { const float aw = fA[t * LF + r], aa = fB[t * LF + r]; const f32x4 d0 = *(const GAS f32x4*)(du + (size_t)r * RW), d1 = *(const GAS f32x4*)(du + (size_t)r * RW + 4), i0 = *(const GAS f32x4*)(iu + (size_t)r * RW), i1 = *(const GAS f32x4*)(iu + (size_t)r * RW + 4);
#pragma unroll
              for (int e = 0; e < 4; ++e) { w_[e] += aw * d0[e]; w_[4 + e] += aw * d1[e]; ic[e] += aa * i0[e]; ic[4 + e] += aa * i1[e]; } } }
        float logd[8];
#pragma unroll
        for (int e = 0; e < 8; ++e) { logd[e] = -0.6065306597126334f * sigmoidf_(w_[e]); ic[e] = sigmoidf_(ic[e]); fC[tau * LF + c0 + e] = logd[e]; }
        __syncthreads();
        if (tid < 64) { float cum = 0.f; for (int q = 0; q < 64; ++q) { cum += fC[q * LF + tid]; fC[q * LF + tid] = cum; } }
        __syncthreads();
        { const float* ka = KA.in[I_KA] + l * RW + h * 64 + c0; const float* brk = KA.in[I_BRK] + l * RW + h * 64 + c0;
          float at[8], bt_[8], kt[8], rt[8]; float bs = 0.f;
#pragma unroll
          for (int e = 0; e < 8; ++e) { const float cum = fC[tau * LF + c0 + e], cumx = cum - logd[e]; const float keff = ck[e] * (1.0f + (ic[e] - 1.0f) * ka[e]);
              bs += cr[e] * keff * brk[e];
              const float en = __expf(-cum);
              at[e] = -kkv[e] * __expf(cumx); bt_[e] = kkv[e] * ic[e] * en; kt[e] = keff * en; rt[e] = cr[e] * __expf(cum); }
          bs += shx(bs, 1, lane); bs += shx(bs, 2, lane); bs += shx(bs, 4, lane); bonus += bs;
          v4u o;
          o.x = pk2(at[0], at[1]); o.y = pk2(at[2], at[3]); o.z = pk2(at[4], at[5]); o.w = pk2(at[6], at[7]); *(LAS v4u*)(mAt + tau * LB + c0) = o;
          o.x = pk2(bt_[0], bt_[1]); o.y = pk2(bt_[2], bt_[3]); o.z = pk2(bt_[4], bt_[5]); o.w = pk2(bt_[6], bt_[7]); *(LAS v4u*)(mBt + tau * LB + c0) = o;
          o.x = pk2(kt[0], kt[1]); o.y = pk2(kt[2], kt[3]); o.z = pk2(kt[4], kt[5]); o.w = pk2(kt[6], kt[7]); *(LAS v4u*)(mKt + tau * LB + c0) = o;
          o.x = pk2(rt[0], rt[1]); o.y = pk2(rt[2], rt[3]); o.z = pk2(rt[4], rt[5]); o.w = pk2(rt[6], rt[7]); *(LAS v4u*)(mRt + tau * LB + c0) = o;
#pragma unroll
          for (int e = 0; e < 8; ++e) { mAtT[(c0 + e) * LB + tau] = (bf16)f2bf(at[e]); mBtT[(c0 + e) * LB + tau] = (bf16)f2bf(bt_[e]); mKtT[(c0 + e) * LB + tau] = (bf16)f2bf(kt[e]); mVT[(c0 + e) * LB + tau] = (bf16)f2bf(cv[e]); }
          if (t == 0) {
#pragma unroll
              for (int e = 0; e < 8; ++e) { const float dc = __expf(fC[63 * LF + c0 + e]); sDC[c0 + e] = dc; WSP(float, WS_DC)[inst * 64 + c0 + e] = dc; } } }
        __syncthreads();
        int lnv = lane, cc, qq;
#define FRESH_LANE() do { asm volatile("" : "+v"(lnv)); cc = lnv & 15; qq = lnv >> 4; } while (0)
        FRESH_LANE();
        for (int tt = wave; tt < 64; tt += 8) { const int prod = tt >> 4, mi = (tt >> 2) & 3, nj = tt & 3; const f32x4 z = {0.f, 0.f, 0.f, 0.f};
            if (prod == 0) { const f32x4 a = mm16<2>(mAt, LB, mBt, LB, mi, nj, lnv, z);
                const int sg = 16 * nj + cc; const int blk = mi >> 1;
                if ((mi >> 1) == (nj >> 1)) {
#pragma unroll
                    for (int e = 0; e < 4; ++e) { const int ta = 16 * mi + 4 * qq + e; sLs[blk * 32 * 33 + (ta & 31) * 33 + (sg & 31)] = (sg < ta) ? a[e] : 0.f; } }
                else if (mi >= 2) {
#pragma unroll
                    for (int e = 0; e < 4; ++e) { const int ta = 16 * mi + 4 * qq + e; sL21[(ta - 32) * LS + sg] = (bf16)f2bf(a[e]); } } }
            else { const LAS bf16* Am = (prod == 2) ? mBt : mKt; const LAS bf16* Bm = (prod == 1) ? mAt : mRt; LAS bf16* Om = (prod == 1) ? mLak : (prod == 2 ? mLrb : mLrk);
                f32x4 a = mm16<2>(Am, LB, Bm, LB, mi, nj, lnv, z);
                const int ta = 16 * nj + cc;
#pragma unroll
                for (int e = 0; e < 4; ++e) { const int sg = 16 * mi + 4 * qq + e; const bool keep = (prod == 1) ? (sg < ta) : (sg <= ta); a[e] = keep ? a[e] : 0.f; }
                *(LAS v2u*)(Om + ta * LB + 16 * mi + 4 * qq) = pk4(a); } }
        __syncthreads();
        FRESH_LANE();
        if (wave < 2) { const int blk = wave, r_ = lnv & 31; const LAS float* Lb = sLs + blk * 32 * 33; float Tr[32], vL[32];
#pragma unroll
            for (int s = 0; s < 32; ++s) vL[s] = Lb[s * 33 + r_];
            SolveStep<31>::run(Tr, vL, r_);
            if (lnv < 32) {
            LAS bf16* trow = mT + (32 * blk + r_) * LB + 32 * blk; LAS bf16* zrow = mT + r_ * LB + 32;
#pragma unroll
            for (int g = 0; g < 4; ++g) { v4u o; o.x = pk2(Tr[8 * g], Tr[8 * g + 1]); o.y = pk2(Tr[8 * g + 2], Tr[8 * g + 3]); o.z = pk2(Tr[8 * g + 4], Tr[8 * g + 5]); o.w = pk2(Tr[8 * g + 6], Tr[8 * g + 7]);
                *(LAS v4u*)(trow + 8 * g) = o; if (blk == 0) *(LAS v4u*)(zrow + 8 * g) = (v4u){0u, 0u, 0u, 0u}; }
            if (blk == 0) {
#pragma unroll
                for (int j = 0; j < 32; ++j) sT11T[j * LS + r_] = (bf16)f2bf(Tr[j]); } } }
        __syncthreads();
        FRESH_LANE();
        if (wave < 4) { const int mi = wave >> 1, nj = wave & 1; const f32x4 a = mm16<1>(sL21, LS, sT11T, LS, mi, nj, lnv, (f32x4){0.f, 0.f, 0.f, 0.f});
            *(LAS v2u*)(sQT + (16 * nj + cc) * LS + 16 * mi + 4 * qq) = pk4(a); }
        __syncthreads();
        FRESH_LANE();
        if (wave < 4) { const int mi = wave >> 1, nj = wave & 1; const f32x4 a = mm16<1>(mT + 32 * LB + 32, LB, sQT, LS, mi, nj, lnv, (f32x4){0.f, 0.f, 0.f, 0.f});
#pragma unroll
            for (int e = 0; e < 4; ++e) mT[(32 + 16 * mi + 4 * qq + e) * LB + 16 * nj + cc] = (bf16)f2bf(a[e]); }
        __syncthreads();
        FRESH_LANE();
        for (int tt = wave; tt < 32; tt += 8) { const int prod = tt >> 4, mi = (tt >> 2) & 3, nj = tt & 3; const f32x4 z = {0.f, 0.f, 0.f, 0.f};
            const f32x4 a = prod ? mm16<2>(mT, LB, mAtT, LB, mi, nj, lnv, z) : mm16<2>(mLak, LB, mVT, LB, mi, nj, lnv, z);
            *(LAS v2u*)((prod ? mWT : mX1T) + (16 * nj + cc) * LB + 16 * mi + 4 * qq) = pk4(a); }
        __syncthreads();
        FRESH_LANE();
        for (int tt = wave; tt < 16; tt += 8) { const int mi = tt >> 2, nj = tt & 3; const f32x4 a = mm16<2>(mT, LB, mX1T, LB, mi, nj, lnv, (f32x4){0.f, 0.f, 0.f, 0.f});
            *(LAS v2u*)(mU0T + (16 * nj + cc) * LB + 16 * mi + 4 * qq) = pk4(a); }
        __syncthreads();
        FRESH_LANE();
        for (int tt = wave; tt < 64; tt += 8) { const int prod = tt >> 4, mi = (tt >> 2) & 3, nj = tt & 3; const int r4 = 16 * mi + 4 * qq, cn = 16 * nj + cc;
            if (prod == 0) {
                const v2u rv = *(const LAS v2u*)(mRt + cn * LB + r4); f32x4 a = {bflo(rv.x), bfhi(rv.x), bflo(rv.y), bfhi(rv.y)};
                a = mm16<2>(mWT, LB, mLrb, LB, mi, nj, lnv, a); const int treal = d ? 63 - cn : cn;
                *(GAS v2u*)(WSP(bf16, WS_RY) + inst * 4096 + treal * 64 + r4) = pk4(a); }
            else if (prod == 1) {
                f32x4 a = mm16<2>(mU0T, LB, mLrb, LB, mi, nj, lnv, (f32x4){0.f, 0.f, 0.f, 0.f}); a = mm16<2>(mVT, LB, mLrk, LB, mi, nj, lnv, a); const int treal = d ? 63 - cn : cn;
                *(GAS v2u*)(WSP(bf16, WS_Y0) + inst * 4096 + treal * 64 + r4) = pk4(a); }
            else if (prod == 2) {
                f32x4 a = mm16<2>(mWT, LB, mBtT, LB, mi, nj, lnv, (f32x4){0.f, 0.f, 0.f, 0.f}); const float dc = sDC[cn];
#pragma unroll
                for (int e = 0; e < 4; ++e) a[e] *= dc;
                *(GAS v2u*)(WSP(bf16, WS_GP) + inst * 4096 + cn * 64 + r4) = pk4(a); }
            else {
                f32x4 a = mm16<2>(mBtT, LB, mU0T, LB, mi, nj, lnv, (f32x4){0.f, 0.f, 0.f, 0.f}); a = mm16<2>(mKtT, LB, mVT, LB, mi, nj, lnv, a);
#pragma unroll
                for (int e = 0; e < 4; ++e) a[e] *= sDC[r4 + e];
                *(GAS v2u*)(WSP(bf16, WS_H0T) + inst * 4096 + cn * 64 + r4) = pk4(a); } }
    }
#undef MAT
#undef FRESH_LANE
    if (cg == 0) WSP(float, WS_BON)[(size_t)unit * 64 + t] = bonus;
}
__device__ __forceinline__ void phase_passA(KARG, Frame& F, int hf, int l) {
    for (int u = F.vcu; u < (MH / 64) * 6; u += F.G) passA_unit(KA, F, hf, l, u);
}
__device__ __forceinline__ void phase_passB(Frame& F, int hf) {
    const int nchain = hf ? 12 : 24, nck = hf ? 256 : 128;
    const int unit = F.vcu * NWAVES + F.wave;
    const int uu = (F.wave) * F.G + F.vcu;
    if (uu >= nchain * 4) return; (void)unit;
    const int chain = uu >> 2, cgp = uu & 3; const int d = chain & 1, h = (chain >> 1) % 6, s = (chain >> 1) / 6;
    const int lane = F.lane, c16 = lane & 15, q = lane >> 4, v = 16 * cgp + c16;
    f32x4 hacc[4];
#pragma unroll
    for (int m = 0; m < 4; ++m) hacc[m] = (f32x4){0.f, 0.f, 0.f, 0.f};
    const bf16* GP = WSP(bf16, WS_GP); const bf16* H0T = WSP(bf16, WS_H0T); const float* DC = WSP(float, WS_DC); bf16* HC = WSP(bf16, WS_HC);
    v2u ga[4][2][2]; v2u h0[4]; f32x4 dc[4];
#define PB_LOAD(GA, H0_, DC_, STEP) do { const int cl_ = d ? nck - 1 - (STEP) : (STEP); const size_t in_ = ((size_t)(s * nck + cl_) * 6 + h) * 2 + d; \
        _Pragma("unroll") for (int mo = 0; mo < 4; ++mo) { const bf16* gr = GP + in_ * 4096 + (16 * mo + c16) * 64 + 4 * q; \
            _Pragma("unroll") for (int ks = 0; ks < 2; ++ks) { GA[mo][ks][0] = *(const GAS v2u*)(gr + 32 * ks); GA[mo][ks][1] = *(const GAS v2u*)(gr + 32 * ks + 16); } \
            H0_[mo] = *(const GAS v2u*)(H0T + in_ * 4096 + v * 64 + 16 * mo + 4 * q); DC_[mo] = *(const GAS f32x4*)(DC + in_ * 64 + 16 * mo + 4 * q); } } while (0)
    PB_LOAD(ga, h0, dc, 0);
    for (int step = 0; step < nck; ++step) {
        const int cl = d ? nck - 1 - step : step; const size_t inst = ((size_t)(s * nck + cl) * 6 + h) * 2 + d;
        v2u gan[4][2][2]; v2u h0n[4]; f32x4 dcn[4];
        { const int sn = (step + 1 < nck) ? step + 1 : step; PB_LOAD(gan, h0n, dcn, sn); }
        v2u hb[4];
#pragma unroll
        for (int m = 0; m < 4; ++m) { hb[m].x = cvtpk(hacc[m][0], hacc[m][1]); hb[m].y = cvtpk(hacc[m][2], hacc[m][3]); *(GAS v2u*)(HC + inst * 4096 + v * 64 + 16 * m + 4 * q) = hb[m]; }
        bf16x8 bfr[2];
#pragma unroll
        for (int ks = 0; ks < 2; ++ks) { v4u t4; t4.x = hb[2 * ks].x; t4.y = hb[2 * ks].y; t4.z = hb[2 * ks + 1].x; t4.w = hb[2 * ks + 1].y; bfr[ks] = __builtin_bit_cast(bf16x8, t4); }
#pragma unroll
        for (int mo = 0; mo < 4; ++mo) { f32x4 cin;
            cin[0] = dc[mo][0] * hacc[mo][0] + bflo(h0[mo].x); cin[1] = dc[mo][1] * hacc[mo][1] + bfhi(h0[mo].x); cin[2] = dc[mo][2] * hacc[mo][2] + bflo(h0[mo].y); cin[3] = dc[mo][3] * hacc[mo][3] + bfhi(h0[mo].y);
#pragma unroll
            for (int ks = 0; ks < 2; ++ks) { v4u a4; a4.x = ga[mo][ks][0].x; a4.y = ga[mo][ks][0].y; a4.z = ga[mo][ks][1].x; a4.w = ga[mo][ks][1].y; cin = mfma16(__builtin_bit_cast(bf16x8, a4), bfr[ks], cin); }
            hacc[mo] = cin; }
#pragma unroll
        for (int mo = 0; mo < 4; ++mo) { h0[mo] = h0n[mo]; dc[mo] = dcn[mo];
#pragma unroll
            for (int ks = 0; ks < 2; ++ks) { ga[mo][ks][0] = gan[mo][ks][0]; ga[mo][ks][1] = gan[mo][ks][1]; } }
    }
#undef PB_LOAD
}
__device__ __forceinline__ void passC_unit(KARG, Frame& F, int hf, int l, int unit) {
    const int lane = F.lane, c31 = lane & 31, hh = lane >> 5; const int ci = unit / 6, h = unit % 6; const int rr0 = ci * 64;
    const int T = hf ? 16384 : 8192; const int sbase = hf ? 0 : (rr0 & ~8191);
    const bf16* PX = WSP(bf16, WS_PX); const bf16* RY = WSP(bf16, WS_RY); const bf16* Y0 = WSP(bf16, WS_Y0); const bf16* HC = WSP(bf16, WS_HC);
    f32x16 acc[2][2];
#pragma unroll
    for (int mt = 0; mt < 2; ++mt)
#pragma unroll
        for (int nt = 0; nt < 2; ++nt) { f32x16 a;
#pragma unroll
            for (int g = 0; g < 4; ++g) { float s4[4] = {0.f, 0.f, 0.f, 0.f};
#pragma unroll
                for (int d = 0; d < 2; ++d) { const size_t inst = ((size_t)ci * 6 + h) * 2 + d; const v2u w = *(const GAS v2u*)(Y0 + inst * 4096 + (32 * nt + c31) * 64 + 32 * mt + 8 * g + 4 * hh);
                    s4[0] += bflo(w.x); s4[1] += bfhi(w.x); s4[2] += bflo(w.y); s4[3] += bfhi(w.y); }
                a[4 * g] = s4[0]; a[4 * g + 1] = s4[1]; a[4 * g + 2] = s4[2]; a[4 * g + 3] = s4[3]; }
            acc[mt][nt] = a; }
#pragma unroll
    for (int d = 0; d < 2; ++d) { const size_t inst = ((size_t)ci * 6 + h) * 2 + d;
#pragma unroll
        for (int ks = 0; ks < 4; ++ks) { bf16x8 af[2], bf_[2];
#pragma unroll
            for (int x = 0; x < 2; ++x) { af[x] = *(const GAS bf16x8*)(HC + inst * 4096 + (32 * x + c31) * 64 + 16 * ks + 8 * hh); bf_[x] = *(const GAS bf16x8*)(RY + inst * 4096 + (32 * x + c31) * 64 + 16 * ks + 8 * hh); }
#pragma unroll
            for (int mt = 0; mt < 2; ++mt)
#pragma unroll
                for (int nt = 0; nt < 2; ++nt) acc[mt][nt] = mfma32(af[mt], bf_[nt], acc[mt][nt]); } }
    f32x16 gacc[2][2] = {};
    { const bf16* GUT = WSP(bf16, WS_SMALL) + (size_t)l * RW * 128;
#pragma unroll
      for (int ks = 0; ks < 8; ++ks) { bf16x8 af[2], bf_[2];
#pragma unroll
          for (int x = 0; x < 2; ++x) { af[x] = *(const GAS bf16x8*)(GUT + (size_t)(h * 64 + 32 * x + c31) * 128 + 16 * ks + 8 * hh);
              const v4u w = *(const GAS v4u*)(PX + (size_t)(rr0 + 32 * x + c31) * PXW + 1280 + 16 * ks + 8 * hh); v4u o;
              o.x = cvtpk(sigmoidf_(bflo(w.x)), sigmoidf_(bfhi(w.x))); o.y = cvtpk(sigmoidf_(bflo(w.y)), sigmoidf_(bfhi(w.y))); o.z = cvtpk(sigmoidf_(bflo(w.z)), sigmoidf_(bfhi(w.z))); o.w = cvtpk(sigmoidf_(bflo(w.w)), sigmoidf_(bfhi(w.w)));
              bf_[x] = __builtin_bit_cast(bf16x8, o); }
#pragma unroll
          for (int mt = 0; mt < 2; ++mt)
#pragma unroll
              for (int nt = 0; nt < 2; ++nt) gacc[mt][nt] = mfma32(af[mt], bf_[nt], gacc[mt][nt]); } }
    const float* gng = KA.in[I_GNG] + l * RW + h * 64; const float* gnb = KA.in[I_GNB] + l * RW + h * 64; const float* cw = KA.in[I_CONV] + (size_t)l * 3 * 1152 + 768 + h * 64;
    bf16* MIX = WSP(bf16, WS_MIX);
#pragma unroll
    for (int nt = 0; nt < 2; ++nt) { const int t = 32 * nt + c31; const int tl = rr0 - sbase + t;
        float s1 = 0.f;
#pragma unroll
        for (int mt = 0; mt < 2; ++mt)
#pragma unroll
            for (int i = 0; i < 16; ++i) s1 += acc[mt][nt][i];
        s1 += shx(s1, 32, lane); const float mu = s1 * (1.0f / 64.0f); float s2 = 0.f;
#pragma unroll
        for (int mt = 0; mt < 2; ++mt)
#pragma unroll
            for (int i = 0; i < 16; ++i) { const float dlt = acc[mt][nt][i] - mu; s2 += dlt * dlt; }
        s2 += shx(s2, 32, lane); const float rstd = 1.0f / sqrtf(s2 * (1.0f / 64.0f) + GN_EPS);
        const float bon = WSP(float, WS_BON)[(size_t)unit * 64 + t];
#pragma unroll
        for (int mt = 0; mt < 2; ++mt)
#pragma unroll
            for (int g = 0; g < 4; ++g) { const int j0 = 32 * mt + 8 * g + 4 * hh; float vv[4] = {0.f, 0.f, 0.f, 0.f};
#pragma unroll
                for (int tap = 0; tap < 3; ++tap) { const int tq = tl + tap - 1; if (tq >= 0 && tq < T) { const v2u w = *(const GAS v2u*)(PX + (size_t)(sbase + tq) * PXW + 768 + h * 64 + j0); const f32x4 cwv = *(const GAS f32x4*)(cw + tap * 1152 + j0);
                    vv[0] += bflo(w.x) * cwv[0]; vv[1] += bfhi(w.x) * cwv[1]; vv[2] += bflo(w.y) * cwv[2]; vv[3] += bfhi(w.y) * cwv[3]; } }
                const f32x4 gg = *(const GAS f32x4*)(gng + j0), gb = *(const GAS f32x4*)(gnb + j0); float o4[4];
#pragma unroll
                for (int e = 0; e < 4; ++e) { const float y = (acc[mt][nt][4 * g + e] - mu) * rstd * gg[e] + gb[e] + bon * vv[e]; o4[e] = y * gacc[mt][nt][4 * g + e]; }
                v2u o; o.x = pk2(o4[0], o4[1]); o.y = pk2(o4[2], o4[3]); *(GAS v2u*)(MIX + (size_t)(rr0 + t) * D + 256 + h * 64 + j0) = o; } }
}
__device__ __forceinline__ void phase_passC(KARG, Frame& F, int hf, int l) {
    const int gw = F.vcu * NWAVES + F.wave, NGW = F.G * NWAVES;
    for (int u = gw; u < (MH / 64) * 6; u += NGW) passC_unit(KA, F, hf, l, u);
}
constexpr int NPHASE = 47;
__global__ void __launch_bounds__(NWAVES * 64, 2) mega_fwd(Args args) {
    const Args& KA = args;
    extern __shared__ __attribute__((aligned(16))) unsigned char lds[];
    Frame F;
    F.lds = (LAS unsigned char*)lds; F.MISC = (volatile LAS unsigned*)(F.lds + MISC_OFF);
    F.tid = threadIdx.x; F.lane = F.tid & 63; F.wave = __builtin_amdgcn_readfirstlane(F.tid >> 6);
    F.G = gridDim.x; { const int bx = blockIdx.x; F.vcu = (F.G % 8 == 0) ? (bx % 8) * (F.G / 8) + bx / 8 : bx; }
    F.ws = args.ws; F.ctl = (gu32*)(args.ws + WS_CTL); F.out = args.out;
    for (int u = F.tid; u < (LDS_BYTES - LDSCTL_OFF) / 4; u += NWAVES * 64) ((LAS unsigned*)(F.lds + LDSCTL_OFF))[u] = 0u;
    __syncthreads();
    XcdBarrier bar; bar.bar = (unsigned*)(F.ctl + CW_BAR) + args.li * XCD_BAR_WORDS; bar.x = 0; bar.st = nullptr;
    const bool multi = (args.ph_hi - args.ph_lo) > 1;
    if (multi) bar = xcd_barrier_post((unsigned*)(F.ctl + CW_BAR) + args.li * XCD_BAR_WORDS, F.MISC + 8);
    for (int p = args.ph_lo; p < args.ph_hi; ++p) {
        { int tv = threadIdx.x; asm volatile("" : "+v"(tv)); F.tid = tv; F.lane = tv & 63; F.wave = __builtin_amdgcn_readfirstlane(tv >> 6); }
        if (p == 0) { if ((PHM >> 11) & 1) phase_weights(args, F); }
        else {
            const int qq = p - 1, hf = qq / 23, r = qq % 23;
            if (r == 0) { if ((PHM >> 12) & 1) phase_xn_init(args, F, hf); }
            else {
                const int l = (r - 1) / 11, k = (r - 1) % 11;
                unsigned char* wl = F.ws + WS_W + (size_t)l * W_LAYER;
                const int nrep = (k == REPK) ? 2 : 1;
                for (int rep = 0; rep < nrep; ++rep) {
                if (rep) xcd_barrier(bar);
                { int tv = threadIdx.x; asm volatile("" : "+v"(tv)); F.tid = tv; F.lane = tv & 63; F.wave = __builtin_amdgcn_readfirstlane(tv >> 6); }
                if (k == 0 || k == 6 || k == 8 || k == 9) {
                    const bf16* Aop; const bf16* Bop; int Nn, Kk; pg8::EpiGen E;
                    if (k == 0) { Aop = WSP(bf16, WS_XN); Bop = (const bf16*)(wl + W_IN); Nn = NIN; Kk = D; E = pg8::EpiGen{WSP(bf16, WS_PY), WSP(bf16, WS_PX), 1408, PXW, PXW, 0}; }
                    else if (k == 6) { Aop = WSP(bf16, WS_MIX); Bop = (const bf16*)(wl + W_OUT); Nn = D; Kk = D; E = pg8::EpiGen{WSP(bf16, WS_F1), WSP(bf16, WS_F1), 1 << 30, D, D, 0}; }
                    else if (k == 8) { Aop = WSP(bf16, WS_XN); Bop = (const bf16*)(wl + W_FFI); Nn = FF; Kk = D; E = pg8::EpiGen{WSP(bf16, WS_H), WSP(bf16, WS_H), 1 << 30, FF, FF, 2}; }
                    else { Aop = WSP(bf16, WS_H); Bop = (const bf16*)(wl + W_FFO); Nn = D; Kk = FF; E = pg8::EpiGen{WSP(bf16, WS_XN), WSP(bf16, WS_XN), 1 << 30, D, D, 0}; }
                    pg8::Gemm g{Aop, Bop, MH, Nn, Kk}; pg8::StaticOrder S; S.init(MH, Nn, F.G, (int)blockIdx.x);
                    pg8::gemm_phase<pg8::EpiGen, pg8::StaticOrder, true, true>(F.lds + RING_OFF, g, S, E, F.tid);
                } else
                switch (k) {
                case 1: if ((PHM >> 1) & 1) phase_pool_attn(args, F, hf, l); break;
                case 2: if ((PHM >> 2) & 1) phase_attn_merge(F); break;
                case 3: if ((PHM >> 3) & 1) phase_passA(args, F, hf, l); break;
                case 4: if ((PHM >> 4) & 1) phase_passB(F, hf); break;
                case 5: if ((PHM >> 5) & 1) phase_passC(args, F, hf, l); break;
                case 7: if ((PHM >> 7) & 1) { const float* base = (l == 0) ? KA.in[hf ? I_XS : I_XP] : (F.out + (size_t)hf * MH * D);
                          phase_rowpass(args, F, hf, WSP(bf16, WS_F1), base, KA.in[I_NMPOST] + l * D, KA.in[I_NFPRE] + l * D); } break;
                default: if ((PHM >> 10) & 1) { phase_rowpass(args, F, hf, WSP(bf16, WS_XN), F.out + (size_t)hf * MH * D, KA.in[I_NFPOST] + l * D, (l == 0) ? (KA.in[I_NMPRE] + D) : nullptr); } break;
                }
                }
            }
        }
        if (p + 1 < args.ph_hi) xcd_barrier(bar);
    }
}

extern "C" void kernel_launch(void* const* d_in, const int* in_sizes, int n_in, void* d_out, int out_size, void* d_ws, size_t ws_size, hipStream_t stream) {
    static int grid = 0;
    if (grid == 0) {
        if (n_in != 24 || out_size != 2 * MH * D || ws_size < WS_END) { fprintf(stderr, "kernel_launch: unexpected problem shape (n_in %d out %d ws %zu)\n", n_in, out_size, ws_size); grid = -1; return; }
        int dev = 0, cus = 0;
        if (hipGetDevice(&dev) != hipSuccess || hipDeviceGetAttribute(&cus, hipDeviceAttributeMultiprocessorCount, dev) != hipSuccess) { grid = -1; return; }
        if (hipFuncSetAttribute((const void*)mega_fwd, hipFuncAttributeMaxDynamicSharedMemorySize, LDS_BYTES) != hipSuccess) { fprintf(stderr, "kernel_launch: hipFuncSetAttribute failed\n"); grid = -1; return; }
        int per_cu = 0; (void)hipOccupancyMaxActiveBlocksPerMultiprocessor(&per_cu, (const void*)mega_fwd, NWAVES * 64, LDS_BYTES); (void)hipGetLastError();
        grid = cus;
    }
    if (grid < 0) return;
    (void)hipMemsetAsync((char*)d_ws + WS_CTL, 0, CTL_ZERO_BYTES, stream);
    Args a{};
    for (int i = 0; i < 24; ++i) a.in[i] = (const float*)d_in[i];
    a.out = (float*)d_out; a.ws = (unsigned char*)d_ws;
#if MK_N_LAUNCHES == 1
    a.ph_lo = 0; a.ph_hi = NPHASE; a.li = 0;
    hipLaunchKernelGGL(mega_fwd, dim3(grid), dim3(NWAVES * 64), LDS_BYTES, stream, a);
#else
    for (int p = 0; p < NPHASE; ++p) { a.ph_lo = p; a.ph_hi = p + 1; a.li = 0; hipLaunchKernelGGL(mega_fwd, dim3(grid), dim3(NWAVES * 64), LDS_BYTES, stream, a); }
#endif
}
```

```cpp
#include <hip/hip_runtime.h>
#include <cstdio>
#include <cstdint>
#ifndef REPK
#define REPK -1
#endif
#ifndef PHM
#define PHM 0xFFFF
#endif
#ifndef MK_N_LAUNCHES
#define MK_N_LAUNCHES 1
#endif
namespace pg8 {
#define PG8_LAS __attribute__((address_space(3)))
typedef unsigned short bf16_t;
typedef short bf16x8 __attribute__((ext_vector_type(8)));
typedef float f32x4 __attribute__((ext_vector_type(4)));
typedef unsigned u32x4 __attribute__((ext_vector_type(4)));
constexpr int BM = 256, BK = 64, HALF = 128, HTB = HALF * BK * 2  , STAGE_BYTES = 8 * HTB, NXCD = 8, WGM = 8;

__host__ __device__ __forceinline__ int lds_byte(int r, int c) { const int st = (r >> 4) * 2 + (c >> 5), rr = r & 15, cc = c & 31, ob = rr * 64 + cc * 2; return st * 1024 + (ob ^ (((ob >> 9) & 1) << 5)); }
__host__ __device__ __forceinline__ void stage_rc(int b, int& R, int& C) { const int st = b / 1024, sb = b % 1024, swz = sb ^ (((sb >> 9) & 1) << 5); R = (st >> 1) * 16 + swz / 64; C = (st & 1) * 32 + (swz % 64) / 2; }
__host__ __device__ __forceinline__ int perm32(int rho) { const int n = rho >> 4, i = rho & 15; return 8 * (i >> 2) + 4 * n + (i & 3); }

struct Unit { int pm, pn; };
struct Gemm { const bf16_t* A; const bf16_t* Bt; int M, N, K; };

struct StaticOrder {
    int nM, nN, nwg, G, c;
    __host__ __device__ void init(int M, int N, int G_, int c_) { nM = M / BM; nN = N / BM; nwg = nM * nN; G = G_; c = c_; }
    __host__ __device__ bool next(int i, Unit& u) const {
        const long L = (long)i * G + c; if (L >= nwg) return false;
        int wgid = (int)L; { const int q = nwg / NXCD, r = nwg % NXCD, xcd = wgid % NXCD, off = wgid / NXCD; wgid = (xcd < r ? xcd * (q + 1) : r * (q + 1) + (xcd - r) * q) + off; }
        const int nig = WGM * nN, gid = wgid / nig, fm = gid * WGM, gsz = (nM - fm) < WGM ? (nM - fm) : WGM;
        u.pm = fm + ((wgid % nig) % gsz); u.pn = (wgid % nig) / gsz; return true;
    }
    __device__ __forceinline__ void a_ready(const Unit&) const {}
    __device__ __forceinline__ void done(const Unit&) const {}
};

__device__ __forceinline__ unsigned cvt_pk_bf16(float lo, float hi) { unsigned r; asm volatile("v_cvt_pk_bf16_f32 %0, %1, %2" : "=v"(r) : "v"(lo), "v"(hi)); return r; }
template <int ACT> struct EpiBf16 {
    static constexpr bool PERM = true, AFTER_DRAIN = false;
    bf16_t* O; int ldc;
    __device__ __forceinline__ void operator()(const f32x4 (&acc)[2][2][4][2], const Unit& u, int wr, int wc, int fr, int fq) const {
        const int row0 = u.pm * BM + wr * 64 + fr; const int col0 = u.pn * BM + wc * 32 + 8 * fq;
#pragma unroll
        for (int ai = 0; ai < 2; ++ai)
#pragma unroll
            for (int m = 0; m < 4; ++m) { bf16_t* rowp = O + (size_t)(row0 + ai * HALF + m * 16) * ldc + col0;
#pragma unroll
                for (int bj = 0; bj < 2; ++bj) { f32x4 v0 = acc[ai][bj][m][0], v1 = acc[ai][bj][m][1];
                    if (ACT == 2) {
#pragma unroll
                        for (int e = 0; e < 4; ++e) { float a = fmaxf(v0[e], 0.f), b = fmaxf(v1[e], 0.f); v0[e] = a * a; v1[e] = b * b; } }
                    u32x4 w; w.x = cvt_pk_bf16(v0[0], v0[1]); w.y = cvt_pk_bf16(v0[2], v0[3]); w.z = cvt_pk_bf16(v1[0], v1[1]); w.w = cvt_pk_bf16(v1[2], v1[3]);
                    *(u32x4*)(rowp + bj * HALF) = w; } }
    }
};
struct EpiGen {
    static constexpr bool PERM = true, AFTER_DRAIN = false;
    bf16_t* O0; bf16_t* O1; int split, ld0, ld1, act;
    __device__ __forceinline__ void operator()(const f32x4 (&acc)[2][2][4][2], const Unit& u, int wr, int wc, int fr, int fq) const {
        const int row0 = u.pm * BM + wr * 64 + fr;
#pragma unroll
        for (int bj = 0; bj < 2; ++bj) {
            const int g0 = u.pn * BM + bj * HALF; const bool lo = g0 < split; bf16_t* base = lo ? (O0 + g0) : (O1 + (g0 - split)); const int ld = lo ? ld0 : ld1;
            base += wc * 32 + 8 * fq;
#pragma unroll
            for (int ai = 0; ai < 2; ++ai)
#pragma unroll
                for (int m = 0; m < 4; ++m) { f32x4 v0 = acc[ai][bj][m][0], v1 = acc[ai][bj][m][1];
                    if (act) {
#pragma unroll
                        for (int e = 0; e < 4; ++e) { const float a = fmaxf(v0[e], 0.f), b = fmaxf(v1[e], 0.f); v0[e] = a * a; v1[e] = b * b; } }
                    u32x4 w; w.x = cvt_pk_bf16(v0[0], v0[1]); w.y = cvt_pk_bf16(v0[2], v0[3]); w.z = cvt_pk_bf16(v1[0], v1[1]); w.w = cvt_pk_bf16(v1[2], v1[3]);
                    *(u32x4*)(base + (size_t)(row0 + ai * HALF + m * 16) * ld) = w; } }
    }
};
struct EpiRoute {
    static constexpr bool PERM = true, AFTER_DRAIN = false;
    bf16_t* PY; bf16_t* PX;
    __device__ __forceinline__ void operator()(const f32x4 (&acc)[2][2][4][2], const Unit& u, int wr, int wc, int fr, int fq) const {
        const int row0 = u.pm * BM + wr * 64 + fr;
#pragma unroll
        for (int bj = 0; bj < 2; ++bj) {
            const int g0 = u.pn * BM + bj * HALF; bf16_t* base = (g0 < 1408) ? (PY + g0) : (PX + (g0 - 1408));
            base += wc * 32 + 8 * fq;
#pragma unroll
            for (int ai = 0; ai < 2; ++ai)
#pragma unroll
                for (int m = 0; m < 4; ++m) { const f32x4 v0 = acc[ai][bj][m][0], v1 = acc[ai][bj][m][1];
                    u32x4 w; w.x = cvt_pk_bf16(v0[0], v0[1]); w.y = cvt_pk_bf16(v0[2], v0[3]); w.z = cvt_pk_bf16(v1[0], v1[1]); w.w = cvt_pk_bf16(v1[2], v1[3]);
                    *(u32x4*)(base + (size_t)(row0 + ai * HALF + m * 16) * 1408) = w; } }
    }
};
template <class Epi, class Sched, bool ALIGN_EPI = false, bool SP2 = false>
__device__ __forceinline__ void gemm_phase(PG8_LAS unsigned char* lds, const Gemm g, const Sched& S, const Epi& E, const int tid) {
    const int wid = __builtin_amdgcn_readfirstlane(tid >> 6), lane = tid & 63, wr = wid >> 2, wc = wid & 3, fr = lane & 15, fq = lane >> 4;
    const int K = g.K, nt = K / BK;
    unsigned voffA[2], voffB[2];
#pragma unroll
    for (int i = 0; i < 2; ++i) { int R, C; stage_rc(tid * 16 + i * 8192, R, C); const int Rb = Epi::PERM ? ((R & ~31) + perm32(R & 31)) : R;
        voffA[i] = (unsigned)(R * K + C) * 2u; voffB[i] = (unsigned)(Rb * K + C) * 2u; }
    const size_t kstep = (size_t)(BK * 2);
    const size_t hstep = (size_t)HALF * K * 2;
    const size_t tstep = 2 * hstep;
    const unsigned ldsw = (unsigned)wid * 1024u;
    const int aoff = lds_byte(wr * 64 + fr, fq * 8), boff = lds_byte(wc * 32 + fr, fq * 8);
#define PG8_SA(b, h) (((b) * 2 + (h)) * HTB)
#define PG8_SB(b, h) ((4 + (b) * 2 + (h)) * HTB)
#define PG8_STAGE(bufoff, gbase, voff) do { _Pragma("unroll") for (int _i = 0; _i < 2; ++_i) \
        __builtin_amdgcn_global_load_lds((const unsigned*)((const char*)(gbase) + (voff)[_i]), (PG8_LAS unsigned*)(lds + (bufoff) + ldsw + _i * 8192), 16, 0, 0); } while (0)
#define PG8_LDA(dst, b, h) do { _Pragma("unroll") for (int m = 0; m < 4; ++m) _Pragma("unroll") for (int k = 0; k < 2; ++k) dst[m][k] = *(const PG8_LAS bf16x8*)(lds + PG8_SA(b, h) + aoff + m * 2048 + k * 1024); } while (0)
#define PG8_LDB(dst, b, h) do { _Pragma("unroll") for (int n = 0; n < 2; ++n) _Pragma("unroll") for (int k = 0; k < 2; ++k) dst[n][k] = *(const PG8_LAS bf16x8*)(lds + PG8_SB(b, h) + boff + n * 2048 + k * 1024); } while (0)
#define PG8_MMA(ai, bj, At, Bt) do { __builtin_amdgcn_s_setprio(1); _Pragma("unroll") for (int m = 0; m < 4; ++m) _Pragma("unroll") for (int n = 0; n < 2; ++n) _Pragma("unroll") for (int k = 0; k < 2; ++k) \
        acc[ai][bj][m][n] = __builtin_amdgcn_mfma_f32_16x16x32_bf16(Bt[n][k], At[m][k], acc[ai][bj][m][n], 0, 0, 0); __builtin_amdgcn_s_setprio(0); } while (0)
#define PG8_WAIT_V(n) asm volatile("s_waitcnt vmcnt(" #n ")" ::: "memory")
#define PG8_WAIT_L(n) asm volatile("s_waitcnt lgkmcnt(" #n ")" ::: "memory")
#define PG8_BAR __builtin_amdgcn_s_barrier()
#define PG8_SCHED __builtin_amdgcn_sched_barrier(0)
    Unit cur, nxt; int ui = 0;
    if (!S.next(0, cur)) return;
    f32x4 acc[2][2][4][2];
#pragma unroll
    for (int a = 0; a < 2; ++a)
#pragma unroll
        for (int b = 0; b < 2; ++b)
#pragma unroll
            for (int m = 0; m < 4; ++m)
#pragma unroll
                for (int n = 0; n < 2; ++n) acc[a][b][m][n] = (f32x4){0.f, 0.f, 0.f, 0.f};
    bf16x8 At[4][2], B0[2][2], B1[2][2];
    const char* cA = (const char*)g.A + (size_t)cur.pm * tstep; const char* cB = (const char*)g.Bt + (size_t)cur.pn * tstep;
    S.a_ready(cur);
    if constexpr (SP2) {
        PG8_STAGE(PG8_SB(0, 0), cB, voffB); PG8_STAGE(PG8_SB(0, 1), cB + hstep, voffB); PG8_STAGE(PG8_SA(0, 0), cA, voffA); PG8_STAGE(PG8_SA(0, 1), cA + hstep, voffA);
        if (wr == 1) PG8_BAR;
        PG8_WAIT_V(2); PG8_BAR;
        PG8_STAGE(PG8_SB(1, 0), cB + kstep, voffB); PG8_STAGE(PG8_SA(1, 0), cA + kstep, voffA); PG8_STAGE(PG8_SB(1, 1), cB + hstep + kstep, voffB);
        PG8_WAIT_V(6); PG8_BAR;
    } else {
        PG8_STAGE(PG8_SB(0, 0), cB, voffB); PG8_STAGE(PG8_SA(0, 0), cA, voffA); PG8_STAGE(PG8_SB(0, 1), cB + hstep, voffB); PG8_STAGE(PG8_SA(0, 1), cA + hstep, voffA);
        if (wr == 1) PG8_BAR;
        PG8_WAIT_V(4); PG8_BAR;
        PG8_STAGE(PG8_SB(1, 0), cB + kstep, voffB); PG8_STAGE(PG8_SA(1, 0), cA + kstep, voffA); PG8_STAGE(PG8_SB(1, 1), cB + hstep + kstep, voffB);
        PG8_WAIT_V(6); PG8_BAR;
    }
    for (;;) {
        const bool has_next = S.next(ui + 1, nxt);
        const char* nA = has_next ? (const char*)g.A + (size_t)nxt.pm * tstep : cA; const char* nB = has_next ? (const char*)g.Bt + (size_t)nxt.pn * tstep : cB;
        for (int t = 0; t < nt; t += 2) {
            const bool last = (t == nt - 2);
            const char* a1 = cA + (size_t)(t + 1) * kstep;
            const char* a2 = last ? nA : cA + (size_t)(t + 2) * kstep; const char* b2 = last ? nB : cB + (size_t)(t + 2) * kstep;
            const char* a3 = a2 + kstep; const char* b3 = b2 + kstep;
            if (last && has_next) S.a_ready(nxt);
            if constexpr (SP2) {
            PG8_LDB(B0, 0, 0); PG8_LDB(B1, 0, 1); PG8_SCHED; PG8_LDA(At, 0, 0); PG8_STAGE(PG8_SA(1, 1), a1 + hstep, voffA);
            PG8_WAIT_V(8); PG8_WAIT_L(0); PG8_BAR; PG8_MMA(0, 0, At, B0); PG8_MMA(0, 1, At, B1); PG8_BAR; PG8_SCHED;
            PG8_LDA(At, 0, 1); PG8_STAGE(PG8_SB(0, 0), b2, voffB); PG8_STAGE(PG8_SB(0, 1), b2 + hstep, voffB); PG8_STAGE(PG8_SA(0, 0), a2, voffA);
            PG8_WAIT_V(8); PG8_WAIT_L(0); PG8_BAR; PG8_MMA(1, 0, At, B0); PG8_MMA(1, 1, At, B1); PG8_BAR; PG8_SCHED;
            PG8_LDB(B0, 1, 0); PG8_LDB(B1, 1, 1); PG8_SCHED; PG8_LDA(At, 1, 0); PG8_STAGE(PG8_SA(0, 1), a2 + hstep, voffA);
            PG8_WAIT_V(8); PG8_WAIT_L(0); PG8_BAR; PG8_MMA(0, 0, At, B0); PG8_MMA(0, 1, At, B1); PG8_BAR; PG8_SCHED;
            PG8_LDA(At, 1, 1); PG8_STAGE(PG8_SB(1, 0), b3, voffB); PG8_STAGE(PG8_SB(1, 1), b3 + hstep, voffB); PG8_STAGE(PG8_SA(1, 0), a3, voffA);
            PG8_WAIT_V(8); PG8_WAIT_L(0); PG8_BAR; PG8_MMA(1, 0, At, B0); PG8_MMA(1, 1, At, B1); PG8_BAR; PG8_SCHED;
            } else {
            PG8_LDB(B0, 0, 0); PG8_SCHED; PG8_LDA(At, 0, 0); PG8_STAGE(PG8_SA(1, 1), a1 + hstep, voffA);
            PG8_WAIT_L(8); PG8_BAR; PG8_WAIT_L(0); PG8_MMA(0, 0, At, B0); PG8_BAR; PG8_SCHED;
            PG8_LDB(B1, 0, 1); PG8_STAGE(PG8_SB(0, 0), b2, voffB);
            PG8_BAR; PG8_WAIT_L(0); PG8_MMA(0, 1, At, B1); PG8_BAR;
            PG8_LDA(At, 0, 1); PG8_STAGE(PG8_SA(0, 0), a2, voffA);
            PG8_BAR; PG8_WAIT_L(0); PG8_MMA(1, 0, At, B0); PG8_BAR; PG8_SCHED;
            PG8_STAGE(PG8_SB(0, 1), b2 + hstep, voffB);
            PG8_WAIT_V(6); PG8_BAR; PG8_MMA(1, 1, At, B1); PG8_BAR;
            PG8_LDB(B0, 1, 0); PG8_SCHED; PG8_LDA(At, 1, 0); PG8_STAGE(PG8_SA(0, 1), a2 + hstep, voffA);
            PG8_WAIT_L(8); PG8_BAR; PG8_WAIT_L(0); PG8_MMA(0, 0, At, B0); PG8_BAR; PG8_SCHED;
            PG8_LDB(B1, 1, 1); PG8_STAGE(PG8_SB(1, 0), b3, voffB);
            PG8_BAR; PG8_WAIT_L(0); PG8_MMA(0, 1, At, B1); PG8_BAR;
            PG8_LDA(At, 1, 1); PG8_STAGE(PG8_SA(1, 0), a3, voffA);
            PG8_BAR; PG8_WAIT_L(0); PG8_MMA(1, 0, At, B0); PG8_BAR; PG8_SCHED;
            PG8_STAGE(PG8_SB(1, 1), b3 + hstep, voffB);
            PG8_WAIT_V(6); PG8_BAR; PG8_MMA(1, 1, At, B1); PG8_BAR;
            }
        }
        if constexpr (ALIGN_EPI) { if (wr == 0) PG8_BAR; }
        if constexpr (!Epi::AFTER_DRAIN) { E(acc, cur, wr, wc, fr, fq); S.done(cur); }
        if (!has_next) break;
#pragma unroll
        for (int a = 0; a < 2; ++a)
#pragma unroll
            for (int b = 0; b < 2; ++b)
#pragma unroll
                for (int m = 0; m < 4; ++m)
#pragma unroll
                    for (int n = 0; n < 2; ++n) acc[a][b][m][n] = (f32x4){0.f, 0.f, 0.f, 0.f};
        cur = nxt; cA = nA; cB = nB; ++ui;
        if constexpr (ALIGN_EPI) { if (wr == 1) PG8_BAR; }
    }
    PG8_WAIT_V(0);
    if constexpr (!ALIGN_EPI) { if (wr == 0) PG8_BAR; }
    PG8_BAR;
    if constexpr (Epi::AFTER_DRAIN) { E.fused(acc, cur, wr, wc, fr, fq, lds, wid, lane); S.done(cur); }
#undef PG8_SA
#undef PG8_SB
#undef PG8_STAGE
#undef PG8_LDA
#undef PG8_LDB
#undef PG8_MMA
#undef PG8_WAIT_V
#undef PG8_WAIT_L
#undef PG8_BAR
#undef PG8_SCHED
}
}
#define GAS __attribute__((address_space(1)))
#define LAS __attribute__((address_space(3)))
typedef unsigned short bf16;
typedef unsigned v4u __attribute__((ext_vector_type(4)));
typedef float f32x4 __attribute__((ext_vector_type(4)));
typedef short bf16x8 __attribute__((ext_vector_type(8)));
typedef GAS unsigned gu32;
typedef GAS unsigned long long gu64;
#define RLX_AGENT __ATOMIC_RELAXED, __HIP_MEMORY_SCOPE_AGENT
#define LDS_WAIT() asm volatile("s_waitcnt lgkmcnt(0)" ::: "memory")
#define VM_WAIT() asm volatile("s_waitcnt vmcnt(0)" ::: "memory")
__device__ __forceinline__ unsigned long long rt() { return __builtin_amdgcn_s_memrealtime(); }
__device__ __forceinline__ unsigned f2bf(float f) { unsigned u = __builtin_bit_cast(unsigned, f); return (u + 0x7fffu + ((u >> 16) & 1u)) >> 16; }
__device__ __forceinline__ unsigned pk2(float lo, float hi) { return f2bf(lo) | (f2bf(hi) << 16); }

#define XB_TMO      128
#define XB_XCNT(j)  (256  + 64 * (j))
#define XB_XSUB(j)  (1280 + 64 * (j))
#define XB_XGEN(j)  (2304 + 64 * (j))
#define XB_TOP      3328
#define XB_TOPGEN   3392
#define XCD_BAR_WORDS 3456
#define XB_SPIN_CAP (1u << 18)

__device__ __forceinline__ unsigned xb_ld(unsigned* p)              { return __hip_atomic_load(p, __ATOMIC_RELAXED, __HIP_MEMORY_SCOPE_AGENT); }
__device__ __forceinline__ unsigned xb_add(unsigned* p, unsigned v) { return __hip_atomic_fetch_add(p, v, __ATOMIC_RELAXED, __HIP_MEMORY_SCOPE_AGENT); }
__device__ __forceinline__ unsigned xb_xcc_id() { return (unsigned)__builtin_amdgcn_s_getreg((3 << 11) | 20) & 0xFu; }
#define XB_SPIN(cond, bar) do { unsigned _sp = 0; while (cond) { __builtin_amdgcn_s_sleep(1); \
    if ((++_sp & 255u) == 0u) { if (xb_ld(&(bar)[XB_TMO])) break; if (_sp > XB_SPIN_CAP) { atomicAdd(&(bar)[XB_TMO], 1u); break; } } } } while (0)

struct XcdBarrier {
    unsigned* bar; unsigned x;
    volatile LAS unsigned* st;
};

__device__ __forceinline__ XcdBarrier xcd_barrier_post(unsigned* bar, volatile LAS unsigned* st) {
    XcdBarrier b; b.bar = bar; b.x = xb_xcc_id(); b.st = st;
    if (threadIdx.x == 0) (void)xb_add(&bar[XB_XCNT(b.x)], 1u);
    return b;
}
__device__ __forceinline__ void xcd_barrier_complete(unsigned* bar, unsigned x, unsigned& nloc, unsigned& nx) {
    const unsigned G = gridDim.x * gridDim.y * gridDim.z;
    unsigned sum, cnt, mine, sp = 0u;
    for (;;) {
        sum = 0u; cnt = 0u; mine = 0u;
#pragma unroll
        for (unsigned j = 0; j < 16; ++j) { const unsigned c = xb_ld(&bar[XB_XCNT(j)]); sum += c; cnt += (c > 0u) ? 1u : 0u; mine = (j == x) ? c : mine; }
        if (sum == G) break;
        __builtin_amdgcn_s_sleep(1);
        if ((++sp & 255u) == 0u) { if (xb_ld(&bar[XB_TMO])) break; if (sp > XB_SPIN_CAP) { atomicAdd(&bar[XB_TMO], 1u); break; } }
    }
    nloc = mine > 0u ? mine : 1u; nx = cnt > 0u ? cnt : 1u;
}

__device__ __forceinline__ void xcd_barrier(const XcdBarrier& b) {
    asm volatile("s_waitcnt vmcnt(0)" ::: "memory");
    __syncthreads();
    if (threadIdx.x == 0) {
        unsigned* bar = b.bar;
        __builtin_amdgcn_s_waitcnt(0);
        unsigned nloc = b.st[0], nx = b.st[1];
        if (nloc == 0u) { xcd_barrier_complete(bar, b.x, nloc, nx); b.st[0] = nloc; b.st[1] = nx; }
        const unsigned old = xb_add(&bar[XB_XSUB(b.x)], 1u);
        const unsigned gen = old / nloc;
        if (old + 1u == (gen + 1u) * nloc) {
            __builtin_amdgcn_fence(__ATOMIC_RELEASE, "agent");
            asm volatile("s_waitcnt vmcnt(0)" ::: "memory");
            const unsigned og = xb_add(&bar[XB_TOP], 1u);
            const unsigned tg = og / nx;
            if (og + 1u == (tg + 1u) * nx) xb_add(&bar[XB_TOPGEN], 1u);
            else XB_SPIN(xb_ld(&bar[XB_TOPGEN]) == tg, bar);
            __builtin_amdgcn_fence(__ATOMIC_ACQUIRE, "agent");
            xb_add(&bar[XB_XGEN(b.x)], 1u);
            asm volatile("s_waitcnt vmcnt(0)" ::: "memory");
        } else {
            XB_SPIN(xb_ld(&bar[XB_XGEN(b.x)]) == gen, bar);
            __builtin_amdgcn_fence(__ATOMIC_ACQUIRE, "agent");
            asm volatile("s_waitcnt vmcnt(0)" ::: "memory");
        }
    }
    __syncthreads();
}
constexpr int NWAVES = 8;
constexpr int D = 1024, MH = 16384, NIN = 2816, FF = 4096, RW = 384, NH = 6, PXW = 1408;
constexpr float NORM_EPS = 1e-6f, GN_EPS = 64e-5f, LOG2E = 1.4426950408889634f, LN2 = 0.6931471805599453f;
enum { I_XP = 0, I_XS, I_NMPRE, I_NMPOST, I_NFPRE, I_NFPOST, I_WIN, I_WOUT, I_POOLW, I_POOLS, I_CONV, I_DW0, I_DUP, I_IA0, I_IUP, I_GUP, I_KK, I_KA, I_BRK, I_GNG, I_GNB, I_RELB, I_WFI, I_WFO };
constexpr size_t MiB = 1u << 20;
constexpr size_t WS_CTL = 0, CTL_ZERO_BYTES = 1 * MiB;
constexpr size_t WS_SMALL = 1 * MiB;
constexpr size_t WS_W = 2 * MiB, W_LAYER = 47 * MiB / 2;
constexpr size_t W_IN = 0, W_OUT = 11 * MiB / 2, W_FFI = 15 * MiB / 2, W_FFO = 31 * MiB / 2;
constexpr size_t WS_XN = 51 * MiB, WS_MIX = 83 * MiB, WS_PX = 115 * MiB, WS_PY = 159 * MiB, WS_FREE = 203 * MiB, WS_END = 256 * MiB;
constexpr size_t WS_H = 115 * MiB;
constexpr size_t WS_F1 = 159 * MiB;
constexpr size_t WS_OB = 203 * MiB, WS_LSE = 239 * MiB;
constexpr size_t WS_GP = 159 * MiB, WS_H0T = 183 * MiB, WS_RY = 207 * MiB, WS_Y0 = 231 * MiB, WS_HC = 51 * MiB, WS_DC = 75 * MiB, WS_BON = 76 * MiB;
constexpr int CW_TMO = 0, CW_CODE = 1, CW_BAR = 4096;
constexpr int RING_OFF = 0, RING_BYTES = 131072, LDSCTL_OFF = RING_BYTES, MISC_OFF = LDSCTL_OFF + 320, LDS_BYTES = 147456;
typedef float f32x16 __attribute__((ext_vector_type(16)));
typedef unsigned v2u __attribute__((ext_vector_type(2)));
typedef float f32x2_t __attribute__((ext_vector_type(2))); typedef __bf16 bf16x2_t __attribute__((ext_vector_type(2)));
__device__ __forceinline__ unsigned cvtpk(float lo, float hi) { f32x2_t v = {lo, hi}; bf16x2_t b = __builtin_convertvector(v, bf16x2_t); return __builtin_bit_cast(unsigned, b); }
__device__ __forceinline__ float bf2f(unsigned u) { return __builtin_bit_cast(float, u << 16); }
__device__ __forceinline__ float bflo(unsigned w) { return __builtin_bit_cast(float, w << 16); }
__device__ __forceinline__ float bfhi(unsigned w) { return __builtin_bit_cast(float, w & 0xffff0000u); }
__device__ __forceinline__ f32x16 mfma32(bf16x8 a, bf16x8 b, f32x16 c) { return __builtin_amdgcn_mfma_f32_32x32x16_bf16(a, b, c, 0, 0, 0); }
__device__ __forceinline__ f32x4 mfma16(bf16x8 a, bf16x8 b, f32x4 c) { return __builtin_amdgcn_mfma_f32_16x16x32_bf16(a, b, c, 0, 0, 0); }
__device__ __forceinline__ int crow(int i, int hh) { return (i & 3) + 8 * (i >> 2) + 4 * hh; }
__device__ __forceinline__ bf16x8 pack8(const f32x16& x, int s) {
    v4u p; p.x = cvtpk(x[8 * s], x[8 * s + 1]); p.y = cvtpk(x[8 * s + 2], x[8 * s + 3]); p.z = cvtpk(x[8 * s + 4], x[8 * s + 5]); p.w = cvtpk(x[8 * s + 6], x[8 * s + 7]);
    return __builtin_bit_cast(bf16x8, p);
}
__device__ __forceinline__ float sigmoidf_(float x) { return 1.0f / (1.0f + __expf(-x)); }
__device__ __forceinline__ float shx(float v, int m, int lane) { return __builtin_bit_cast(float, __builtin_amdgcn_ds_bpermute((lane ^ m) << 2, __builtin_bit_cast(int, v))); }
__device__ __forceinline__ float wave_sum(float v, int lane) {
#pragma unroll
    for (int o = 1; o < 64; o <<= 1) v += shx(v, o, lane);
    return v;
}

struct Frame {
    LAS unsigned char* lds;
    volatile LAS unsigned* MISC;
    gu32* ctl;
    int tid, lane, wave, G, vcu;
    float* out; unsigned char* ws;
};
#define WSP(T, off) ((T*)(F.ws + (off)))
struct Args { const float* in[24]; float* out; unsigned char* ws; int ph_lo, ph_hi, li, pad; };
#define KARG const Args& KA
#define INP(i) (KA.in[i])

__device__ __forceinline__ void transpose_item(const float* W, int ldw, int K, bf16* WT, int n0, int srccol0, int k0, LAS float* scr, int lane) {
#pragma unroll 8
    for (int i = 0; i < 32; ++i) { const int kk = 2 * i + (lane >> 5); scr[kk * 33 + (lane & 31)] = W[(size_t)(k0 + kk) * ldw + srccol0 + (lane & 31)]; }
    LDS_WAIT(); asm volatile("" ::: "memory");
    const int c = lane & 7;
#pragma unroll
    for (int j = 0; j < 4; ++j) { const int n = (lane >> 3) + 8 * j; const LAS float* s = scr + (8 * c) * 33 + n;
        v4u o; o.x = pk2(s[0 * 33], s[1 * 33]); o.y = pk2(s[2 * 33], s[3 * 33]); o.z = pk2(s[4 * 33], s[5 * 33]); o.w = pk2(s[6 * 33], s[7 * 33]);
        *(GAS v4u*)(WT + (size_t)(n0 + n) * K + k0 + 8 * c) = o; }
    LDS_WAIT(); asm volatile("" ::: "memory");
}
__device__ __forceinline__ int win_src(int n) { return n < 256 ? n : (n < 1408 ? 1664 + (n - 256) : (n < 2560 ? 256 + (n - 1408) : 1408 + (n - 2560))); }
__device__ __forceinline__ void phase_weights(KARG, Frame& F) {
    LAS float* scr = (LAS float*)(F.lds + RING_OFF + F.wave * 16384);
    const int gw = F.vcu * NWAVES + F.wave, NGW = F.G * NWAVES;
    constexpr int I_IN = (D / 64) * (NIN / 32), I_OUT = (D / 64) * (D / 32), I_FI = (D / 64) * (FF / 32), I_FO = (FF / 64) * (D / 32), I_G = (128 / 64) * (RW / 32);
    constexpr int I_U = 4 * (RW / 32);
    constexpr int PER_L = I_IN + I_OUT + I_FI + I_FO + I_G + I_U;
    for (int it = gw; it < 2 * PER_L; it += NGW) {
        const int l = it / PER_L; int r = it % PER_L;
        unsigned char* wl = F.ws + WS_W + (size_t)l * W_LAYER;
        if (r < I_IN) { const int nb = r % (NIN / 32), kb = r / (NIN / 32); transpose_item(KA.in[I_WIN] + (size_t)l * D * NIN, NIN, D, (bf16*)(wl + W_IN), 32 * nb, win_src(32 * nb), 64 * kb, scr, F.lane); continue; } r -= I_IN;
        if (r < I_OUT) { const int nb = r % (D / 32), kb = r / (D / 32); transpose_item(KA.in[I_WOUT] + (size_t)l * D * D, D, D, (bf16*)(wl + W_OUT), 32 * nb, 32 * nb, 64 * kb, scr, F.lane); continue; } r -= I_OUT;
        if (r < I_FI) { const int nb = r % (FF / 32), kb = r / (FF / 32); transpose_item(KA.in[I_WFI] + (size_t)l * D * FF, FF, D, (bf16*)(wl + W_FFI), 32 * nb, 32 * nb, 64 * kb, scr, F.lane); continue; } r -= I_FI;
        if (r < I_FO) { const int nb = r % (D / 32), kb = r / (D / 32); transpose_item(KA.in[I_WFO] + (size_t)l * FF * D, D, FF, (bf16*)(wl + W_FFO), 32 * nb, 32 * nb, 64 * kb, scr, F.lane); continue; } r -= I_FO;
        if (r < I_G) { const int nb = r % (RW / 32), kb = r / (RW / 32); transpose_item(KA.in[I_GUP] + (size_t)l * 128 * RW, RW, 128, WSP(bf16, WS_SMALL) + (size_t)l * RW * 128, 32 * nb, 32 * nb, 64 * kb, scr, F.lane); continue; } r -= I_G;
        { const int nb = r % (RW / 32), which = r / (RW / 32), d = which & 1, isI = which >> 1;
          transpose_item(KA.in[isI ? I_IUP : I_DUP] + (size_t)(l * 2 + d) * 64 * RW, RW, 64, WSP(bf16, WS_SMALL) + 98304 * (1 + isI) + (size_t)(l * 2 + d) * RW * 64, 32 * nb, 32 * nb, 0, scr, F.lane); }
    }
}
__device__ __forceinline__ void phase_xn_init(KARG, Frame& F, int hf) {
    const int gw = F.vcu * NWAVES + F.wave, NGW = F.G * NWAVES;
    const float* X = KA.in[hf ? I_XS : I_XP]; const GAS f32x4* gp = (const GAS f32x4*)KA.in[I_NMPRE] + F.lane;
    f32x4 g[4];
#pragma unroll
    for (int j = 0; j < 4; ++j) g[j] = gp[64 * j];
    for (int m = gw; m < MH; m += NGW) {
        const GAS f32x4* xr = (const GAS f32x4*)(X + (size_t)m * D) + F.lane; f32x4 v[4]; float s = 0.f;
#pragma unroll
        for (int j = 0; j < 4; ++j) { v[j] = xr[64 * j]; s += (v[j].x * v[j].x + v[j].y * v[j].y) + (v[j].z * v[j].z + v[j].w * v[j].w); }
        const float rstd = 1.0f / sqrtf(wave_sum(s, F.lane) * (1.f / D) + NORM_EPS);
        GAS v2u* o8 = (GAS v2u*)(WSP(bf16, WS_XN) + (size_t)m * D) + F.lane;
#pragma unroll
        for (int j = 0; j < 4; ++j) { v2u w; w.x = pk2(v[j].x * rstd * g[j].x, v[j].y * rstd * g[j].y); w.y = pk2(v[j].z * rstd * g[j].z, v[j].w * rstd * g[j].w); o8[64 * j] = w; }
    }
}
__device__ __forceinline__ void phase_rowpass(KARG, Frame& F, int hf, const bf16* Fm, const float* base, const float* gpost, const float* gnext) {
    const int gw = F.vcu * NWAVES + F.wave, NGW = F.G * NWAVES;
    f32x4 gp[4], gn[4];
#pragma unroll
    for (int j = 0; j < 4; ++j) { gp[j] = ((const GAS f32x4*)gpost + F.lane)[64 * j]; gn[j] = gnext ? ((const GAS f32x4*)gnext + F.lane)[64 * j] : (f32x4){0.f, 0.f, 0.f, 0.f}; }
    float* out = F.out + (size_t)hf * MH * D;
    for (int m = gw; m < MH; m += NGW) {
        const GAS v2u* fr = (const GAS v2u*)(Fm + (size_t)m * D) + F.lane; const GAS f32x4* xr = (const GAS f32x4*)(base + (size_t)m * D) + F.lane;
        f32x4 f[4], x[4]; float s = 0.f;
#pragma unroll
        for (int j = 0; j < 4; ++j) { const v2u w = fr[64 * j]; x[j] = xr[64 * j]; f[j] = (f32x4){bflo(w.x), bfhi(w.x), bflo(w.y), bfhi(w.y)}; s += (f[j].x * f[j].x + f[j].y * f[j].y) + (f[j].z * f[j].z + f[j].w * f[j].w); }
        const float rstd = 1.0f / sqrtf(wave_sum(s, F.lane) * (1.f / D) + NORM_EPS); float s2 = 0.f;
        GAS f32x4* orow = (GAS f32x4*)(out + (size_t)m * D) + F.lane;
#pragma unroll
        for (int j = 0; j < 4; ++j) { x[j] = x[j] + f[j] * rstd * gp[j]; orow[64 * j] = x[j]; s2 += (x[j].x * x[j].x + x[j].y * x[j].y) + (x[j].z * x[j].z + x[j].w * x[j].w); }
        if (gnext) {
            const float r2 = 1.0f / sqrtf(wave_sum(s2, F.lane) * (1.f / D) + NORM_EPS);
            GAS v2u* o8 = (GAS v2u*)(WSP(bf16, WS_XN) + (size_t)m * D) + F.lane;
#pragma unroll
            for (int j = 0; j < 4; ++j) { v2u w; w.x = pk2(x[j].x * r2 * gn[j].x, x[j].y * r2 * gn[j].y); w.y = pk2(x[j].z * r2 * gn[j].z, x[j].w * r2 * gn[j].w); o8[64 * j] = w; }
        }
    }
}
__device__ __forceinline__ void pool_tile(KARG, Frame& F, int hf, int l, int tile) {
    LAS float* U = (LAS float*)(F.lds + RING_OFF);
    LAS float* Pd = U + 48 * 256;
    const bf16* PY = WSP(bf16, WS_PY); bf16* MIX = WSP(bf16, WS_MIX);
    const int T = hf ? 16384 : 8192; const int r0 = tile * 32; const int sbase = hf ? 0 : (r0 & ~8191); const int t0 = r0 - sbase;
    __syncthreads();
    for (int i = F.tid; i < 48 * 32; i += 512) { const int rr = i >> 5, c8 = (i & 31) * 8; const int t = t0 - 8 + rr;
        if (t >= 0 && t < T) { const v4u w = *(const GAS v4u*)(PY + (size_t)(sbase + t) * PXW + c8); LAS float* u = U + rr * 256 + c8;
            u[0] = bflo(w.x); u[1] = bfhi(w.x); u[2] = bflo(w.y); u[3] = bfhi(w.y); u[4] = bflo(w.z); u[5] = bfhi(w.z); u[6] = bflo(w.w); u[7] = bfhi(w.w); } }
    __syncthreads();
    { const int ch = F.tid & 255, g = ch >> 6, win = 2 << g, hw = win >> 1;
      for (int tt = F.tid >> 8; tt < 32; tt += 2) { const int t = t0 + tt; int lo = t - hw; if (lo < 0) lo = 0; int hi = t + win - hw; if (hi > T) hi = T;
          float s = 0.f; for (int q = lo; q < hi; ++q) s += U[(q - t0 + 8) * 256 + ch];
          Pd[tt * 256 + ch] = s / (float)(hi - lo) - U[(tt + 8) * 256 + ch]; } }
    __syncthreads();
    { const int d = F.tid & 63, g = (F.tid >> 6) & 3, tg = F.tid >> 8;
      const float* pw = KA.in[I_POOLW] + (size_t)l * 4 * 64 * 64 + g * 4096 + d; const float sc = KA.in[I_POOLS][l * 256 + g * 64 + d];
      float acc[16];
#pragma unroll
      for (int i = 0; i < 16; ++i) acc[i] = 0.f;
      for (int c = 0; c < 64; ++c) { const float w = pw[c * 64];
#pragma unroll
          for (int i = 0; i < 16; ++i) acc[i] += Pd[(tg * 16 + i) * 256 + g * 64 + c] * w; }
#pragma unroll
      for (int i = 0; i < 16; ++i) MIX[(size_t)(r0 + tg * 16 + i) * D + g * 64 + d] = (bf16)f2bf(acc[i] * sc); }
}
constexpr int BT_STRIDE = 192;
__device__ __forceinline__ void attn_bias_table(KARG, Frame& F, LAS float* bt) {
    const float* rb = KA.in[I_RELB];
    for (int i = F.tid; i < 18 * BT_STRIDE; i += 512) { const int bh = i / BT_STRIDE, o = i % BT_STRIDE, b = bh / 6, h = bh % 6; const int rel = o - 96; float val = 0.f;
        if (rel >= -64 && rel <= 64) { const int rp = rel * (1 << (2 * b)); int ret = rp > 0 ? 16 : 0; const int n = rp < 0 ? -rp : rp;
            if (n < 8) ret += n; else { const float nf = (float)n; int large = 8 + (int)(logf(nf / 8.0f) / logf(128.0f) * 8.0f); if (large > 15) large = 15; ret += large; }
            val = rb[ret * 6 + h] * LOG2E; }
        bt[i] = val; }
}
__device__ __forceinline__ void attn_unit(Frame& F, int hf, int uidx, const LAS float* btab) {
    const int lane = F.lane, c31 = lane & 31, hh = lane >> 5;
    const int T = hf ? 16384 : 8192, nblk = T >> 6, nseq = hf ? 1 : 2;
    const int qt = uidx & 1; int g = uidx >> 1; const int blk = g % nblk; g /= nblk; const int s = g % nseq; g /= nseq; const int h = g % 6, b = g / 6;
    const int dsh = 2 * b, L = T >> dsh, nbs = L >> 6, r = blk / nbs, n = blk % nbs, row0 = s * 8192 + r;
    const bf16* PY = WSP(bf16, WS_PY);
    bf16x8 idf[2];
#pragma unroll
    for (int p = 0; p < 2; ++p)
#pragma unroll
        for (int e = 0; e < 8; ++e) idf[p][e] = (c31 - 16 * p - 8 * hh == e) ? (short)0x3F80 : (short)0;
    const int qi = 32 * qt + c31; const int qrow = row0 + ((64 * n + qi) << dsh);
    bf16x8 qf[4];
#pragma unroll
    for (int ks = 0; ks < 4; ++ks) qf[ks] = *(const GAS bf16x8*)(PY + (size_t)qrow * PXW + 256 + h * 64 + 8 * hh + 16 * ks);
    f32x16 sacc[5];
#pragma unroll
    for (int k5 = 0; k5 < 5; ++k5) { int kp = 64 * (n - 1) + 32 * (qt + k5) + c31; kp = kp < 0 ? 0 : (kp > L - 1 ? L - 1 : kp);
        const bf16* kptr = PY + (size_t)(row0 + (kp << dsh)) * PXW + 640 + h * 64 + 8 * hh; f32x16 a = {};
#pragma unroll
        for (int ks = 0; ks < 4; ++ks) a = mfma32(*(const GAS bf16x8*)(kptr + 16 * ks), qf[ks], a);
        sacc[k5] = a; }
    const LAS float* bt = btab + (b * 6 + h) * BT_STRIDE + 32 - qi;
    const float SC = 0.125f * LOG2E; float m = -3.0e38f;
#pragma unroll
    for (int k5 = 0; k5 < 5; ++k5)
#pragma unroll
        for (int i = 0; i < 16; ++i) { const int j = 32 * (qt + k5) + crow(i, hh); const int rel = j - 64 - qi, kp = 64 * (n - 1) + j;
            const bool valid = (rel >= -64) && (rel <= 64) && (kp >= 0) && (kp < L);
            float t = sacc[k5][i] * SC + bt[j]; t = valid ? t : -1.0e30f; sacc[k5][i] = t; m = fmaxf(m, t); }
    m = fmaxf(m, shx(m, 32, lane)); float lsum = 0.f;
#pragma unroll
    for (int k5 = 0; k5 < 5; ++k5)
#pragma unroll
        for (int i = 0; i < 16; ++i) { const float p = exp2f(sacc[k5][i] - m); sacc[k5][i] = p; lsum += p; }
    lsum += shx(lsum, 32, lane); const float inv = 1.0f / lsum;
    f32x16 o[2] = {};
#pragma unroll
    for (int k5 = 0; k5 < 5; ++k5) { int kp = 64 * (n - 1) + 32 * (qt + k5) + c31; kp = kp < 0 ? 0 : (kp > L - 1 ? L - 1 : kp);
        const bf16* vptr = PY + (size_t)(row0 + (kp << dsh)) * PXW + 1024 + h * 64 + 8 * hh; bf16x8 vf[4];
#pragma unroll
        for (int ks = 0; ks < 4; ++ks) vf[ks] = *(const GAS bf16x8*)(vptr + 16 * ks);
#pragma unroll
        for (int i = 0; i < 16; ++i) sacc[k5][i] *= inv;
#pragma unroll
        for (int dt = 0; dt < 2; ++dt) { f32x16 vt = {}; vt = mfma32(vf[2 * dt], idf[0], vt); vt = mfma32(vf[2 * dt + 1], idf[1], vt);
#pragma unroll
            for (int s2 = 0; s2 < 2; ++s2) o[dt] = mfma32(pack8(sacc[k5], s2), pack8(vt, s2), o[dt]); } }
    bf16* OB = WSP(bf16, WS_OB) + (size_t)b * MH * RW; float* LSE = WSP(float, WS_LSE) + (size_t)b * MH * NH;
#pragma unroll
    for (int dt = 0; dt < 2; ++dt)
#pragma unroll
        for (int i = 0; i < 16; ++i) { const int orow = row0 + ((64 * n + 32 * qt + crow(i, hh)) << dsh); OB[(size_t)orow * RW + h * 64 + 32 * dt + c31] = (bf16)f2bf(o[dt][i]); }
    if (hh == 0) LSE[(size_t)qrow * NH + h] = (m + log2f(lsum)) * LN2;
}
__device__ __forceinline__ void phase_pool_attn(KARG, Frame& F, int hf, int l) {
    for (int t = F.vcu; t < MH / 32; t += F.G) pool_tile(KA, F, hf, l, t);
    __syncthreads();
    LAS float* bt = (LAS float*)(F.lds + RING_OFF);
    attn_bias_table(KA, F, bt);
    __syncthreads();
    const int gw = F.vcu * NWAVES + F.wave, NGW = F.G * NWAVES;
    for (int u = gw; u < 9216; u += NGW) attn_unit(F, hf, u, bt);
}
__device__ __forceinline__ void phase_attn_merge(Frame& F) {
    const bf16* OB = WSP(bf16, WS_OB); const float* LSE = WSP(float, WS_LSE); bf16* MIX = WSP(bf16, WS_MIX);
    const int gt = F.vcu * 512 + F.tid, NT = F.G * 512;
    for (int it = gt; it < MH * 48; it += NT) { const int row = it / 48, cg = it % 48, h = cg >> 3;
        float ls[3], mx = -3.0e38f;
#pragma unroll
        for (int b = 0; b < 3; ++b) { ls[b] = LSE[((size_t)b * MH + row) * NH + h]; mx = fmaxf(mx, ls[b]); }
        float al[3], sum = 0.f;
#pragma unroll
        for (int b = 0; b < 3; ++b) { al[b] = __expf(ls[b] - mx); sum += al[b]; }
        const float inv = 1.0f / sum; float acc[8];
#pragma unroll
        for (int e = 0; e < 8; ++e) acc[e] = 0.f;
#pragma unroll
        for (int b = 0; b < 3; ++b) { const v4u w = *(const GAS v4u*)(OB + ((size_t)b * MH + row) * RW + cg * 8); const float a = al[b] * inv;
            acc[0] += a * bflo(w.x); acc[1] += a * bfhi(w.x); acc[2] += a * bflo(w.y); acc[3] += a * bfhi(w.y); acc[4] += a * bflo(w.z); acc[5] += a * bfhi(w.z); acc[6] += a * bflo(w.w); acc[7] += a * bfhi(w.w); }
        v4u o; o.x = pk2(acc[0], acc[1]); o.y = pk2(acc[2], acc[3]); o.z = pk2(acc[4], acc[5]); o.w = pk2(acc[6], acc[7]);
        *(GAS v4u*)(MIX + (size_t)row * D + 640 + cg * 8) = o; }
}
constexpr int LB = 72;
constexpr int LS = 40;
constexpr int LF = 65;
constexpr int MATB = 64 * LB * 2;
template <int KS> __device__ __forceinline__ f32x4 mm16(const LAS bf16* A, int lda, const LAS bf16* BT, int ldb, int mi, int nj, int lane, f32x4 acc) {
    const LAS bf16* ap = A + (16 * mi + (lane & 15)) * lda + 8 * (lane >> 4); const LAS bf16* bp = BT + (16 * nj + (lane & 15)) * ldb + 8 * (lane >> 4);
#pragma unroll
    for (int ks = 0; ks < KS; ++ks) acc = mfma16(*(const LAS bf16x8*)(ap + 32 * ks), *(const LAS bf16x8*)(bp + 32 * ks), acc);
    return acc;
}
template <int N, int S, int J> __device__ __forceinline__ void rl_fma(float& acc, const float (&Tr)[32], const float (&vL)[32]) {
    if constexpr (N == 4) { unsigned t0, t1, t2, t3;
        asm volatile("v_readlane_b32 %1, %5, %13\n\tv_readlane_b32 %2, %6, %13\n\tv_readlane_b32 %3, %7, %13\n\tv_readlane_b32 %4, %8, %13\n\tv_fmac_f32 %0, %1, %9\n\tv_fmac_f32 %0, %2, %10\n\tv_fmac_f32 %0, %3, %11\n\tv_fmac_f32 %0, %4, %12"
                     : "+v"(acc), "=&s"(t0), "=&s"(t1), "=&s"(t2), "=&s"(t3) : "v"(vL[S]), "v"(vL[S + 1]), "v"(vL[S + 2]), "v"(vL[S + 3]), "v"(Tr[S]), "v"(Tr[S + 1]), "v"(Tr[S + 2]), "v"(Tr[S + 3]), "n"(J)); }
    else if constexpr (N == 3) { unsigned t0, t1, t2;
        asm volatile("v_readlane_b32 %1, %4, %10\n\tv_readlane_b32 %2, %5, %10\n\tv_readlane_b32 %3, %6, %10\n\tv_fmac_f32 %0, %1, %7\n\tv_fmac_f32 %0, %2, %8\n\tv_fmac_f32 %0, %3, %9"
                     : "+v"(acc), "=&s"(t0), "=&s"(t1), "=&s"(t2) : "v"(vL[S]), "v"(vL[S + 1]), "v"(vL[S + 2]), "v"(Tr[S]), "v"(Tr[S + 1]), "v"(Tr[S + 2]), "n"(J)); }
    else if constexpr (N == 2) { unsigned t0, t1;
        asm volatile("v_readlane_b32 %1, %3, %7\n\tv_readlane_b32 %2, %4, %7\n\ts_nop 0\n\tv_fmac_f32 %0, %1, %5\n\tv_fmac_f32 %0, %2, %6"
                     : "+v"(acc), "=&s"(t0), "=&s"(t1) : "v"(vL[S]), "v"(vL[S + 1]), "v"(Tr[S]), "v"(Tr[S + 1]), "n"(J)); }
    else if constexpr (N == 1) { unsigned t0;
        asm volatile("v_readlane_b32 %1, %2, %4\n\ts_nop 1\n\tv_fmac_f32 %0, %1, %3" : "+v"(acc), "=&s"(t0) : "v"(vL[S]), "v"(Tr[S]), "n"(J)); }
}
template <int S, int J> __device__ __forceinline__ void rl_fma_all(float& acc, const float (&Tr)[32], const float (&vL)[32]) {
    constexpr int REM = 32 - S;
    if constexpr (REM >= 4) { rl_fma<4, S, J>(acc, Tr, vL); rl_fma_all<S + 4, J>(acc, Tr, vL); }
    else if constexpr (REM > 0) { rl_fma<REM, S, J>(acc, Tr, vL); }
}
template <int J> struct SolveStep {
    static __device__ __forceinline__ void run(float (&Tr)[32], const float (&vL)[32], int r_) {
        float acc = (J == r_) ? 1.f : 0.f;
        rl_fma_all<J + 1, J>(acc, Tr, vL);
        Tr[J] = (J <= r_) ? acc : 0.f;
        SolveStep<J - 1>::run(Tr, vL, r_);
    }
};
template <> struct SolveStep<-1> { static __device__ __forceinline__ void run(float (&)[32], const float (&)[32], int) {} };
__device__ __forceinline__ v2u pk4(const f32x4 v) { v2u o; o.x = cvtpk(v[0], v[1]); o.y = cvtpk(v[2], v[3]); return o; }
__device__ __forceinline__ void passA_unit(KARG, Frame& F, int hf, int l, int unit) {
    int tid = F.tid; asm volatile("" : "+v"(tid)); int t = tid >> 3, cg = tid & 7, c0 = cg * 8;
    const int ci = unit / 6, h = unit % 6; const int rr0 = ci * 64; const int T = hf ? 16384 : 8192; const int sbase = hf ? 0 : (rr0 & ~8191);
    int tl = rr0 - sbase + t;
    const bf16* PX = WSP(bf16, WS_PX);
    LAS unsigned char* L0 = F.lds + RING_OFF;
#define MAT(i) ((LAS bf16*)(L0 + (i) * MATB))
    LAS bf16* mAt = MAT(0); LAS bf16* mBt = MAT(1); LAS bf16* mKt = MAT(2); LAS bf16* mRt = MAT(3); LAS bf16* mAtT = MAT(4); LAS bf16* mBtT = MAT(5); LAS bf16* mKtT = MAT(6); LAS bf16* mVT = MAT(7);
    LAS bf16* mLak = MAT(8); LAS bf16* mLrb = MAT(9); LAS bf16* mLrk = MAT(10); LAS bf16* mT = MAT(11); LAS bf16* mX1T = MAT(12); LAS bf16* mWT = MAT(13); LAS bf16* mU0T = MAT(8);
    LAS float* fC = (LAS float*)(L0 + 8 * MATB);
    LAS bf16* sLogd = (LAS bf16*)(L0 + 8 * MATB + 16640);
    LAS bf16* sIcl = sLogd + 64 * LB;
    LAS bf16* mActW = MAT(12); LAS bf16* mActA = MAT(13);
    LAS float* sLs = (LAS float*)(L0 + 12 * MATB);
    LAS bf16* sL21 = (LAS bf16*)(L0 + 12 * MATB + 8448);
    LAS bf16* sT11T = sL21 + 32 * LS;
    LAS bf16* sQT = sT11T + 32 * LS;
    LAS float* sDC = (LAS float*)(L0 + 14 * MATB);
    float bonus = 0.f;
    for (int d = 0; d < 2; ++d) {
        asm volatile("" : "+v"(tid)); t = tid >> 3; cg = tid & 7; c0 = cg * 8; tl = rr0 - sbase + t;
        const int lane = tid & 63, wave = __builtin_amdgcn_readfirstlane(tid >> 6);
        const int tau = d ? 63 - t : t; const size_t inst = ((size_t)ci * 6 + h) * 2 + d;
    float cr[8], ck[8], cv[8];
    { const float* cw = KA.in[I_CONV] + (size_t)l * 3 * 1152;
#pragma unroll
      for (int e = 0; e < 8; ++e) { cr[e] = 0.f; ck[e] = 0.f; cv[e] = 0.f; }
#pragma unroll
      for (int tap = 0; tap < 3; ++tap) { const int tq = tl + tap - 1; if (tq >= 0 && tq < T) { const bf16* row = PX + (size_t)(sbase + tq) * PXW + h * 64 + c0;
          const v4u wr_ = *(const GAS v4u*)(row), wk_ = *(const GAS v4u*)(row + 384), wv_ = *(const GAS v4u*)(row + 768); const float* w = cw + tap * 1152 + h * 64 + c0;
          const unsigned ur[4] = {wr_.x, wr_.y, wr_.z, wr_.w}, uk[4] = {wk_.x, wk_.y, wk_.z, wk_.w}, uv[4] = {wv_.x, wv_.y, wv_.z, wv_.w};
#pragma unroll
          for (int e = 0; e < 8; ++e) { const float xr = (e & 1) ? bfhi(ur[e >> 1]) : bflo(ur[e >> 1]), xk = (e & 1) ? bfhi(uk[e >> 1]) : bflo(uk[e >> 1]), xv = (e & 1) ? bfhi(uv[e >> 1]) : bflo(uv[e >> 1]);
              cr[e] += xr * w[e]; ck[e] += xk * w[384 + e]; cv[e] += xv * w[768 + e]; } } } }
    float kkv[8];
    { float ss = 0.f; const float* kkw = KA.in[I_KK] + l * RW + h * 64 + c0;
#pragma unroll
      for (int e = 0; e < 8; ++e) { kkv[e] = ck[e] * kkw[e]; ss += kkv[e] * kkv[e]; }
      ss += shx(ss, 1, lane); ss += shx(ss, 2, lane); ss += shx(ss, 4, lane);
      const float inv = 1.0f / fmaxf(sqrtf(ss), 1e-12f);
#pragma unroll
      for (int e = 0; e < 8; ++e) kkv[e] *= inv; }
        __syncthreads();
        { const bf16* row = PX + (size_t)(rr0 + t) * PXW + 1152 + c0; const v4u ww = *(const GAS v4u*)(row), wa = *(const GAS v4u*)(row + 64);
          v4u o; o.x = pk2(tanhf(bflo(ww.x)), tanhf(bfhi(ww.x))); o.y = pk2(tanhf(bflo(ww.y)), tanhf(bfhi(ww.y))); o.z = pk2(tanhf(bflo(ww.z)), tanhf(bfhi(ww.z))); o.w = pk2(tanhf(bflo(ww.w)), tanhf(bfhi(ww.w)));
          *(LAS v4u*)(mActW + tau * LB + c0) = o; *(LAS v4u*)(mActA + tau * LB + c0) = wa; }
        __syncthreads();
        { const int prod = wave >> 2, nj = wave & 3, cl = lane & 15, ql = lane >> 4; const int c = 16 * nj + cl;
          const bf16* UT = WSP(bf16, WS_SMALL) + 98304 * (1 + prod) + (size_t)(l * 2 + d) * RW * 64 + (size_t)(h * 64 + c) * 64 + 8 * ql;
          const bf16x8 b0 = *(const GAS bf16x8*)(UT), b1 = *(const GAS bf16x8*)(UT + 32);
          const float bias = KA.in[prod ? I_IA0 : I_DW0][(size_t)(l * 2 + d) * RW + h * 64 + c];
          f32x4 v[4];
#pragma unroll
          for (int mi = 0; mi < 4; ++mi) { const LAS bf16* ap = (prod ? mActA : mActW) + (16 * mi + cl) * LB + 8 * ql; f32x4 a = {bias, bias, bias, bias};
              a = mfma16(*(const LAS bf16x8*)(ap), b0, a); a = mfma16(*(const LAS bf16x8*)(ap + 32), b1, a); v[mi] = a; }
          if (prod) {
#pragma unroll
              for (int mi = 0; mi < 4; ++mi)
#pragma unroll
                  for (int e = 0; e < 4; ++e) sIcl[(16 * mi + 4 * ql + e) * LB + c] = (bf16)f2bf(sigmoidf_(v[mi][e]));
          } else { float base = 0.f;
#pragma unroll
              for (int mi = 0; mi < 4; ++mi) { float ld_[4], p[4];
#pragma unroll
                  for (int e = 0; e < 4; ++e) { ld_[e] = -0.6065306597126334f * sigmoidf_(v[mi][e]); p[e] = ld_[e] + (e ? p[e - 1] : 0.f); }
                  const float g0 = shx(p[3], 0, cl), g1 = shx(p[3], 0, cl + 16), g2 = shx(p[3], 0, cl + 32), g3 = shx(p[3], 0, cl + 48);
                  const float off = base + (ql > 0 ? g0 : 0.f) + (ql > 1 ? g1 : 0.f) + (ql > 2 ? g2 : 0.f); base += (g0 + g1) + (g2 + g3);
#pragma unroll
                  for (int e = 0; e < 4; ++e) { fC[(16 * mi + 4 * ql + e) * LF + c] = off + p[e]; sLogd[(16 * mi + 4 * ql + e) * LB + c] = (bf16)f2bf(ld_[e]); } } } }
        __syncthreads();
        float logd[8], ic[8];
        { const v4u wl_ = *(const LAS v4u*)(sLogd + tau * LB + c0), wi_ = *(const LAS v4u*)(sIcl + tau * LB + c0);
          logd[0] = bflo(wl_.x); logd[1] = bfhi(wl_.x); logd[2] = bflo(wl_.y); logd[3] = bfhi(wl_.y); logd[4] = bflo(wl_.z); logd[5] = bfhi(wl_.z); logd[6] = bflo(wl_.w); logd[7] = bfhi(wl_.w);
          ic[0] = bflo(wi_.x); ic[1] = bfhi(wi_.x); ic[2] = bflo(wi_.y); ic[3] = bfhi(wi_.y); ic[4] = bflo(wi_.z); ic[5] = bfhi(wi_.z); ic[6] = bflo(wi_.w); ic[7] = bfhi(wi_.w); }
        { const float* ka = KA.in[I_KA] + l * RW + h * 64 + c0; const float* brk = KA.in[I_BRK] + l * RW + h * 64 + c0;
          float at[8], bt_[8], kt[8], rt[8]; float bs = 0.f;
#pragma unroll
          for (int e = 0; e < 8; ++e) { const float cum = fC[tau * LF + c0 + e], cumx = cum - logd[e]; const float keff = ck[e] * (1.0f + (ic[e] - 1.0f) * ka[e]);
              bs += cr[e] * keff * brk[e];
              const float en = __expf(-cum);
              at[e] = -kkv[e] * __expf(cumx); bt_[e] = kkv[e] * ic[e] * en; kt[e] = keff * en; rt[e] = cr[e] * __expf(cum); }
          bs += shx(bs, 1, lane); bs += shx(bs, 2, lane); bs += shx(bs, 4, lane); bonus += bs;
          v4u o;
          o.x = pk2(at[0], at[1]); o.y = pk2(at[2], at[3]); o.z = pk2(at[4], at[5]); o.w = pk2(at[6], at[7]); *(LAS v4u*)(mAt + tau * LB + c0) = o;
          o.x = pk2(bt_[0], bt_[1]); o.y = pk2(bt_[2], bt_[3]); o.z = pk2(bt_[4], bt_[5]); o.w = pk2(bt_[6], bt_[7]); *(LAS v4u*)(mBt + tau * LB + c0) = o;
          o.x = pk2(kt[0], kt[1]); o.y = pk2(kt[2], kt[3]); o.z = pk2(kt[4], kt[5]); o.w = pk2(kt[6], kt[7]); *(LAS v4u*)(mKt + tau * LB + c0) = o;
          o.x = pk2(rt[0], rt[1]); o.y = pk2(rt[2], rt[3]); o.z = pk2(rt[4], rt[5]); o.w = pk2(rt[6], rt[7]); *(LAS v4u*)(mRt + tau * LB + c0) = o;
#pragma unroll
          for (int e = 0; e < 8; ++e) { mAtT[(c0 + e) * LB + tau] = (bf16)f2bf(at[e]); mBtT[(c0 + e) * LB + tau] = (bf16)f2bf(bt_[e]); mKtT[(c0 + e) * LB + tau] = (bf16)f2bf(kt[e]); mVT[(c0 + e) * LB + tau] = (bf16)f2bf(cv[e]); }
          if (t == 0) {
#pragma unroll
              for (int e = 0; e < 8; ++e) { const float dc = __expf(fC[63 * LF + c0 + e]); const int k_ = c0 + e; sDC[k_] = dc; WSP(float, WS_DC)[inst * 64 + 16 * ((k_ >> 2) & 3) + 4 * (k_ >> 4) + (k_ & 3)] = dc; } } }
        __syncthreads();
        int lnv = lane, cc, qq;
#define FRESH_LANE() do { asm volatile("" : "+v"(lnv)); cc = lnv & 15; qq = lnv >> 4; } while (0)
        FRESH_LANE();
        for (int tt = wave; tt < 64; tt += 8) { const int prod = tt >> 4, mi = (tt >> 2) & 3, nj = tt & 3; const f32x4 z = {0.f, 0.f, 0.f, 0.f};
            if (prod == 0) { const f32x4 a = mm16<2>(mAt, LB, mBt, LB, mi, nj, lnv, z);
                const int sg = 16 * nj + cc; const int blk = mi >> 1;
                if ((mi >> 1) == (nj >> 1)) {
#pragma unroll
                    for (int e = 0; e < 4; ++e) { const int ta = 16 * mi + 4 * qq + e; sLs[blk * 32 * 33 + (ta & 31) * 33 + (sg & 31)] = (sg < ta) ? a[e] : 0.f; } }
                else if (mi >= 2) {
#pragma unroll
                    for (int e = 0; e < 4; ++e) { const int ta = 16 * mi + 4 * qq + e; sL21[(ta - 32) * LS + sg] = (bf16)f2bf(a[e]); } } }
            else { const LAS bf16* Am = (prod == 2) ? mBt : mKt; const LAS bf16* Bm = (prod == 1) ? mAt : mRt; LAS bf16* Om = (prod == 1) ? mLak : (prod == 2 ? mLrb : mLrk);
                f32x4 a = mm16<2>(Am, LB, Bm, LB, mi, nj, lnv, z);
                const int ta = 16 * nj + cc;
#pragma unroll
                for (int e = 0; e < 4; ++e) { const int sg = 16 * mi + 4 * qq + e; const bool keep = (prod == 1) ? (sg < ta) : (sg <= ta); a[e] = keep ? a[e] : 0.f; }
                *(LAS v2u*)(Om + ta * LB + 16 * mi + 4 * qq) = pk4(a); } }
        __syncthreads();
        FRESH_LANE();
        if (wave < 2) { const int blk = wave, r_ = lnv & 31; const LAS float* Lb = sLs + blk * 32 * 33; float Tr[32], vL[32];
#pragma unroll
            for (int s = 0; s < 32; ++s) vL[s] = Lb[s * 33 + r_];
            SolveStep<31>::run(Tr, vL, r_);
            if (lnv < 32) {
            LAS bf16* trow = mT + (32 * blk + r_) * LB + 32 * blk; LAS bf16* zrow = mT + r_ * LB + 32;
#pragma unroll
            for (int g = 0; g < 4; ++g) { v4u o; o.x = pk2(Tr[8 * g], Tr[8 * g + 1]); o.y = pk2(Tr[8 * g + 2], Tr[8 * g + 3]); o.z = pk2(Tr[8 * g + 4], Tr[8 * g + 5]); o.w = pk2(Tr[8 * g + 6], Tr[8 * g + 7]);
                *(LAS v4u*)(trow + 8 * g) = o; if (blk == 0) *(LAS v4u*)(zrow + 8 * g) = (v4u){0u, 0u, 0u, 0u}; }
            if (blk == 0) {
#pragma unroll
                for (int j = 0; j < 32; ++j) sT11T[j * LS + r_] = (bf16)f2bf(Tr[j]); } } }
        __syncthreads();
        FRESH_LANE();
        if (wave < 4) { const int mi = wave >> 1, nj = wave & 1; const f32x4 a = mm16<1>(sL21, LS, sT11T, LS, mi, nj, lnv, (f32x4){0.f, 0.f, 0.f, 0.f});
            *(LAS v2u*)(sQT + (16 * nj + cc) * LS + 16 * mi + 4 * qq) = pk4(a); }
        __syncthreads();
        FRESH_LANE();
        if (wave < 4) { const int mi = wave >> 1, nj = wave & 1; const f32x4 a = mm16<1>(mT + 32 * LB + 32, LB, sQT, LS, mi, nj, lnv, (f32x4){0.f, 0.f, 0.f, 0.f});
#pragma unroll
            for (int e = 0; e < 4; ++e) mT[(32 + 16 * mi + 4 * qq + e) * LB + 16 * nj + cc] = (bf16)f2bf(a[e]); }
        __syncthreads();
        FRESH_LANE();
        for (int tt = wave; tt < 32; tt += 8) { const int prod = tt >> 4, mi = (tt >> 2) & 3, nj = tt & 3; const f32x4 z = {0.f, 0.f, 0.f, 0.f};
            const f32x4 a = prod ? mm16<2>(mT, LB, mAtT, LB, mi, nj, lnv, z) : mm16<2>(mLak, LB, mVT, LB, mi, nj, lnv, z);
            *(LAS v2u*)((prod ? mWT : mX1T) + (16 * nj + cc) * LB + 16 * mi + 4 * qq) = pk4(a); }
        __syncthreads();
        FRESH_LANE();
        for (int tt = wave; tt < 16; tt += 8) { const int mi = tt >> 2, nj = tt & 3; const f32x4 a = mm16<2>(mT, LB, mX1T, LB, mi, nj, lnv, (f32x4){0.f, 0.f, 0.f, 0.f});
            *(LAS v2u*)(mU0T + (16 * nj + cc) * LB + 16 * mi + 4 * qq) = pk4(a); }
        __syncthreads();
        FRESH_LANE();
        for (int tt = wave; tt < 64; tt += 8) { const int prod = tt >> 4, mi = (tt >> 2) & 3, nj = tt & 3; const int r4 = 16 * mi + 4 * qq, cn = 16 * nj + cc;
            if (prod == 0) {
                const v2u rv = *(const LAS v2u*)(mRt + cn * LB + r4); f32x4 a = {bflo(rv.x), bfhi(rv.x), bflo(rv.y), bfhi(rv.y)};
                a = mm16<2>(mWT, LB, mLrb, LB, mi, nj, lnv, a); const int treal = d ? 63 - cn : cn;
                *(GAS v2u*)(WSP(bf16, WS_RY) + inst * 4096 + treal * 64 + r4) = pk4(a); }
            else if (prod == 1) {
                f32x4 a = mm16<2>(mU0T, LB, mLrb, LB, mi, nj, lnv, (f32x4){0.f, 0.f, 0.f, 0.f}); a = mm16<2>(mVT, LB, mLrk, LB, mi, nj, lnv, a); const int treal = d ? 63 - cn : cn;
                *(GAS v2u*)(WSP(bf16, WS_Y0) + inst * 4096 + treal * 64 + r4) = pk4(a); }
            else if (prod == 2) {
                f32x4 a = mm16<2>(mWT, LB, mBtT, LB, mi, nj, lnv, (f32x4){0.f, 0.f, 0.f, 0.f}); const float dc = sDC[cn];
#pragma unroll
                for (int e = 0; e < 4; ++e) a[e] *= dc;
                *(GAS v2u*)(WSP(bf16, WS_GP) + inst * 4096 + cn * 64 + (r4 & 32) + 8 * qq + 4 * (mi & 1)) = pk4(a); }
            else {
                f32x4 a = mm16<2>(mBtT, LB, mU0T, LB, mi, nj, lnv, (f32x4){0.f, 0.f, 0.f, 0.f}); a = mm16<2>(mKtT, LB, mVT, LB, mi, nj, lnv, a);
#pragma unroll
                for (int e = 0; e < 4; ++e) a[e] *= sDC[r4 + e];
                *(GAS v2u*)(WSP(bf16, WS_H0T) + inst * 4096 + cn * 64 + 16 * qq + 4 * mi) = pk4(a); } }
    }
#undef MAT
#undef FRESH_LANE
    if (cg == 0) WSP(float, WS_BON)[(size_t)unit * 64 + t] = bonus;
}
__device__ __forceinline__ void phase_passA(KARG, Frame& F, int hf, int l) {
    for (int u = F.vcu; u < (MH / 64) * 6; u += F.G) passA_unit(KA, F, hf, l, u);
}
__device__ __forceinline__ void phase_passB(Frame& F, int hf) {
    const int nchain = hf ? 12 : 24, nck = hf ? 256 : 128;
    const int unit = F.vcu * NWAVES + F.wave;
    const int uu = (F.wave) * F.G + F.vcu;
    if (uu >= nchain * 4) return; (void)unit;
    const int chain = uu >> 2, cgp = uu & 3; const int d = chain & 1, h = (chain >> 1) % 6, s = (chain >> 1) / 6;
    const int lane = F.lane, c16 = lane & 15, q = lane >> 4, v = 16 * cgp + c16;
    f32x4 hacc[4];
#pragma unroll
    for (int m = 0; m < 4; ++m) hacc[m] = (f32x4){0.f, 0.f, 0.f, 0.f};
    const bf16* GP = WSP(bf16, WS_GP); const bf16* H0T = WSP(bf16, WS_H0T); const float* DC = WSP(float, WS_DC); bf16* HC = WSP(bf16, WS_HC);
    struct PBSet { v4u ga[4][2]; v4u h0[2]; f32x4 dc[4]; };
#define PB_LOAD(S_, STEP) do { const int st_ = (STEP) < nck ? (STEP) : nck - 1; const int cl_ = d ? nck - 1 - st_ : st_; const size_t in_ = ((size_t)(s * nck + cl_) * 6 + h) * 2 + d; \
        _Pragma("unroll") for (int mo = 0; mo < 4; ++mo) { const bf16* gr = GP + in_ * 4096 + (16 * mo + c16) * 64 + 8 * q; \
            S_.ga[mo][0] = *(const GAS v4u*)(gr); S_.ga[mo][1] = *(const GAS v4u*)(gr + 32); S_.dc[mo] = *(const GAS f32x4*)(DC + in_ * 64 + 16 * q + 4 * mo); } \
        S_.h0[0] = *(const GAS v4u*)(H0T + in_ * 4096 + v * 64 + 16 * q); S_.h0[1] = *(const GAS v4u*)(H0T + in_ * 4096 + v * 64 + 16 * q + 8); } while (0)
#define PB_STEP(S_, STEP) do { const int cl_ = d ? nck - 1 - (STEP) : (STEP); const size_t inst = ((size_t)(s * nck + cl_) * 6 + h) * 2 + d; \
        v2u hb[4]; \
        _Pragma("unroll") for (int m = 0; m < 4; ++m) { hb[m].x = cvtpk(hacc[m][0], hacc[m][1]); hb[m].y = cvtpk(hacc[m][2], hacc[m][3]); *(GAS v2u*)(HC + inst * 4096 + v * 64 + 16 * m + 4 * q) = hb[m]; } \
        bf16x8 bfr[2]; \
        _Pragma("unroll") for (int ks = 0; ks < 2; ++ks) { v4u t4; t4.x = hb[2 * ks].x; t4.y = hb[2 * ks].y; t4.z = hb[2 * ks + 1].x; t4.w = hb[2 * ks + 1].y; bfr[ks] = __builtin_bit_cast(bf16x8, t4); } \
        const unsigned hw[8] = {S_.h0[0].x, S_.h0[0].y, S_.h0[0].z, S_.h0[0].w, S_.h0[1].x, S_.h0[1].y, S_.h0[1].z, S_.h0[1].w}; \
        _Pragma("unroll") for (int mo = 0; mo < 4; ++mo) { f32x4 cin; \
            cin[0] = S_.dc[mo][0] * hacc[mo][0] + bflo(hw[2 * mo]); cin[1] = S_.dc[mo][1] * hacc[mo][1] + bfhi(hw[2 * mo]); cin[2] = S_.dc[mo][2] * hacc[mo][2] + bflo(hw[2 * mo + 1]); cin[3] = S_.dc[mo][3] * hacc[mo][3] + bfhi(hw[2 * mo + 1]); \
            cin = mfma16(__builtin_bit_cast(bf16x8, S_.ga[mo][0]), bfr[0], cin); cin = mfma16(__builtin_bit_cast(bf16x8, S_.ga[mo][1]), bfr[1], cin); hacc[mo] = cin; } } while (0)
    PBSet s0, s1, s2;
    PB_LOAD(s0, 0); PB_LOAD(s1, 1); PB_LOAD(s2, 2);
    for (int step = 0; step < nck; step += 3) {
        PB_STEP(s0, step); PB_LOAD(s0, step + 3);
        if (step + 1 < nck) { PB_STEP(s1, step + 1); PB_LOAD(s1, step + 4); }
        if (step + 2 < nck) { PB_STEP(s2, step + 2); PB_LOAD(s2, step + 5); }
    }
#undef PB_STEP
#undef PB_LOAD
}
__device__ __forceinline__ void passC_unit(KARG, Frame& F, int hf, int l, int unit) {
    const int lane = F.lane, c31 = lane & 31, hh = lane >> 5; const int ci = unit / 6, h = unit % 6; const int rr0 = ci * 64;
    const int T = hf ? 16384 : 8192; const int sbase = hf ? 0 : (rr0 & ~8191);
    const bf16* PX = WSP(bf16, WS_PX); const bf16* RY = WSP(bf16, WS_RY); const bf16* Y0 = WSP(bf16, WS_Y0); const bf16* HC = WSP(bf16, WS_HC);
    f32x16 acc[2][2];
#pragma unroll
    for (int mt = 0; mt < 2; ++mt)
#pragma unroll
        for (int nt = 0; nt < 2; ++nt) { f32x16 a;
#pragma unroll
            for (int g = 0; g < 4; ++g) { float s4[4] = {0.f, 0.f, 0.f, 0.f};
#pragma unroll
                for (int d = 0; d < 2; ++d) { const size_t inst = ((size_t)ci * 6 + h) * 2 + d; const v2u w = *(const GAS v2u*)(Y0 + inst * 4096 + (32 * nt + c31) * 64 + 32 * mt + 8 * g + 4 * hh);
                    s4[0] += bflo(w.x); s4[1] += bfhi(w.x); s4[2] += bflo(w.y); s4[3] += bfhi(w.y); }
                a[4 * g] = s4[0]; a[4 * g + 1] = s4[1]; a[4 * g + 2] = s4[2]; a[4 * g + 3] = s4[3]; }
            acc[mt][nt] = a; }
#pragma unroll
    for (int d = 0; d < 2; ++d) { const size_t inst = ((size_t)ci * 6 + h) * 2 + d;
#pragma unroll
        for (int ks = 0; ks < 4; ++ks) { bf16x8 af[2], bf_[2];
#pragma unroll
            for (int x = 0; x < 2; ++x) { af[x] = *(const GAS bf16x8*)(HC + inst * 4096 + (32 * x + c31) * 64 + 16 * ks + 8 * hh); bf_[x] = *(const GAS bf16x8*)(RY + inst * 4096 + (32 * x + c31) * 64 + 16 * ks + 8 * hh); }
#pragma unroll
            for (int mt = 0; mt < 2; ++mt)
#pragma unroll
                for (int nt = 0; nt < 2; ++nt) acc[mt][nt] = mfma32(af[mt], bf_[nt], acc[mt][nt]); } }
    f32x16 gacc[2][2] = {};
    { const bf16* GUT = WSP(bf16, WS_SMALL) + (size_t)l * RW * 128;
#pragma unroll
      for (int ks = 0; ks < 8; ++ks) { bf16x8 af[2], bf_[2];
#pragma unroll
          for (int x = 0; x < 2; ++x) { af[x] = *(const GAS bf16x8*)(GUT + (size_t)(h * 64 + 32 * x + c31) * 128 + 16 * ks + 8 * hh);
              const v4u w = *(const GAS v4u*)(PX + (size_t)(rr0 + 32 * x + c31) * PXW + 1280 + 16 * ks + 8 * hh); v4u o;
              o.x = cvtpk(sigmoidf_(bflo(w.x)), sigmoidf_(bfhi(w.x))); o.y = cvtpk(sigmoidf_(bflo(w.y)), sigmoidf_(bfhi(w.y))); o.z = cvtpk(sigmoidf_(bflo(w.z)), sigmoidf_(bfhi(w.z))); o.w = cvtpk(sigmoidf_(bflo(w.w)), sigmoidf_(bfhi(w.w)));
              bf_[x] = __builtin_bit_cast(bf16x8, o); }
#pragma unroll
          for (int mt = 0; mt < 2; ++mt)
#pragma unroll
              for (int nt = 0; nt < 2; ++nt) gacc[mt][nt] = mfma32(af[mt], bf_[nt], gacc[mt][nt]); } }
    const float* gng = KA.in[I_GNG] + l * RW + h * 64; const float* gnb = KA.in[I_GNB] + l * RW + h * 64; const float* cw = KA.in[I_CONV] + (size_t)l * 3 * 1152 + 768 + h * 64;
    bf16* MIX = WSP(bf16, WS_MIX);
#pragma unroll
    for (int nt = 0; nt < 2; ++nt) { const int t = 32 * nt + c31; const int tl = rr0 - sbase + t;
        float s1 = 0.f;
#pragma unroll
        for (int mt = 0; mt < 2; ++mt)
#pragma unroll
            for (int i = 0; i < 16; ++i) s1 += acc[mt][nt][i];
        s1 += shx(s1, 32, lane); const float mu = s1 * (1.0f / 64.0f); float s2 = 0.f;
#pragma unroll
        for (int mt = 0; mt < 2; ++mt)
#pragma unroll
            for (int i = 0; i < 16; ++i) { const float dlt = acc[mt][nt][i] - mu; s2 += dlt * dlt; }
        s2 += shx(s2, 32, lane); const float rstd = 1.0f / sqrtf(s2 * (1.0f / 64.0f) + GN_EPS);
        const float bon = WSP(float, WS_BON)[(size_t)unit * 64 + t];
#pragma unroll
        for (int mt = 0; mt < 2; ++mt)
#pragma unroll
            for (int g = 0; g < 4; ++g) { const int j0 = 32 * mt + 8 * g + 4 * hh; float vv[4] = {0.f, 0.f, 0.f, 0.f};
#pragma unroll
                for (int tap = 0; tap < 3; ++tap) { const int tq = tl + tap - 1; if (tq >= 0 && tq < T) { const v2u w = *(const GAS v2u*)(PX + (size_t)(sbase + tq) * PXW + 768 + h * 64 + j0); const f32x4 cwv = *(const GAS f32x4*)(cw + tap * 1152 + j0);
                    vv[0] += bflo(w.x) * cwv[0]; vv[1] += bfhi(w.x) * cwv[1]; vv[2] += bflo(w.y) * cwv[2]; vv[3] += bfhi(w.y) * cwv[3]; } }
                const f32x4 gg = *(const GAS f32x4*)(gng + j0), gb = *(const GAS f32x4*)(gnb + j0); float o4[4];
#pragma unroll
                for (int e = 0; e < 4; ++e) { const float y = (acc[mt][nt][4 * g + e] - mu) * rstd * gg[e] + gb[e] + bon * vv[e]; o4[e] = y * gacc[mt][nt][4 * g + e]; }
                v2u o; o.x = pk2(o4[0], o4[1]); o.y = pk2(o4[2], o4[3]); *(GAS v2u*)(MIX + (size_t)(rr0 + t) * D + 256 + h * 64 + j0) = o; } }
}
__device__ __forceinline__ void phase_passC(KARG, Frame& F, int hf, int l) {
    const int gw = F.vcu * NWAVES + F.wave, NGW = F.G * NWAVES;
    for (int u = gw; u < (MH / 64) * 6; u += NGW) passC_unit(KA, F, hf, l, u);
}
constexpr int NPHASE = 47;
__global__ void __launch_bounds__(NWAVES * 64, 2) mega_fwd(Args args) {
    const Args& KA = args;
    extern __shared__ __attribute__((aligned(16))) unsigned char lds[];
    Frame F;
    F.lds = (LAS unsigned char*)lds; F.MISC = (volatile LAS unsigned*)(F.lds + MISC_OFF);
    F.tid = threadIdx.x; F.lane = F.tid & 63; F.wave = __builtin_amdgcn_readfirstlane(F.tid >> 6);
    F.G = gridDim.x; { const int bx = blockIdx.x; F.vcu = (F.G % 8 == 0) ? (bx % 8) * (F.G / 8) + bx / 8 : bx; }
    F.ws = args.ws; F.ctl = (gu32*)(args.ws + WS_CTL); F.out = args.out;
    for (int u = F.tid; u < (LDS_BYTES - LDSCTL_OFF) / 4; u += NWAVES * 64) ((LAS unsigned*)(F.lds + LDSCTL_OFF))[u] = 0u;
    __syncthreads();
    XcdBarrier bar; bar.bar = (unsigned*)(F.ctl + CW_BAR) + args.li * XCD_BAR_WORDS; bar.x = 0; bar.st = nullptr;
    const bool multi = (args.ph_hi - args.ph_lo) > 1;
    if (multi) bar = xcd_barrier_post((unsigned*)(F.ctl + CW_BAR) + args.li * XCD_BAR_WORDS, F.MISC + 8);
    for (int p = args.ph_lo; p < args.ph_hi; ++p) {
        { int tv = threadIdx.x; asm volatile("" : "+v"(tv)); F.tid = tv; F.lane = tv & 63; F.wave = __builtin_amdgcn_readfirstlane(tv >> 6); }
        if (p == 0) { if ((PHM >> 11) & 1) phase_weights(args, F); }
        else {
            const int qq = p - 1, hf = qq / 23, r = qq % 23;
            if (r == 0) { if ((PHM >> 12) & 1) phase_xn_init(args, F, hf); }
            else {
                const int l = (r - 1) / 11, k = (r - 1) % 11;
                unsigned char* wl = F.ws + WS_W + (size_t)l * W_LAYER;
                const int nrep = (k == REPK) ? 2 : 1;
                for (int rep = 0; rep < nrep; ++rep) {
                if (rep) xcd_barrier(bar);
                { int tv = threadIdx.x; asm volatile("" : "+v"(tv)); F.tid = tv; F.lane = tv & 63; F.wave = __builtin_amdgcn_readfirstlane(tv >> 6); }
                if (k == 0 || k == 6 || k == 8 || k == 9) {
                    const bf16* Aop; const bf16* Bop; int Nn, Kk; pg8::EpiGen E;
                    if (k == 0) { Aop = WSP(bf16, WS_XN); Bop = (const bf16*)(wl + W_IN); Nn = NIN; Kk = D; E = pg8::EpiGen{WSP(bf16, WS_PY), WSP(bf16, WS_PX), 1408, PXW, PXW, 0}; }
                    else if (k == 6) { Aop = WSP(bf16, WS_MIX); Bop = (const bf16*)(wl + W_OUT); Nn = D; Kk = D; E = pg8::EpiGen{WSP(bf16, WS_F1), WSP(bf16, WS_F1), 1 << 30, D, D, 0}; }
                    else if (k == 8) { Aop = WSP(bf16, WS_XN); Bop = (const bf16*)(wl + W_FFI); Nn = FF; Kk = D; E = pg8::EpiGen{WSP(bf16, WS_H), WSP(bf16, WS_H), 1 << 30, FF, FF, 2}; }
                    else { Aop = WSP(bf16, WS_H); Bop = (const bf16*)(wl + W_FFO); Nn = D; Kk = FF; E = pg8::EpiGen{WSP(bf16, WS_XN), WSP(bf16, WS_XN), 1 << 30, D, D, 0}; }
                    pg8::Gemm g{Aop, Bop, MH, Nn, Kk}; pg8::StaticOrder S; S.init(MH, Nn, F.G, (int)blockIdx.x);
                    pg8::gemm_phase<pg8::EpiGen, pg8::StaticOrder, true, true>(F.lds + RING_OFF, g, S, E, F.tid);
                } else
                switch (k) {
                case 1: if ((PHM >> 1) & 1) phase_pool_attn(args, F, hf, l); break;
                case 2: if ((PHM >> 2) & 1) phase_attn_merge(F); break;
                case 3: if ((PHM >> 3) & 1) phase_passA(args, F, hf, l); break;
                case 4: if ((PHM >> 4) & 1) phase_passB(F, hf); break;
                case 5: if ((PHM >> 5) & 1) phase_passC(args, F, hf, l); break;
                case 7: if ((PHM >> 7) & 1) { const float* base = (l == 0) ? KA.in[hf ? I_XS : I_XP] : (F.out + (size_t)hf * MH * D);
                          phase_rowpass(args, F, hf, WSP(bf16, WS_F1), base, KA.in[I_NMPOST] + l * D, KA.in[I_NFPRE] + l * D); } break;
                default: if ((PHM >> 10) & 1) { phase_rowpass(args, F, hf, WSP(bf16, WS_XN), F.out + (size_t)hf * MH * D, KA.in[I_NFPOST] + l * D, (l == 0) ? (KA.in[I_NMPRE] + D) : nullptr); } break;
                }
                }
            }
        }
        if (p + 1 < args.ph_hi) xcd_barrier(bar);
    }
}

extern "C" void kernel_launch(void* const* d_in, const int* in_sizes, int n_in, void* d_out, int out_size, void* d_ws, size_t ws_size, hipStream_t stream) {
    static int grid = 0;
    if (grid == 0) {
        if (n_in != 24 || out_size != 2 * MH * D || ws_size < WS_END) { fprintf(stderr, "kernel_launch: unexpected problem shape (n_in %d out %d ws %zu)\n", n_in, out_size, ws_size); grid = -1; return; }
        int dev = 0, cus = 0;
        if (hipGetDevice(&dev) != hipSuccess || hipDeviceGetAttribute(&cus, hipDeviceAttributeMultiprocessorCount, dev) != hipSuccess) { grid = -1; return; }
        if (hipFuncSetAttribute((const void*)mega_fwd, hipFuncAttributeMaxDynamicSharedMemorySize, LDS_BYTES) != hipSuccess) { fprintf(stderr, "kernel_launch: hipFuncSetAttribute failed\n"); grid = -1; return; }
        int per_cu = 0; (void)hipOccupancyMaxActiveBlocksPerMultiprocessor(&per_cu, (const void*)mega_fwd, NWAVES * 64, LDS_BYTES); (void)hipGetLastError();
        grid = cus;
    }
    if (grid < 0) return;
    (void)hipMemsetAsync((char*)d_ws + WS_CTL, 0, CTL_ZERO_BYTES, stream);
    Args a{};
    for (int i = 0; i < 24; ++i) a.in[i] = (const float*)d_in[i];
    a.out = (float*)d_out; a.ws = (unsigned char*)d_ws;
#if MK_N_LAUNCHES == 1
    a.ph_lo = 0; a.ph_hi = NPHASE; a.li = 0;
    hipLaunchKernelGGL(mega_fwd, dim3(grid), dim3(NWAVES * 64), LDS_BYTES, stream, a);
#else
    for (int p = 0; p < NPHASE; ++p) { a.ph_lo = p; a.ph_hi = p + 1; a.li = 0; hipLaunchKernelGGL(mega_fwd, dim3(grid), dim3(NWAVES * 64), LDS_BYTES, stream, a); }
#endif
}
```

```cpp
#include <hip/hip_runtime.h>
#include <cstdio>
#include <cstdint>
#ifndef REPK
#define REPK -1
#endif
#ifndef PHM
#define PHM 0xFFFF
#endif
#ifndef MK_N_LAUNCHES
#define MK_N_LAUNCHES 1
#endif
namespace pg8 {
#define PG8_LAS __attribute__((address_space(3)))
typedef unsigned short bf16_t;
typedef short bf16x8 __attribute__((ext_vector_type(8)));
typedef float f32x4 __attribute__((ext_vector_type(4)));
typedef unsigned u32x4 __attribute__((ext_vector_type(4)));
constexpr int BM = 256, BK = 64, HALF = 128, HTB = HALF * BK * 2  , STAGE_BYTES = 8 * HTB, NXCD = 8, WGM = 8;

__host__ __device__ __forceinline__ int lds_byte(int r, int c) { const int st = (r >> 4) * 2 + (c >> 5), rr = r & 15, cc = c & 31, ob = rr * 64 + cc * 2; return st * 1024 + (ob ^ (((ob >> 9) & 1) << 5)); }
__host__ __device__ __forceinline__ void stage_rc(int b, int& R, int& C) { const int st = b / 1024, sb = b % 1024, swz = sb ^ (((sb >> 9) & 1) << 5); R = (st >> 1) * 16 + swz / 64; C = (st & 1) * 32 + (swz % 64) / 2; }
__host__ __device__ __forceinline__ int perm32(int rho) { const int n = rho >> 4, i = rho & 15; return 8 * (i >> 2) + 4 * n + (i & 3); }

struct Unit { int pm, pn; };
struct Gemm { const bf16_t* A; const bf16_t* Bt; int M, N, K; };

struct StaticOrder {
    int nM, nN, nwg, G, c;
    __host__ __device__ void init(int M, int N, int G_, int c_) { nM = M / BM; nN = N / BM; nwg = nM * nN; G = G_; c = c_; }
    __host__ __device__ bool next(int i, Unit& u) const {
        const long L = (long)i * G + c; if (L >= nwg) return false;
        int wgid = (int)L; { const int q = nwg / NXCD, r = nwg % NXCD, xcd = wgid % NXCD, off = wgid / NXCD; wgid = (xcd < r ? xcd * (q + 1) : r * (q + 1) + (xcd - r) * q) + off; }
        const int nig = WGM * nN, gid = wgid / nig, fm = gid * WGM, gsz = (nM - fm) < WGM ? (nM - fm) : WGM;
        u.pm = fm + ((wgid % nig) % gsz); u.pn = (wgid % nig) / gsz; return true;
    }
    __device__ __forceinline__ void a_ready(const Unit&) const {}
    __device__ __forceinline__ void done(const Unit&) const {}
};

__device__ __forceinline__ unsigned cvt_pk_bf16(float lo, float hi) { unsigned r; asm volatile("v_cvt_pk_bf16_f32 %0, %1, %2" : "=v"(r) : "v"(lo), "v"(hi)); return r; }
template <int ACT> struct EpiBf16 {
    static constexpr bool PERM = true, AFTER_DRAIN = false;
    bf16_t* O; int ldc;
    __device__ __forceinline__ void operator()(const f32x4 (&acc)[2][2][4][2], const Unit& u, int wr, int wc, int fr, int fq) const {
        const int row0 = u.pm * BM + wr * 64 + fr; const int col0 = u.pn * BM + wc * 32 + 8 * fq;
#pragma unroll
        for (int ai = 0; ai < 2; ++ai)
#pragma unroll
            for (int m = 0; m < 4; ++m) { bf16_t* rowp = O + (size_t)(row0 + ai * HALF + m * 16) * ldc + col0;
#pragma unroll
                for (int bj = 0; bj < 2; ++bj) { f32x4 v0 = acc[ai][bj][m][0], v1 = acc[ai][bj][m][1];
                    if (ACT == 2) {
#pragma unroll
                        for (int e = 0; e < 4; ++e) { float a = fmaxf(v0[e], 0.f), b = fmaxf(v1[e], 0.f); v0[e] = a * a; v1[e] = b * b; } }
                    u32x4 w; w.x = cvt_pk_bf16(v0[0], v0[1]); w.y = cvt_pk_bf16(v0[2], v0[3]); w.z = cvt_pk_bf16(v1[0], v1[1]); w.w = cvt_pk_bf16(v1[2], v1[3]);
                    *(u32x4*)(rowp + bj * HALF) = w; } }
    }
};
struct EpiGen {
    static constexpr bool PERM = true, AFTER_DRAIN = false;
    bf16_t* O0; bf16_t* O1; int split, ld0, ld1, act;
    __device__ __forceinline__ void operator()(const f32x4 (&acc)[2][2][4][2], const Unit& u, int wr, int wc, int fr, int fq) const {
        const int row0 = u.pm * BM + wr * 64 + fr;
#pragma unroll
        for (int bj = 0; bj < 2; ++bj) {
            const int g0 = u.pn * BM + bj * HALF; const bool lo = g0 < split; bf16_t* base = lo ? (O0 + g0) : (O1 + (g0 - split)); const int ld = lo ? ld0 : ld1;
            base += wc * 32 + 8 * fq;
#pragma unroll
            for (int ai = 0; ai < 2; ++ai)
#pragma unroll
                for (int m = 0; m < 4; ++m) { f32x4 v0 = acc[ai][bj][m][0], v1 = acc[ai][bj][m][1];
                    if (act) {
#pragma unroll
                        for (int e = 0; e < 4; ++e) { const float a = fmaxf(v0[e], 0.f), b = fmaxf(v1[e], 0.f); v0[e] = a * a; v1[e] = b * b; } }
                    u32x4 w; w.x = cvt_pk_bf16(v0[0], v0[1]); w.y = cvt_pk_bf16(v0[2], v0[3]); w.z = cvt_pk_bf16(v1[0], v1[1]); w.w = cvt_pk_bf16(v1[2], v1[3]);
                    *(u32x4*)(base + (size_t)(row0 + ai * HALF + m * 16) * ld) = w; } }
    }
};
struct EpiRoute {
    static constexpr bool PERM = true, AFTER_DRAIN = false;
    bf16_t* PY; bf16_t* PX;
    __device__ __forceinline__ void operator()(const f32x4 (&acc)[2][2][4][2], const Unit& u, int wr, int wc, int fr, int fq) const {
        const int row0 = u.pm * BM + wr * 64 + fr;
#pragma unroll
        for (int bj = 0; bj < 2; ++bj) {
            const int g0 = u.pn * BM + bj * HALF; bf16_t* base = (g0 < 1408) ? (PY + g0) : (PX + (g0 - 1408));
            base += wc * 32 + 8 * fq;
#pragma unroll
            for (int ai = 0; ai < 2; ++ai)
#pragma unroll
                for (int m = 0; m < 4; ++m) { const f32x4 v0 = acc[ai][bj][m][0], v1 = acc[ai][bj][m][1];
                    u32x4 w; w.x = cvt_pk_bf16(v0[0], v0[1]); w.y = cvt_pk_bf16(v0[2], v0[3]); w.z = cvt_pk_bf16(v1[0], v1[1]); w.w = cvt_pk_bf16(v1[2], v1[3]);
                    *(u32x4*)(base + (size_t)(row0 + ai * HALF + m * 16) * 1408) = w; } }
    }
};
template <class Epi, class Sched, bool ALIGN_EPI = false, bool SP2 = false>
__device__ __forceinline__ void gemm_phase(PG8_LAS unsigned char* lds, const Gemm g, const Sched& S, const Epi& E, const int tid) {
    const int wid = __builtin_amdgcn_readfirstlane(tid >> 6), lane = tid & 63, wr = wid >> 2, wc = wid & 3, fr = lane & 15, fq = lane >> 4;
    const int K = g.K, nt = K / BK;
    unsigned voffA[2], voffB[2];
#pragma unroll
    for (int i = 0; i < 2; ++i) { int R, C; stage_rc(tid * 16 + i * 8192, R, C); const int Rb = Epi::PERM ? ((R & ~31) + perm32(R & 31)) : R;
        voffA[i] = (unsigned)(R * K + C) * 2u; voffB[i] = (unsigned)(Rb * K + C) * 2u; }
    const size_t kstep = (size_t)(BK * 2);
    const size_t hstep = (size_t)HALF * K * 2;
    const size_t tstep = 2 * hstep;
    const unsigned ldsw = (unsigned)wid * 1024u;
    const int aoff = lds_byte(wr * 64 + fr, fq * 8), boff = lds_byte(wc * 32 + fr, fq * 8);
#define PG8_SA(b, h) (((b) * 2 + (h)) * HTB)
#define PG8_SB(b, h) ((4 + (b) * 2 + (h)) * HTB)
#define PG8_STAGE(bufoff, gbase, voff) do { _Pragma("unroll") for (int _i = 0; _i < 2; ++_i) \
        __builtin_amdgcn_global_load_lds((const unsigned*)((const char*)(gbase) + (voff)[_i]), (PG8_LAS unsigned*)(lds + (bufoff) + ldsw + _i * 8192), 16, 0, 0); } while (0)
#define PG8_LDA(dst, b, h) do { _Pragma("unroll") for (int m = 0; m < 4; ++m) _Pragma("unroll") for (int k = 0; k < 2; ++k) dst[m][k] = *(const PG8_LAS bf16x8*)(lds + PG8_SA(b, h) + aoff + m * 2048 + k * 1024); } while (0)
#define PG8_LDB(dst, b, h) do { _Pragma("unroll") for (int n = 0; n < 2; ++n) _Pragma("unroll") for (int k = 0; k < 2; ++k) dst[n][k] = *(const PG8_LAS bf16x8*)(lds + PG8_SB(b, h) + boff + n * 2048 + k * 1024); } while (0)
#define PG8_MMA(ai, bj, At, Bt) do { __builtin_amdgcn_s_setprio(1); _Pragma("unroll") for (int m = 0; m < 4; ++m) _Pragma("unroll") for (int n = 0; n < 2; ++n) _Pragma("unroll") for (int k = 0; k < 2; ++k) \
        acc[ai][bj][m][n] = __builtin_amdgcn_mfma_f32_16x16x32_bf16(Bt[n][k], At[m][k], acc[ai][bj][m][n], 0, 0, 0); __builtin_amdgcn_s_setprio(0); } while (0)
#define PG8_WAIT_V(n) asm volatile("s_waitcnt vmcnt(" #n ")" ::: "memory")
#define PG8_WAIT_L(n) asm volatile("s_waitcnt lgkmcnt(" #n ")" ::: "memory")
#define PG8_BAR __builtin_amdgcn_s_barrier()
#define PG8_SCHED __builtin_amdgcn_sched_barrier(0)
    Unit cur, nxt; int ui = 0;
    if (!S.next(0, cur)) return;
    f32x4 acc[2][2][4][2];
#pragma unroll
    for (int a = 0; a < 2; ++a)
#pragma unroll
        for (int b = 0; b < 2; ++b)
#pragma unroll
            for (int m = 0; m < 4; ++m)
#pragma unroll
                for (int n = 0; n < 2; ++n) acc[a][b][m][n] = (f32x4){0.f, 0.f, 0.f, 0.f};
    bf16x8 At[4][2], B0[2][2], B1[2][2];
    const char* cA = (const char*)g.A + (size_t)cur.pm * tstep; const char* cB = (const char*)g.Bt + (size_t)cur.pn * tstep;
    S.a_ready(cur);
    if constexpr (SP2) {
        PG8_STAGE(PG8_SB(0, 0), cB, voffB); PG8_STAGE(PG8_SB(0, 1), cB + hstep, voffB); PG8_STAGE(PG8_SA(0, 0), cA, voffA); PG8_STAGE(PG8_SA(0, 1), cA + hstep, voffA);
        if (wr == 1) PG8_BAR;
        PG8_WAIT_V(2); PG8_BAR;
        PG8_STAGE(PG8_SB(1, 0), cB + kstep, voffB); PG8_STAGE(PG8_SA(1, 0), cA + kstep, voffA); PG8_STAGE(PG8_SB(1, 1), cB + hstep + kstep, voffB);
        PG8_WAIT_V(6); PG8_BAR;
    } else {
        PG8_STAGE(PG8_SB(0, 0), cB, voffB); PG8_STAGE(PG8_SA(0, 0), cA, voffA); PG8_STAGE(PG8_SB(0, 1), cB + hstep, voffB); PG8_STAGE(PG8_SA(0, 1), cA + hstep, voffA);
        if (wr == 1) PG8_BAR;
        PG8_WAIT_V(4); PG8_BAR;
        PG8_STAGE(PG8_SB(1, 0), cB + kstep, voffB); PG8_STAGE(PG8_SA(1, 0), cA + kstep, voffA); PG8_STAGE(PG8_SB(1, 1), cB + hstep + kstep, voffB);
        PG8_WAIT_V(6); PG8_BAR;
    }
    for (;;) {
        const bool has_next = S.next(ui + 1, nxt);
        const char* nA = has_next ? (const char*)g.A + (size_t)nxt.pm * tstep : cA; const char* nB = has_next ? (const char*)g.Bt + (size_t)nxt.pn * tstep : cB;
        for (int t = 0; t < nt; t += 2) {
            const bool last = (t == nt - 2);
            const char* a1 = cA + (size_t)(t + 1) * kstep;
            const char* a2 = last ? nA : cA + (size_t)(t + 2) * kstep; const char* b2 = last ? nB : cB + (size_t)(t + 2) * kstep;
            const char* a3 = a2 + kstep; const char* b3 = b2 + kstep;
            if (last && has_next) S.a_ready(nxt);
            if constexpr (SP2) {
            PG8_LDB(B0, 0, 0); PG8_LDB(B1, 0, 1); PG8_SCHED; PG8_LDA(At, 0, 0); PG8_STAGE(PG8_SA(1, 1), a1 + hstep, voffA);
            PG8_WAIT_V(8); PG8_WAIT_L(0); PG8_BAR; PG8_MMA(0, 0, At, B0); PG8_MMA(0, 1, At, B1); PG8_BAR; PG8_SCHED;
            PG8_LDA(At, 0, 1); PG8_STAGE(PG8_SB(0, 0), b2, voffB); PG8_STAGE(PG8_SB(0, 1), b2 + hstep, voffB); PG8_STAGE(PG8_SA(0, 0), a2, voffA);
            PG8_WAIT_V(8); PG8_WAIT_L(0); PG8_BAR; PG8_MMA(1, 0, At, B0); PG8_MMA(1, 1, At, B1); PG8_BAR; PG8_SCHED;
            PG8_LDB(B0, 1, 0); PG8_LDB(B1, 1, 1); PG8_SCHED; PG8_LDA(At, 1, 0); PG8_STAGE(PG8_SA(0, 1), a2 + hstep, voffA);
            PG8_WAIT_V(8); PG8_WAIT_L(0); PG8_BAR; PG8_MMA(0, 0, At, B0); PG8_MMA(0, 1, At, B1); PG8_BAR; PG8_SCHED;
            PG8_LDA(At, 1, 1); PG8_STAGE(PG8_SB(1, 0), b3, voffB); PG8_STAGE(PG8_SB(1, 1), b3 + hstep, voffB); PG8_STAGE(PG8_SA(1, 0), a3, voffA);
            PG8_WAIT_V(8); PG8_WAIT_L(0); PG8_BAR; PG8_MMA(1, 0, At, B0); PG8_MMA(1, 1, At, B1); PG8_BAR; PG8_SCHED;
            } else {
            PG8_LDB(B0, 0, 0); PG8_SCHED; PG8_LDA(At, 0, 0); PG8_STAGE(PG8_SA(1, 1), a1 + hstep, voffA);
            PG8_WAIT_L(8); PG8_BAR; PG8_WAIT_L(0); PG8_MMA(0, 0, At, B0); PG8_BAR; PG8_SCHED;
            PG8_LDB(B1, 0, 1); PG8_STAGE(PG8_SB(0, 0), b2, voffB);
            PG8_BAR; PG8_WAIT_L(0); PG8_MMA(0, 1, At, B1); PG8_BAR;
            PG8_LDA(At, 0, 1); PG8_STAGE(PG8_SA(0, 0), a2, voffA);
            PG8_BAR; PG8_WAIT_L(0); PG8_MMA(1, 0, At, B0); PG8_BAR; PG8_SCHED;
            PG8_STAGE(PG8_SB(0, 1), b2 + hstep, voffB);
            PG8_WAIT_V(6); PG8_BAR; PG8_MMA(1, 1, At, B1); PG8_BAR;
            PG8_LDB(B0, 1, 0); PG8_SCHED; PG8_LDA(At, 1, 0); PG8_STAGE(PG8_SA(0, 1), a2 + hstep, voffA);
            PG8_WAIT_L(8); PG8_BAR; PG8_WAIT_L(0); PG8_MMA(0, 0, At, B0); PG8_BAR; PG8_SCHED;
            PG8_LDB(B1, 1, 1); PG8_STAGE(PG8_SB(1, 0), b3, voffB);
            PG8_BAR; PG8_WAIT_L(0); PG8_MMA(0, 1, At, B1); PG8_BAR;
            PG8_LDA(At, 1, 1); PG8_STAGE(PG8_SA(1, 0), a3, voffA);
            PG8_BAR; PG8_WAIT_L(0); PG8_MMA(1, 0, At, B0); PG8_BAR; PG8_SCHED;
            PG8_STAGE(PG8_SB(1, 1), b3 + hstep, voffB);
            PG8_WAIT_V(6); PG8_BAR; PG8_MMA(1, 1, At, B1); PG8_BAR;
            }
        }
        if constexpr (ALIGN_EPI) { if (wr == 0) PG8_BAR; }
        if constexpr (!Epi::AFTER_DRAIN) { E(acc, cur, wr, wc, fr, fq); S.done(cur); }
        if (!has_next) break;
#pragma unroll
        for (int a = 0; a < 2; ++a)
#pragma unroll
            for (int b = 0; b < 2; ++b)
#pragma unroll
                for (int m = 0; m < 4; ++m)
#pragma unroll
                    for (int n = 0; n < 2; ++n) acc[a][b][m][n] = (f32x4){0.f, 0.f, 0.f, 0.f};
        cur = nxt; cA = nA; cB = nB; ++ui;
        if constexpr (ALIGN_EPI) { if (wr == 1) PG8_BAR; }
    }
    PG8_WAIT_V(0);
    if constexpr (!ALIGN_EPI) { if (wr == 0) PG8_BAR; }
    PG8_BAR;
    if constexpr (Epi::AFTER_DRAIN) { E.fused(acc, cur, wr, wc, fr, fq, lds, wid, lane); S.done(cur); }
#undef PG8_SA
#undef PG8_SB
#undef PG8_STAGE
#undef PG8_LDA
#undef PG8_LDB
#undef PG8_MMA
#undef PG8_WAIT_V
#undef PG8_WAIT_L
#undef PG8_BAR
#undef PG8_SCHED
}
}
#define GAS __attribute__((address_space(1)))
#define LAS __attribute__((address_space(3)))
typedef unsigned short bf16;
typedef unsigned v4u __attribute__((ext_vector_type(4)));
typedef float f32x4 __attribute__((ext_vector_type(4)));
typedef short bf16x8 __attribute__((ext_vector_type(8)));
typedef GAS unsigned gu32;
typedef GAS unsigned long long gu64;
#define RLX_AGENT __ATOMIC_RELAXED, __HIP_MEMORY_SCOPE_AGENT
#define LDS_WAIT() asm volatile("s_waitcnt lgkmcnt(0)" ::: "memory")
#define VM_WAIT() asm volatile("s_waitcnt vmcnt(0)" ::: "memory")
__device__ __forceinline__ unsigned long long rt() { return __builtin_amdgcn_s_memrealtime(); }
__device__ __forceinline__ unsigned f2bf(float f) { unsigned u = __builtin_bit_cast(unsigned, f); return (u + 0x7fffu + ((u >> 16) & 1u)) >> 16; }
__device__ __forceinline__ unsigned pk2(float lo, float hi) { return f2bf(lo) | (f2bf(hi) << 16); }

#define XB_TMO      128
#define XB_XCNT(j)  (256  + 64 * (j))
#define XB_XSUB(j)  (1280 + 64 * (j))
#define XB_XGEN(j)  (2304 + 64 * (j))
#define XB_TOP      3328
#define XB_TOPGEN   3392
#define XCD_BAR_WORDS 3456
#define XB_SPIN_CAP (1u << 18)

__device__ __forceinline__ unsigned xb_ld(unsigned* p)              { return __hip_atomic_load(p, __ATOMIC_RELAXED, __HIP_MEMORY_SCOPE_AGENT); }
__device__ __forceinline__ unsigned xb_add(unsigned* p, unsigned v) { return __hip_atomic_fetch_add(p, v, __ATOMIC_RELAXED, __HIP_MEMORY_SCOPE_AGENT); }
__device__ __forceinline__ unsigned xb_xcc_id() { return (unsigned)__builtin_amdgcn_s_getreg((3 << 11) | 20) & 0xFu; }
#define XB_SPIN(cond, bar) do { unsigned _sp = 0; while (cond) { __builtin_amdgcn_s_sleep(1); \
    if ((++_sp & 255u) == 0u) { if (xb_ld(&(bar)[XB_TMO])) break; if (_sp > XB_SPIN_CAP) { atomicAdd(&(bar)[XB_TMO], 1u); break; } } } } while (0)

struct XcdBarrier {
    unsigned* bar; unsigned x;
    volatile LAS unsigned* st;
};

__device__ __forceinline__ XcdBarrier xcd_barrier_post(unsigned* bar, volatile LAS unsigned* st) {
    XcdBarrier b; b.bar = bar; b.x = xb_xcc_id(); b.st = st;
    if (threadIdx.x == 0) (void)xb_add(&bar[XB_XCNT(b.x)], 1u);
    return b;
}
__device__ __forceinline__ void xcd_barrier_complete(unsigned* bar, unsigned x, unsigned& nloc, unsigned& nx) {
    const unsigned G = gridDim.x * gridDim.y * gridDim.z;
    unsigned sum, cnt, mine, sp = 0u;
    for (;;) {
        sum = 0u; cnt = 0u; mine = 0u;
#pragma unroll
        for (unsigned j = 0; j < 16; ++j) { const unsigned c = xb_ld(&bar[XB_XCNT(j)]); sum += c; cnt += (c > 0u) ? 1u : 0u; mine = (j == x) ? c : mine; }
        if (sum == G) break;
        __builtin_amdgcn_s_sleep(1);
        if ((++sp & 255u) == 0u) { if (xb_ld(&bar[XB_TMO])) break; if (sp > XB_SPIN_CAP) { atomicAdd(&bar[XB_TMO], 1u); break; } }
    }
    nloc = mine > 0u ? mine : 1u; nx = cnt > 0u ? cnt : 1u;
}

__device__ __forceinline__ void xcd_barrier(const XcdBarrier& b) {
    asm volatile("s_waitcnt vmcnt(0)" ::: "memory");
    __syncthreads();
    if (threadIdx.x == 0) {
        unsigned* bar = b.bar;
        __builtin_amdgcn_s_waitcnt(0);
        unsigned nloc = b.st[0], nx = b.st[1];
        if (nloc == 0u) { xcd_barrier_complete(bar, b.x, nloc, nx); b.st[0] = nloc; b.st[1] = nx; }
        const unsigned old = xb_add(&bar[XB_XSUB(b.x)], 1u);
        const unsigned gen = old / nloc;
        if (old + 1u == (gen + 1u) * nloc) {
            __builtin_amdgcn_fence(__ATOMIC_RELEASE, "agent");
            asm volatile("s_waitcnt vmcnt(0)" ::: "memory");
            const unsigned og = xb_add(&bar[XB_TOP], 1u);
            const unsigned tg = og / nx;
            if (og + 1u == (tg + 1u) * nx) xb_add(&bar[XB_TOPGEN], 1u);
            else XB_SPIN(xb_ld(&bar[XB_TOPGEN]) == tg, bar);
            __builtin_amdgcn_fence(__ATOMIC_ACQUIRE, "agent");
            xb_add(&bar[XB_XGEN(b.x)], 1u);
            asm volatile("s_waitcnt vmcnt(0)" ::: "memory");
        } else {
            XB_SPIN(xb_ld(&bar[XB_XGEN(b.x)]) == gen, bar);
            __builtin_amdgcn_fence(__ATOMIC_ACQUIRE, "agent");
            asm volatile("s_waitcnt vmcnt(0)" ::: "memory");
        }
    }
    __syncthreads();
}
constexpr int NWAVES = 8;
constexpr int D = 1024, MH = 16384, NIN = 2816, FF = 4096, RW = 384, NH = 6, PXW = 1408;
constexpr float NORM_EPS = 1e-6f, GN_EPS = 64e-5f, LOG2E = 1.4426950408889634f, LN2 = 0.6931471805599453f;
enum { I_XP = 0, I_XS, I_NMPRE, I_NMPOST, I_NFPRE, I_NFPOST, I_WIN, I_WOUT, I_POOLW, I_POOLS, I_CONV, I_DW0, I_DUP, I_IA0, I_IUP, I_GUP, I_KK, I_KA, I_BRK, I_GNG, I_GNB, I_RELB, I_WFI, I_WFO };
constexpr size_t MiB = 1u << 20;
constexpr size_t WS_CTL = 0, CTL_ZERO_BYTES = 1 * MiB;
constexpr size_t WS_SMALL = 1 * MiB;
constexpr size_t WS_W = 2 * MiB, W_LAYER = 47 * MiB / 2;
constexpr size_t W_IN = 0, W_OUT = 11 * MiB / 2, W_FFI = 15 * MiB / 2, W_FFO = 31 * MiB / 2;
constexpr size_t WS_XN = 51 * MiB, WS_MIX = 83 * MiB, WS_PX = 115 * MiB, WS_PY = 159 * MiB, WS_FREE = 203 * MiB, WS_END = 256 * MiB;
constexpr size_t WS_H = 115 * MiB;
constexpr size_t WS_F1 = 159 * MiB;
constexpr size_t WS_OB = 203 * MiB, WS_LSE = 239 * MiB;
constexpr size_t WS_GP = 159 * MiB, WS_H0T = 183 * MiB, WS_RY = 207 * MiB, WS_Y0 = 231 * MiB, WS_HC = 51 * MiB, WS_DC = 75 * MiB, WS_BON = 76 * MiB;
constexpr int CW_TMO = 0, CW_CODE = 1, CW_BAR = 4096;
constexpr int RING_OFF = 0, RING_BYTES = 131072, LDSCTL_OFF = RING_BYTES, MISC_OFF = LDSCTL_OFF + 320, LDS_BYTES = 147456;
typedef float f32x16 __attribute__((ext_vector_type(16)));
typedef unsigned v2u __attribute__((ext_vector_type(2)));
typedef float f32x2_t __attribute__((ext_vector_type(2))); typedef __bf16 bf16x2_t __attribute__((ext_vector_type(2)));
__device__ __forceinline__ unsigned cvtpk(float lo, float hi) { f32x2_t v = {lo, hi}; bf16x2_t b = __builtin_convertvector(v, bf16x2_t); return __builtin_bit_cast(unsigned, b); }
__device__ __forceinline__ float bf2f(unsigned u) { return __builtin_bit_cast(float, u << 16); }
__device__ __forceinline__ float bflo(unsigned w) { return __builtin_bit_cast(float, w << 16); }
__device__ __forceinline__ float bfhi(unsigned w) { return __builtin_bit_cast(float, w & 0xffff0000u); }
__device__ __forceinline__ f32x16 mfma32(bf16x8 a, bf16x8 b, f32x16 c) { return __builtin_amdgcn_mfma_f32_32x32x16_bf16(a, b, c, 0, 0, 0); }
__device__ __forceinline__ f32x4 mfma16(bf16x8 a, bf16x8 b, f32x4 c) { return __builtin_amdgcn_mfma_f32_16x16x32_bf16(a, b, c, 0, 0, 0); }
__device__ __forceinline__ int crow(int i, int hh) { return (i & 3) + 8 * (i >> 2) + 4 * hh; }
__device__ __forceinline__ bf16x8 pack8(const f32x16& x, int s) {
    v4u p; p.x = cvtpk(x[8 * s], x[8 * s + 1]); p.y = cvtpk(x[8 * s + 2], x[8 * s + 3]); p.z = cvtpk(x[8 * s + 4], x[8 * s + 5]); p.w = cvtpk(x[8 * s + 6], x[8 * s + 7]);
    return __builtin_bit_cast(bf16x8, p);
}
__device__ __forceinline__ float sigmoidf_(float x) { return __builtin_amdgcn_rcpf(1.0f + __builtin_amdgcn_exp2f(-1.4426950408889634f * x)); }
__device__ __forceinline__ float tanhf_(float x) { return 1.0f - 2.0f * __builtin_amdgcn_rcpf(1.0f + __builtin_amdgcn_exp2f(2.8853900817779268f * x)); }
__device__ __forceinline__ float shx(float v, int m, int lane) { return __builtin_bit_cast(float, __builtin_amdgcn_ds_bpermute((lane ^ m) << 2, __builtin_bit_cast(int, v))); }
__device__ __forceinline__ float wave_sum(float v, int lane) {
#pragma unroll
    for (int o = 1; o < 64; o <<= 1) v += shx(v, o, lane);
    return v;
}

struct Frame {
    LAS unsigned char* lds;
    volatile LAS unsigned* MISC;
    gu32* ctl;
    int tid, lane, wave, G, vcu;
    float* out; unsigned char* ws;
};
#define WSP(T, off) ((T*)(F.ws + (off)))
struct Args { const float* in[24]; float* out; unsigned char* ws; int ph_lo, ph_hi, li, pad; };
#define KARG const Args& KA
#define INP(i) (KA.in[i])

__device__ __forceinline__ void transpose_item(const float* W, int ldw, int K, bf16* WT, int n0, int srccol0, int k0, LAS float* scr, int lane) {
#pragma unroll 8
    for (int i = 0; i < 32; ++i) { const int kk = 2 * i + (lane >> 5); scr[kk * 33 + (lane & 31)] = W[(size_t)(k0 + kk) * ldw + srccol0 + (lane & 31)]; }
    LDS_WAIT(); asm volatile("" ::: "memory");
    const int c = lane & 7;
#pragma unroll
    for (int j = 0; j < 4; ++j) { const int n = (lane >> 3) + 8 * j; const LAS float* s = scr + (8 * c) * 33 + n;
        v4u o; o.x = pk2(s[0 * 33], s[1 * 33]); o.y = pk2(s[2 * 33], s[3 * 33]); o.z = pk2(s[4 * 33], s[5 * 33]); o.w = pk2(s[6 * 33], s[7 * 33]);
        *(GAS v4u*)(WT + (size_t)(n0 + n) * K + k0 + 8 * c) = o; }
    LDS_WAIT(); asm volatile("" ::: "memory");
}
__device__ __forceinline__ int win_src(int n) { return n < 256 ? n : (n < 1408 ? 1664 + (n - 256) : (n < 2560 ? 256 + (n - 1408) : 1408 + (n - 2560))); }
__device__ __forceinline__ void phase_weights(KARG, Frame& F) {
    LAS float* scr = (LAS float*)(F.lds + RING_OFF + F.wave * 16384);
    const int gw = F.vcu * NWAVES + F.wave, NGW = F.G * NWAVES;
    constexpr int I_IN = (D / 64) * (NIN / 32), I_OUT = (D / 64) * (D / 32), I_FI = (D / 64) * (FF / 32), I_FO = (FF / 64) * (D / 32), I_G = (128 / 64) * (RW / 32);
    constexpr int I_U = 4 * (RW / 32);
    constexpr int PER_L = I_IN + I_OUT + I_FI + I_FO + I_G + I_U;
    for (int it = gw; it < 2 * PER_L; it += NGW) {
        const int l = it / PER_L; int r = it % PER_L;
        unsigned char* wl = F.ws + WS_W + (size_t)l * W_LAYER;
        if (r < I_IN) { const int nb = r % (NIN / 32), kb = r / (NIN / 32); transpose_item(KA.in[I_WIN] + (size_t)l * D * NIN, NIN, D, (bf16*)(wl + W_IN), 32 * nb, win_src(32 * nb), 64 * kb, scr, F.lane); continue; } r -= I_IN;
        if (r < I_OUT) { const int nb = r % (D / 32), kb = r / (D / 32); transpose_item(KA.in[I_WOUT] + (size_t)l * D * D, D, D, (bf16*)(wl + W_OUT), 32 * nb, 32 * nb, 64 * kb, scr, F.lane); continue; } r -= I_OUT;
        if (r < I_FI) { const int nb = r % (FF / 32), kb = r / (FF / 32); transpose_item(KA.in[I_WFI] + (size_t)l * D * FF, FF, D, (bf16*)(wl + W_FFI), 32 * nb, 32 * nb, 64 * kb, scr, F.lane); continue; } r -= I_FI;
        if (r < I_FO) { const int nb = r % (D / 32), kb = r / (D / 32); transpose_item(KA.in[I_WFO] + (size_t)l * FF * D, D, FF, (bf16*)(wl + W_FFO), 32 * nb, 32 * nb, 64 * kb, scr, F.lane); continue; } r -= I_FO;
        if (r < I_G) { const int nb = r % (RW / 32), kb = r / (RW / 32); transpose_item(KA.in[I_GUP] + (size_t)l * 128 * RW, RW, 128, WSP(bf16, WS_SMALL) + (size_t)l * RW * 128, 32 * nb, 32 * nb, 64 * kb, scr, F.lane); continue; } r -= I_G;
        { const int nb = r % (RW / 32), which = r / (RW / 32), d = which & 1, isI = which >> 1;
          transpose_item(KA.in[isI ? I_IUP : I_DUP] + (size_t)(l * 2 + d) * 64 * RW, RW, 64, WSP(bf16, WS_SMALL) + 98304 * (1 + isI) + (size_t)(l * 2 + d) * RW * 64, 32 * nb, 32 * nb, 0, scr, F.lane); }
    }
}
__device__ __forceinline__ void phase_xn_init(KARG, Frame& F, int hf) {
    const int gw = F.vcu * NWAVES + F.wave, NGW = F.G * NWAVES;
    const float* X = KA.in[hf ? I_XS : I_XP]; const GAS f32x4* gp = (const GAS f32x4*)KA.in[I_NMPRE] + F.lane;
    f32x4 g[4];
#pragma unroll
    for (int j = 0; j < 4; ++j) g[j] = gp[64 * j];
    for (int m = gw; m < MH; m += NGW) {
        const GAS f32x4* xr = (const GAS f32x4*)(X + (size_t)m * D) + F.lane; f32x4 v[4]; float s = 0.f;
#pragma unroll
        for (int j = 0; j < 4; ++j) { v[j] = xr[64 * j]; s += (v[j].x * v[j].x + v[j].y * v[j].y) + (v[j].z * v[j].z + v[j].w * v[j].w); }
        const float rstd = 1.0f / sqrtf(wave_sum(s, F.lane) * (1.f / D) + NORM_EPS);
        GAS v2u* o8 = (GAS v2u*)(WSP(bf16, WS_XN) + (size_t)m * D) + F.lane;
#pragma unroll
        for (int j = 0; j < 4; ++j) { v2u w; w.x = pk2(v[j].x * rstd * g[j].x, v[j].y * rstd * g[j].y); w.y = pk2(v[j].z * rstd * g[j].z, v[j].w * rstd * g[j].w); o8[64 * j] = w; }
    }
}
__device__ __forceinline__ void phase_rowpass(KARG, Frame& F, int hf, const bf16* Fm, const float* base, const float* gpost, const float* gnext) {
    const int gw = F.vcu * NWAVES + F.wave, NGW = F.G * NWAVES;
    f32x4 gp[4], gn[4];
#pragma unroll
    for (int j = 0; j < 4; ++j) { gp[j] = ((const GAS f32x4*)gpost + F.lane)[64 * j]; gn[j] = gnext ? ((const GAS f32x4*)gnext + F.lane)[64 * j] : (f32x4){0.f, 0.f, 0.f, 0.f}; }
    float* out = F.out + (size_t)hf * MH * D;
    for (int m = gw; m < MH; m += NGW) {
        const GAS v2u* fr = (const GAS v2u*)(Fm + (size_t)m * D) + F.lane; const GAS f32x4* xr = (const GAS f32x4*)(base + (size_t)m * D) + F.lane;
        f32x4 f[4], x[4]; float s = 0.f;
#pragma unroll
        for (int j = 0; j < 4; ++j) { const v2u w = fr[64 * j]; x[j] = xr[64 * j]; f[j] = (f32x4){bflo(w.x), bfhi(w.x), bflo(w.y), bfhi(w.y)}; s += (f[j].x * f[j].x + f[j].y * f[j].y) + (f[j].z * f[j].z + f[j].w * f[j].w); }
        const float rstd = 1.0f / sqrtf(wave_sum(s, F.lane) * (1.f / D) + NORM_EPS); float s2 = 0.f;
        GAS f32x4* orow = (GAS f32x4*)(out + (size_t)m * D) + F.lane;
#pragma unroll
        for (int j = 0; j < 4; ++j) { x[j] = x[j] + f[j] * rstd * gp[j]; orow[64 * j] = x[j]; s2 += (x[j].x * x[j].x + x[j].y * x[j].y) + (x[j].z * x[j].z + x[j].w * x[j].w); }
        if (gnext) {
            const float r2 = 1.0f / sqrtf(wave_sum(s2, F.lane) * (1.f / D) + NORM_EPS);
            GAS v2u* o8 = (GAS v2u*)(WSP(bf16, WS_XN) + (size_t)m * D) + F.lane;
#pragma unroll
            for (int j = 0; j < 4; ++j) { v2u w; w.x = pk2(x[j].x * r2 * gn[j].x, x[j].y * r2 * gn[j].y); w.y = pk2(x[j].z * r2 * gn[j].z, x[j].w * r2 * gn[j].w); o8[64 * j] = w; }
        }
    }
}
__device__ __forceinline__ void pool_tile(KARG, Frame& F, int hf, int l, int tile) {
    LAS float* U = (LAS float*)(F.lds + RING_OFF);
    LAS float* Pd = U + 48 * 256;
    const bf16* PY = WSP(bf16, WS_PY); bf16* MIX = WSP(bf16, WS_MIX);
    const int T = hf ? 16384 : 8192; const int r0 = tile * 32; const int sbase = hf ? 0 : (r0 & ~8191); const int t0 = r0 - sbase;
    __syncthreads();
    for (int i = F.tid; i < 48 * 32; i += 512) { const int rr = i >> 5, c8 = (i & 31) * 8; const int t = t0 - 8 + rr;
        if (t >= 0 && t < T) { const v4u w = *(const GAS v4u*)(PY + (size_t)(sbase + t) * PXW + c8); LAS float* u = U + rr * 256 + c8;
            u[0] = bflo(w.x); u[1] = bfhi(w.x); u[2] = bflo(w.y); u[3] = bfhi(w.y); u[4] = bflo(w.z); u[5] = bfhi(w.z); u[6] = bflo(w.w); u[7] = bfhi(w.w); } }
    __syncthreads();
    { const int ch = F.tid & 255, g = ch >> 6, win = 2 << g, hw = win >> 1;
      for (int tt = F.tid >> 8; tt < 32; tt += 2) { const int t = t0 + tt; int lo = t - hw; if (lo < 0) lo = 0; int hi = t + win - hw; if (hi > T) hi = T;
          float s = 0.f; for (int q = lo; q < hi; ++q) s += U[(q - t0 + 8) * 256 + ch];
          Pd[tt * 256 + ch] = s / (float)(hi - lo) - U[(tt + 8) * 256 + ch]; } }
    __syncthreads();
    { const int d = F.tid & 63, g = (F.tid >> 6) & 3, tg = F.tid >> 8;
      const float* pw = KA.in[I_POOLW] + (size_t)l * 4 * 64 * 64 + g * 4096 + d; const float sc = KA.in[I_POOLS][l * 256 + g * 64 + d];
      float acc[16];
#pragma unroll
      for (int i = 0; i < 16; ++i) acc[i] = 0.f;
      for (int c = 0; c < 64; ++c) { const float w = pw[c * 64];
#pragma unroll
          for (int i = 0; i < 16; ++i) acc[i] += Pd[(tg * 16 + i) * 256 + g * 64 + c] * w; }
#pragma unroll
      for (int i = 0; i < 16; ++i) MIX[(size_t)(r0 + tg * 16 + i) * D + g * 64 + d] = (bf16)f2bf(acc[i] * sc); }
}
constexpr int BT_STRIDE = 192;
__device__ __forceinline__ void attn_bias_table(KARG, Frame& F, LAS float* bt) {
    const float* rb = KA.in[I_RELB];
    for (int i = F.tid; i < 18 * BT_STRIDE; i += 512) { const int bh = i / BT_STRIDE, o = i % BT_STRIDE, b = bh / 6, h = bh % 6; const int rel = o - 96; float val = 0.f;
        if (rel >= -64 && rel <= 64) { const int rp = rel * (1 << (2 * b)); int ret = rp > 0 ? 16 : 0; const int n = rp < 0 ? -rp : rp;
            if (n < 8) ret += n; else { const float nf = (float)n; int large = 8 + (int)(logf(nf / 8.0f) / logf(128.0f) * 8.0f); if (large > 15) large = 15; ret += large; }
            val = rb[ret * 6 + h] * LOG2E; }
        bt[i] = val; }
}
__device__ __forceinline__ void attn_unit(Frame& F, int hf, int uidx, const LAS float* btab) {
    const int lane = F.lane, c31 = lane & 31, hh = lane >> 5;
    const int T = hf ? 16384 : 8192, nblk = T >> 6, nseq = hf ? 1 : 2;
    const int qt = uidx & 1; int g = uidx >> 1; const int blk = g % nblk; g /= nblk; const int s = g % nseq; g /= nseq; const int h = g % 6, b = g / 6;
    const int dsh = 2 * b, L = T >> dsh, nbs = L >> 6, r = blk / nbs, n = blk % nbs, row0 = s * 8192 + r;
    const bf16* PY = WSP(bf16, WS_PY);
    bf16x8 idf[2];
#pragma unroll
    for (int p = 0; p < 2; ++p)
#pragma unroll
        for (int e = 0; e < 8; ++e) idf[p][e] = (c31 - 16 * p - 8 * hh == e) ? (short)0x3F80 : (short)0;
    const int qi = 32 * qt + c31; const int qrow = row0 + ((64 * n + qi) << dsh);
    bf16x8 qf[4];
#pragma unroll
    for (int ks = 0; ks < 4; ++ks) qf[ks] = *(const GAS bf16x8*)(PY + (size_t)qrow * PXW + 256 + h * 64 + 8 * hh + 16 * ks);
    f32x16 sacc[5];
#pragma unroll
    for (int k5 = 0; k5 < 5; ++k5) { int kp = 64 * (n - 1) + 32 * (qt + k5) + c31; kp = kp < 0 ? 0 : (kp > L - 1 ? L - 1 : kp);
        const bf16* kptr = PY + (size_t)(row0 + (kp << dsh)) * PXW + 640 + h * 64 + 8 * hh; f32x16 a = {};
#pragma unroll
        for (int ks = 0; ks < 4; ++ks) a = mfma32(*(const GAS bf16x8*)(kptr + 16 * ks), qf[ks], a);
        sacc[k5] = a; }
    const LAS float* bt = btab + (b * 6 + h) * BT_STRIDE + 32 - qi;
    const float SC = 0.125f * LOG2E; float m = -3.0e38f;
#pragma unroll
    for (int k5 = 0; k5 < 5; ++k5)
#pragma unroll
        for (int i = 0; i < 16; ++i) { const int j = 32 * (qt + k5) + crow(i, hh); const int rel = j - 64 - qi, kp = 64 * (n - 1) + j;
            const bool valid = (rel >= -64) && (rel <= 64) && (kp >= 0) && (kp < L);
            float t = sacc[k5][i] * SC + bt[j]; t = valid ? t : -1.0e30f; sacc[k5][i] = t; m = fmaxf(m, t); }
    m = fmaxf(m, shx(m, 32, lane)); float lsum = 0.f;
#pragma unroll
    for (int k5 = 0; k5 < 5; ++k5)
#pragma unroll
        for (int i = 0; i < 16; ++i) { const float p = __builtin_amdgcn_exp2f(sacc[k5][i] - m); sacc[k5][i] = p; lsum += p; }
    lsum += shx(lsum, 32, lane); const float inv = 1.0f / lsum;
    f32x16 o[2] = {};
#pragma unroll
    for (int k5 = 0; k5 < 5; ++k5) { int kp = 64 * (n - 1) + 32 * (qt + k5) + c31; kp = kp < 0 ? 0 : (kp > L - 1 ? L - 1 : kp);
        const bf16* vptr = PY + (size_t)(row0 + (kp << dsh)) * PXW + 1024 + h * 64 + 8 * hh; bf16x8 vf[4];
#pragma unroll
        for (int ks = 0; ks < 4; ++ks) vf[ks] = *(const GAS bf16x8*)(vptr + 16 * ks);
#pragma unroll
        for (int i = 0; i < 16; ++i) sacc[k5][i] *= inv;
#pragma unroll
        for (int dt = 0; dt < 2; ++dt) { f32x16 vt = {}; vt = mfma32(vf[2 * dt], idf[0], vt); vt = mfma32(vf[2 * dt + 1], idf[1], vt);
#pragma unroll
            for (int s2 = 0; s2 < 2; ++s2) o[dt] = mfma32(pack8(sacc[k5], s2), pack8(vt, s2), o[dt]); } }
    bf16* OB = WSP(bf16, WS_OB) + (size_t)b * MH * RW; float* LSE = WSP(float, WS_LSE) + (size_t)b * MH * NH;
#pragma unroll
    for (int dt = 0; dt < 2; ++dt)
#pragma unroll
        for (int i = 0; i < 16; ++i) { const int orow = row0 + ((64 * n + 32 * qt + crow(i, hh)) << dsh); OB[(size_t)orow * RW + h * 64 + 32 * dt + c31] = (bf16)f2bf(o[dt][i]); }
    if (hh == 0) LSE[(size_t)qrow * NH + h] = (m + log2f(lsum)) * LN2;
}
__device__ __forceinline__ void phase_pool_attn(KARG, Frame& F, int hf, int l) {
    for (int t = F.vcu; t < MH / 32; t += F.G) pool_tile(KA, F, hf, l, t);
    __syncthreads();
    LAS float* bt = (LAS float*)(F.lds + RING_OFF);
    attn_bias_table(KA, F, bt);
    __syncthreads();
    const int gw = F.vcu * NWAVES + F.wave, NGW = F.G * NWAVES;
    for (int u = gw; u < 9216; u += NGW) attn_unit(F, hf, u, bt);
}
__device__ __forceinline__ void phase_attn_merge(Frame& F) {
    const bf16* OB = WSP(bf16, WS_OB); const float* LSE = WSP(float, WS_LSE); bf16* MIX = WSP(bf16, WS_MIX);
    const int gt = F.vcu * 512 + F.tid, NT = F.G * 512;
    for (int it = gt; it < MH * 48; it += NT) { const int row = it / 48, cg = it % 48, h = cg >> 3;
        float ls[3], mx = -3.0e38f;
#pragma unroll
        for (int b = 0; b < 3; ++b) { ls[b] = LSE[((size_t)b * MH + row) * NH + h]; mx = fmaxf(mx, ls[b]); }
        float al[3], sum = 0.f;
#pragma unroll
        for (int b = 0; b < 3; ++b) { al[b] = __expf(ls[b] - mx); sum += al[b]; }
        const float inv = 1.0f / sum; float acc[8];
#pragma unroll
        for (int e = 0; e < 8; ++e) acc[e] = 0.f;
#pragma unroll
        for (int b = 0; b < 3; ++b) { const v4u w = *(const GAS v4u*)(OB + ((size_t)b * MH + row) * RW + cg * 8); const float a = al[b] * inv;
            acc[0] += a * bflo(w.x); acc[1] += a * bfhi(w.x); acc[2] += a * bflo(w.y); acc[3] += a * bfhi(w.y); acc[4] += a * bflo(w.z); acc[5] += a * bfhi(w.z); acc[6] += a * bflo(w.w); acc[7] += a * bfhi(w.w); }
        v4u o; o.x = pk2(acc[0], acc[1]); o.y = pk2(acc[2], acc[3]); o.z = pk2(acc[4], acc[5]); o.w = pk2(acc[6], acc[7]);
        *(GAS v4u*)(MIX + (size_t)row * D + 640 + cg * 8) = o; }
}
constexpr int LB = 72;
constexpr int LS = 40;
constexpr int LF = 65;
constexpr int MATB = 64 * LB * 2;
template <int KS, bool SWA = false, bool SWB = false> __device__ __forceinline__ f32x4 mm16(const LAS bf16* A, int lda, const LAS bf16* BT, int ldb, int mi, int nj, int lane, f32x4 acc) {
    const int ra = 16 * mi + (lane & 15), rb = 16 * nj + (lane & 15), ch = lane >> 4;
    const LAS bf16* ap = A + ra * lda; const LAS bf16* bp = BT + rb * ldb;
#pragma unroll
    for (int ks = 0; ks < KS; ++ks) { const int ca = SWA ? ((ch + 4 * ks) ^ ((ra >> 3) & 7)) : (ch + 4 * ks), cb = SWB ? ((ch + 4 * ks) ^ ((rb >> 3) & 7)) : (ch + 4 * ks);
        acc = mfma16(*(const LAS bf16x8*)(ap + 8 * ca), *(const LAS bf16x8*)(bp + 8 * cb), acc); }
    return acc;
}
template <int N, int S, int J> __device__ __forceinline__ void rl_fma(float& acc, const float (&Tr)[32], const float (&vL)[32]) {
    if constexpr (N == 4) { unsigned t0, t1, t2, t3;
        asm volatile("v_readlane_b32 %1, %5, %13\n\tv_readlane_b32 %2, %6, %13\n\tv_readlane_b32 %3, %7, %13\n\tv_readlane_b32 %4, %8, %13\n\tv_fmac_f32 %0, %1, %9\n\tv_fmac_f32 %0, %2, %10\n\tv_fmac_f32 %0, %3, %11\n\tv_fmac_f32 %0, %4, %12"
                     : "+v"(acc), "=&s"(t0), "=&s"(t1), "=&s"(t2), "=&s"(t3) : "v"(vL[S]), "v"(vL[S + 1]), "v"(vL[S + 2]), "v"(vL[S + 3]), "v"(Tr[S]), "v"(Tr[S + 1]), "v"(Tr[S + 2]), "v"(Tr[S + 3]), "n"(J)); }
    else if constexpr (N == 3) { unsigned t0, t1, t2;
        asm volatile("v_readlane_b32 %1, %4, %10\n\tv_readlane_b32 %2, %5, %10\n\tv_readlane_b32 %3, %6, %10\n\tv_fmac_f32 %0, %1, %7\n\tv_fmac_f32 %0, %2, %8\n\tv_fmac_f32 %0, %3, %9"
                     : "+v"(acc), "=&s"(t0), "=&s"(t1), "=&s"(t2) : "v"(vL[S]), "v"(vL[S + 1]), "v"(vL[S + 2]), "v"(Tr[S]), "v"(Tr[S + 1]), "v"(Tr[S + 2]), "n"(J)); }
    else if constexpr (N == 2) { unsigned t0, t1;
        asm volatile("v_readlane_b32 %1, %3, %7\n\tv_readlane_b32 %2, %4, %7\n\ts_nop 0\n\tv_fmac_f32 %0, %1, %5\n\tv_fmac_f32 %0, %2, %6"
                     : "+v"(acc), "=&s"(t0), "=&s"(t1) : "v"(vL[S]), "v"(vL[S + 1]), "v"(Tr[S]), "v"(Tr[S + 1]), "n"(J)); }
    else if constexpr (N == 1) { unsigned t0;
        asm volatile("v_readlane_b32 %1, %2, %4\n\ts_nop 1\n\tv_fmac_f32 %0, %1, %3" : "+v"(acc), "=&s"(t0) : "v"(vL[S]), "v"(Tr[S]), "n"(J)); }
}
template <int S, int J> __device__ __forceinline__ void rl_fma_all(float& acc, const float (&Tr)[32], const float (&vL)[32]) {
    constexpr int REM = 32 - S;
    if constexpr (REM >= 4) { rl_fma<4, S, J>(acc, Tr, vL); rl_fma_all<S + 4, J>(acc, Tr, vL); }
    else if constexpr (REM > 0) { rl_fma<REM, S, J>(acc, Tr, vL); }
}
template <int J> struct SolveStep {
    static __device__ __forceinline__ void run(float (&Tr)[32], const float (&vL)[32], int r_) {
        float acc = (J == r_) ? 1.f : 0.f;
        rl_fma_all<J + 1, J>(acc, Tr, vL);
        Tr[J] = (J <= r_) ? acc : 0.f;
        SolveStep<J - 1>::run(Tr, vL, r_);
    }
};
template <> struct SolveStep<-1> { static __device__ __forceinline__ void run(float (&)[32], const float (&)[32], int) {} };
__device__ __forceinline__ v2u pk4(const f32x4 v) { v2u o; o.x = cvtpk(v[0], v[1]); o.y = cvtpk(v[2], v[3]); return o; }
__device__ __forceinline__ void passA_unit(KARG, Frame& F, int hf, int l, int unit) {
    int tid = F.tid; asm volatile("" : "+v"(tid)); int t = tid >> 3, cg = tid & 7, c0 = cg * 8;
    const int ci = unit / 6, h = unit % 6; const int rr0 = ci * 64; const int T = hf ? 16384 : 8192; const int sbase = hf ? 0 : (rr0 & ~8191);
    int tl = rr0 - sbase + t;
    const bf16* PX = WSP(bf16, WS_PX);
    LAS unsigned char* L0 = F.lds + RING_OFF;
#define MAT(i) ((LAS bf16*)(L0 + (i) * MATB))
    LAS bf16* mAt = MAT(0); LAS bf16* mBt = MAT(1); LAS bf16* mKt = MAT(2); LAS bf16* mRt = MAT(3); LAS bf16* mAtT = MAT(4); LAS bf16* mBtT = MAT(5); LAS bf16* mKtT = MAT(6); LAS bf16* mVT = MAT(7);
    LAS bf16* mLak = MAT(8); LAS bf16* mLrb = MAT(9); LAS bf16* mLrk = MAT(10); LAS bf16* mT = MAT(11); LAS bf16* mX1T = MAT(12); LAS bf16* mWT = MAT(13); LAS bf16* mU0T = MAT(8);
    LAS float* fC = (LAS float*)(L0 + 8 * MATB);
    LAS bf16* sLogd = (LAS bf16*)(L0 + 8 * MATB + 16640);
    LAS bf16* sIcl = sLogd + 64 * LB;
    LAS bf16* mActW = MAT(12); LAS bf16* mActA = MAT(13);
    LAS float* sLs = (LAS float*)(L0 + 12 * MATB);
    LAS bf16* sL21 = (LAS bf16*)(L0 + 12 * MATB + 8448);
    LAS bf16* sT11T = sL21 + 32 * LS;
    LAS bf16* sQT = sT11T + 32 * LS;
    LAS float* sDC = (LAS float*)(L0 + 14 * MATB);
    float bonus = 0.f;
    for (int d = 0; d < 2; ++d) {
        asm volatile("" : "+v"(tid)); t = tid >> 3; cg = tid & 7; c0 = cg * 8; tl = rr0 - sbase + t;
        const int lane = tid & 63, wave = __builtin_amdgcn_readfirstlane(tid >> 6);
        const int tau = d ? 63 - t : t; const size_t inst = ((size_t)ci * 6 + h) * 2 + d;
    float cr[8], ck[8], cv[8];
    { const float* cw = KA.in[I_CONV] + (size_t)l * 3 * 1152;
#pragma unroll
      for (int e = 0; e < 8; ++e) { cr[e] = 0.f; ck[e] = 0.f; cv[e] = 0.f; }
#pragma unroll
      for (int tap = 0; tap < 3; ++tap) { const int tq = tl + tap - 1; if (tq >= 0 && tq < T) { const bf16* row = PX + (size_t)(sbase + tq) * PXW + h * 64 + c0;
          const v4u wr_ = *(const GAS v4u*)(row), wk_ = *(const GAS v4u*)(row + 384), wv_ = *(const GAS v4u*)(row + 768); const float* w = cw + tap * 1152 + h * 64 + c0;
          const unsigned ur[4] = {wr_.x, wr_.y, wr_.z, wr_.w}, uk[4] = {wk_.x, wk_.y, wk_.z, wk_.w}, uv[4] = {wv_.x, wv_.y, wv_.z, wv_.w};
#pragma unroll
          for (int e = 0; e < 8; ++e) { const float xr = (e & 1) ? bfhi(ur[e >> 1]) : bflo(ur[e >> 1]), xk = (e & 1) ? bfhi(uk[e >> 1]) : bflo(uk[e >> 1]), xv = (e & 1) ? bfhi(uv[e >> 1]) : bflo(uv[e >> 1]);
              cr[e] += xr * w[e]; ck[e] += xk * w[384 + e]; cv[e] += xv * w[768 + e]; } } } }
    float kkv[8];
    { float ss = 0.f; const float* kkw = KA.in[I_KK] + l * RW + h * 64 + c0;
#pragma unroll
      for (int e = 0; e < 8; ++e) { kkv[e] = ck[e] * kkw[e]; ss += kkv[e] * kkv[e]; }
      ss += shx(ss, 1, lane); ss += shx(ss, 2, lane); ss += shx(ss, 4, lane);
      const float inv = 1.0f / fmaxf(sqrtf(ss), 1e-12f);
#pragma unroll
      for (int e = 0; e < 8; ++e) kkv[e] *= inv; }
        __syncthreads();
        { const bf16* row = PX + (size_t)(rr0 + t) * PXW + 1152 + c0; const v4u ww = *(const GAS v4u*)(row), wa = *(const GAS v4u*)(row + 64);
          v4u o; o.x = pk2(tanhf_(bflo(ww.x)), tanhf_(bfhi(ww.x))); o.y = pk2(tanhf_(bflo(ww.y)), tanhf_(bfhi(ww.y))); o.z = pk2(tanhf_(bflo(ww.z)), tanhf_(bfhi(ww.z))); o.w = pk2(tanhf_(bflo(ww.w)), tanhf_(bfhi(ww.w)));
          *(LAS v4u*)(mActW + tau * LB + c0) = o; *(LAS v4u*)(mActA + tau * LB + c0) = wa; }
        __syncthreads();
        { const int prod = wave >> 2, nj = wave & 3, cl = lane & 15, ql = lane >> 4; const int c = 16 * nj + cl;
          const bf16* UT = WSP(bf16, WS_SMALL) + 98304 * (1 + prod) + (size_t)(l * 2 + d) * RW * 64 + (size_t)(h * 64 + c) * 64 + 8 * ql;
          const bf16x8 b0 = *(const GAS bf16x8*)(UT), b1 = *(const GAS bf16x8*)(UT + 32);
          const float bias = KA.in[prod ? I_IA0 : I_DW0][(size_t)(l * 2 + d) * RW + h * 64 + c];
          f32x4 v[4];
#pragma unroll
          for (int mi = 0; mi < 4; ++mi) { const LAS bf16* ap = (prod ? mActA : mActW) + (16 * mi + cl) * LB + 8 * ql; f32x4 a = {bias, bias, bias, bias};
              a = mfma16(*(const LAS bf16x8*)(ap), b0, a); a = mfma16(*(const LAS bf16x8*)(ap + 32), b1, a); v[mi] = a; }
          if (prod) {
#pragma unroll
              for (int mi = 0; mi < 4; ++mi)
#pragma unroll
                  for (int e = 0; e < 4; ++e) sIcl[(16 * mi + 4 * ql + e) * LB + c] = (bf16)f2bf(sigmoidf_(v[mi][e]));
          } else { float base = 0.f;
#pragma unroll
              for (int mi = 0; mi < 4; ++mi) { float ld_[4], p[4];
#pragma unroll
                  for (int e = 0; e < 4; ++e) { ld_[e] = -0.6065306597126334f * sigmoidf_(v[mi][e]); p[e] = ld_[e] + (e ? p[e - 1] : 0.f); }
                  const float g0 = shx(p[3], 0, cl), g1 = shx(p[3], 0, cl + 16), g2 = shx(p[3], 0, cl + 32), g3 = shx(p[3], 0, cl + 48);
                  const float off = base + (ql > 0 ? g0 : 0.f) + (ql > 1 ? g1 : 0.f) + (ql > 2 ? g2 : 0.f); base += (g0 + g1) + (g2 + g3);
#pragma unroll
                  for (int e = 0; e < 4; ++e) { fC[(16 * mi + 4 * ql + e) * LF + c] = off + p[e]; sLogd[(16 * mi + 4 * ql + e) * LB + c] = (bf16)f2bf(ld_[e]); } } } }
        __syncthreads();
        float logd[8], ic[8];
        { const v4u wl_ = *(const LAS v4u*)(sLogd + tau * LB + c0), wi_ = *(const LAS v4u*)(sIcl + tau * LB + c0);
          logd[0] = bflo(wl_.x); logd[1] = bfhi(wl_.x); logd[2] = bflo(wl_.y); logd[3] = bfhi(wl_.y); logd[4] = bflo(wl_.z); logd[5] = bfhi(wl_.z); logd[6] = bflo(wl_.w); logd[7] = bfhi(wl_.w);
          ic[0] = bflo(wi_.x); ic[1] = bfhi(wi_.x); ic[2] = bflo(wi_.y); ic[3] = bfhi(wi_.y); ic[4] = bflo(wi_.z); ic[5] = bfhi(wi_.z); ic[6] = bflo(wi_.w); ic[7] = bfhi(wi_.w); }
        { const float* ka = KA.in[I_KA] + l * RW + h * 64 + c0; const float* brk = KA.in[I_BRK] + l * RW + h * 64 + c0;
          float at[8], bt_[8], kt[8], rt[8]; float bs = 0.f;
#pragma unroll
          for (int e = 0; e < 8; ++e) { const float cum = fC[tau * LF + c0 + e], cumx = cum - logd[e]; const float keff = ck[e] * (1.0f + (ic[e] - 1.0f) * ka[e]);
              bs += cr[e] * keff * brk[e];
              const float en = __expf(-cum);
              at[e] = -kkv[e] * __expf(cumx); bt_[e] = kkv[e] * ic[e] * en; kt[e] = keff * en; rt[e] = cr[e] * __expf(cum); }
          bs += shx(bs, 1, lane); bs += shx(bs, 2, lane); bs += shx(bs, 4, lane); bonus += bs;
          v4u o;
          o.x = pk2(at[0], at[1]); o.y = pk2(at[2], at[3]); o.z = pk2(at[4], at[5]); o.w = pk2(at[6], at[7]); *(LAS v4u*)(mAt + tau * LB + c0) = o;
          o.x = pk2(bt_[0], bt_[1]); o.y = pk2(bt_[2], bt_[3]); o.z = pk2(bt_[4], bt_[5]); o.w = pk2(bt_[6], bt_[7]); *(LAS v4u*)(mBt + tau * LB + c0) = o;
          o.x = pk2(kt[0], kt[1]); o.y = pk2(kt[2], kt[3]); o.z = pk2(kt[4], kt[5]); o.w = pk2(kt[6], kt[7]); *(LAS v4u*)(mKt + tau * LB + c0) = o;
          o.x = pk2(rt[0], rt[1]); o.y = pk2(rt[2], rt[3]); o.z = pk2(rt[4], rt[5]); o.w = pk2(rt[6], rt[7]); *(LAS v4u*)(mRt + tau * LB + c0) = o;
          { const int tsw = tau ^ (cg << 3);
#pragma unroll
          for (int e = 0; e < 8; ++e) { mAtT[(c0 + e) * LB + tsw] = (bf16)f2bf(at[e]); mBtT[(c0 + e) * LB + tsw] = (bf16)f2bf(bt_[e]); mKtT[(c0 + e) * LB + tsw] = (bf16)f2bf(kt[e]); mVT[(c0 + e) * LB + tsw] = (bf16)f2bf(cv[e]); } }
          if (t == 0) {
#pragma unroll
              for (int e = 0; e < 8; ++e) { const float dc = __expf(fC[63 * LF + c0 + e]); const int k_ = c0 + e; sDC[k_] = dc; WSP(float, WS_DC)[inst * 64 + 16 * ((k_ >> 2) & 3) + 4 * (k_ >> 4) + (k_ & 3)] = dc; } } }
        __syncthreads();
        int lnv = lane, cc, qq;
#define FRESH_LANE() do { asm volatile("" : "+v"(lnv)); cc = lnv & 15; qq = lnv >> 4; } while (0)
        FRESH_LANE();
        for (int tt = wave; tt < 64; tt += 8) { const int prod = tt >> 4, mi = (tt >> 2) & 3, nj = tt & 3; const f32x4 z = {0.f, 0.f, 0.f, 0.f};
            if (prod == 0) { const f32x4 a = mm16<2>(mAt, LB, mBt, LB, mi, nj, lnv, z);
                const int sg = 16 * nj + cc; const int blk = mi >> 1;
                if ((mi >> 1) == (nj >> 1)) {
#pragma unroll
                    for (int e = 0; e < 4; ++e) { const int ta = 16 * mi + 4 * qq + e; sLs[blk * 32 * 33 + (ta & 31) * 33 + (sg & 31)] = (sg < ta) ? a[e] : 0.f; } }
                else if (mi >= 2) {
#pragma unroll
                    for (int e = 0; e < 4; ++e) { const int ta = 16 * mi + 4 * qq + e; sL21[(ta - 32) * LS + sg] = (bf16)f2bf(a[e]); } } }
            else { const LAS bf16* Am = (prod == 2) ? mBt : mKt; const LAS bf16* Bm = (prod == 1) ? mAt : mRt; LAS bf16* Om = (prod == 1) ? mLak : (prod == 2 ? mLrb : mLrk);
                f32x4 a = mm16<2>(Am, LB, Bm, LB, mi, nj, lnv, z);
                const int ta = 16 * nj + cc;
#pragma unroll
                for (int e = 0; e < 4; ++e) { const int sg = 16 * mi + 4 * qq + e; const bool keep = (prod == 1) ? (sg < ta) : (sg <= ta); a[e] = keep ? a[e] : 0.f; }
                *(LAS v2u*)(Om + ta * LB + 16 * mi + 4 * qq) = pk4(a); } }
        __syncthreads();
        FRESH_LANE();
        if (wave < 2) { const int blk = wave, r_ = lnv & 31; const LAS float* Lb = sLs + blk * 32 * 33; float Tr[32], vL[32];
#pragma unroll
            for (int s = 0; s < 32; ++s) vL[s] = Lb[s * 33 + r_];
            SolveStep<31>::run(Tr, vL, r_);
            if (lnv < 32) {
            LAS bf16* trow = mT + (32 * blk + r_) * LB + 32 * blk; LAS bf16* zrow = mT + r_ * LB + 32;
#pragma unroll
            for (int g = 0; g < 4; ++g) { v4u o; o.x = pk2(Tr[8 * g], Tr[8 * g + 1]); o.y = pk2(Tr[8 * g + 2], Tr[8 * g + 3]); o.z = pk2(Tr[8 * g + 4], Tr[8 * g + 5]); o.w = pk2(Tr[8 * g + 6], Tr[8 * g + 7]);
                *(LAS v4u*)(trow + 8 * g) = o; if (blk == 0) *(LAS v4u*)(zrow + 8 * g) = (v4u){0u, 0u, 0u, 0u}; }
            if (blk == 0) {
#pragma unroll
                for (int j = 0; j < 32; ++j) sT11T[j * LS + r_] = (bf16)f2bf(Tr[j]); } } }
        __syncthreads();
        FRESH_LANE();
        if (wave < 4) { const int mi = wave >> 1, nj = wave & 1; const f32x4 a = mm16<1>(sL21, LS, sT11T, LS, mi, nj, lnv, (f32x4){0.f, 0.f, 0.f, 0.f});
            *(LAS v2u*)(sQT + (16 * nj + cc) * LS + 16 * mi + 4 * qq) = pk4(a); }
        __syncthreads();
        FRESH_LANE();
        if (wave < 4) { const int mi = wave >> 1, nj = wave & 1; const f32x4 a = mm16<1>(mT + 32 * LB + 32, LB, sQT, LS, mi, nj, lnv, (f32x4){0.f, 0.f, 0.f, 0.f});
#pragma unroll
            for (int e = 0; e < 4; ++e) mT[(32 + 16 * mi + 4 * qq + e) * LB + 16 * nj + cc] = (bf16)f2bf(a[e]); }
        __syncthreads();
        FRESH_LANE();
        for (int tt = wave; tt < 32; tt += 8) { const int prod = tt >> 4, mi = (tt >> 2) & 3, nj = tt & 3; const f32x4 z = {0.f, 0.f, 0.f, 0.f};
            const f32x4 a = prod ? mm16<2, false, true>(mT, LB, mAtT, LB, mi, nj, lnv, z) : mm16<2, false, true>(mLak, LB, mVT, LB, mi, nj, lnv, z);
            *(LAS v2u*)((prod ? mWT : mX1T) + (16 * nj + cc) * LB + 16 * mi + 4 * qq) = pk4(a); }
        __syncthreads();
        FRESH_LANE();
        for (int tt = wave; tt < 16; tt += 8) { const int mi = tt >> 2, nj = tt & 3; const f32x4 a = mm16<2>(mT, LB, mX1T, LB, mi, nj, lnv, (f32x4){0.f, 0.f, 0.f, 0.f});
            *(LAS v2u*)(mU0T + (16 * nj + cc) * LB + 16 * mi + 4 * qq) = pk4(a); }
        __syncthreads();
        FRESH_LANE();
        for (int tt = wave; tt < 64; tt += 8) { const int prod = tt >> 4, mi = (tt >> 2) & 3, nj = tt & 3; const int r4 = 16 * mi + 4 * qq, cn = 16 * nj + cc;
            if (prod == 0) {
                const v2u rv = *(const LAS v2u*)(mRt + cn * LB + r4); f32x4 a = {bflo(rv.x), bfhi(rv.x), bflo(rv.y), bfhi(rv.y)};
                a = mm16<2>(mWT, LB, mLrb, LB, mi, nj, lnv, a); const int treal = d ? 63 - cn : cn;
                *(GAS v2u*)(WSP(bf16, WS_RY) + inst * 4096 + treal * 64 + r4) = pk4(a); }
            else if (prod == 1) {
                f32x4 a = mm16<2>(mU0T, LB, mLrb, LB, mi, nj, lnv, (f32x4){0.f, 0.f, 0.f, 0.f}); a = mm16<2, true, false>(mVT, LB, mLrk, LB, mi, nj, lnv, a); const int treal = d ? 63 - cn : cn;
                *(GAS v2u*)(WSP(bf16, WS_Y0) + inst * 4096 + treal * 64 + r4) = pk4(a); }
            else if (prod == 2) {
                f32x4 a = mm16<2, false, true>(mWT, LB, mBtT, LB, mi, nj, lnv, (f32x4){0.f, 0.f, 0.f, 0.f}); const float dc = sDC[cn];
#pragma unroll
                for (int e = 0; e < 4; ++e) a[e] *= dc;
                *(GAS v2u*)(WSP(bf16, WS_GP) + inst * 4096 + cn * 64 + (r4 & 32) + 8 * qq + 4 * (mi & 1)) = pk4(a); }
            else {
                f32x4 a = mm16<2, true, false>(mBtT, LB, mU0T, LB, mi, nj, lnv, (f32x4){0.f, 0.f, 0.f, 0.f}); a = mm16<2, true, true>(mKtT, LB, mVT, LB, mi, nj, lnv, a);
#pragma unroll
                for (int e = 0; e < 4; ++e) a[e] *= sDC[r4 + e];
                *(GAS v2u*)(WSP(bf16, WS_H0T) + inst * 4096 + cn * 64 + 16 * qq + 4 * mi) = pk4(a); } }
    }
#undef MAT
#undef FRESH_LANE
    if (cg == 0) WSP(float, WS_BON)[(size_t)unit * 64 + t] = bonus;
}
__device__ __forceinline__ void phase_passA(KARG, Frame& F, int hf, int l) {
    for (int u = F.vcu; u < (MH / 64) * 6; u += F.G) passA_unit(KA, F, hf, l, u);
}
__device__ __forceinline__ void phase_passB(Frame& F, int hf) {
    const int nchain = hf ? 12 : 24, nck = hf ? 256 : 128;
    const int unit = F.vcu * NWAVES + F.wave;
    const int uu = (F.wave) * F.G + F.vcu;
    if (uu >= nchain * 4) return; (void)unit;
    const int chain = uu >> 2, cgp = uu & 3; const int d = chain & 1, h = (chain >> 1) % 6, s = (chain >> 1) / 6;
    const int lane = F.lane, c16 = lane & 15, q = lane >> 4, v = 16 * cgp + c16;
    f32x4 hacc[4];
#pragma unroll
    for (int m = 0; m < 4; ++m) hacc[m] = (f32x4){0.f, 0.f, 0.f, 0.f};
    const bf16* GP = WSP(bf16, WS_GP); const bf16* H0T = WSP(bf16, WS_H0T); const float* DC = WSP(float, WS_DC); bf16* HC = WSP(bf16, WS_HC);
    struct PBSet { v4u ga[4][2]; v4u h0[2]; f32x4 dc[4]; };
#define PB_LOAD(S_, STEP) do { const int st_ = (STEP) < nck ? (STEP) : nck - 1; const int cl_ = d ? nck - 1 - st_ : st_; const size_t in_ = ((size_t)(s * nck + cl_) * 6 + h) * 2 + d; \
        _Pragma("unroll") for (int mo = 0; mo < 4; ++mo) { const bf16* gr = GP + in_ * 4096 + (16 * mo + c16) * 64 + 8 * q; \
            S_.ga[mo][0] = *(const GAS v4u*)(gr); S_.ga[mo][1] = *(const GAS v4u*)(gr + 32); S_.dc[mo] = *(const GAS f32x4*)(DC + in_ * 64 + 16 * q + 4 * mo); } \
        S_.h0[0] = *(const GAS v4u*)(H0T + in_ * 4096 + v * 64 + 16 * q); S_.h0[1] = *(const GAS v4u*)(H0T + in_ * 4096 + v * 64 + 16 * q + 8); } while (0)
#define PB_STEP(S_, STEP) do { const int cl_ = d ? nck - 1 - (STEP) : (STEP); const size_t inst = ((size_t)(s * nck + cl_) * 6 + h) * 2 + d; \
        v2u hb[4]; \
        _Pragma("unroll") for (int m = 0; m < 4; ++m) { hb[m].x = cvtpk(hacc[m][0], hacc[m][1]); hb[m].y = cvtpk(hacc[m][2], hacc[m][3]); *(GAS v2u*)(HC + inst * 4096 + v * 64 + 16 * m + 4 * q) = hb[m]; } \
        bf16x8 bfr[2]; \
        _Pragma("unroll") for (int ks = 0; ks < 2; ++ks) { v4u t4; t4.x = hb[2 * ks].x; t4.y = hb[2 * ks].y; t4.z = hb[2 * ks + 1].x; t4.w = hb[2 * ks + 1].y; bfr[ks] = __builtin_bit_cast(bf16x8, t4); } \
        const unsigned hw[8] = {S_.h0[0].x, S_.h0[0].y, S_.h0[0].z, S_.h0[0].w, S_.h0[1].x, S_.h0[1].y, S_.h0[1].z, S_.h0[1].w}; \
        _Pragma("unroll") for (int mo = 0; mo < 4; ++mo) { f32x4 cin; \
            cin[0] = S_.dc[mo][0] * hacc[mo][0] + bflo(hw[2 * mo]); cin[1] = S_.dc[mo][1] * hacc[mo][1] + bfhi(hw[2 * mo]); cin[2] = S_.dc[mo][2] * hacc[mo][2] + bflo(hw[2 * mo + 1]); cin[3] = S_.dc[mo][3] * hacc[mo][3] + bfhi(hw[2 * mo + 1]); \
            cin = mfma16(__builtin_bit_cast(bf16x8, S_.ga[mo][0]), bfr[0], cin); cin = mfma16(__builtin_bit_cast(bf16x8, S_.ga[mo][1]), bfr[1], cin); hacc[mo] = cin; } } while (0)
    PBSet s0, s1, s2;
    PB_LOAD(s0, 0); PB_LOAD(s1, 1); PB_LOAD(s2, 2);
    for (int step = 0; step < nck; step += 3) {
        PB_STEP(s0, step); PB_LOAD(s0, step + 3);
        if (step + 1 < nck) { PB_STEP(s1, step + 1); PB_LOAD(s1, step + 4); }
        if (step + 2 < nck) { PB_STEP(s2, step + 2); PB_LOAD(s2, step + 5); }
    }
#undef PB_STEP
#undef PB_LOAD
}
__device__ __forceinline__ void passC_unit(KARG, Frame& F, int hf, int l, int unit) {
    const int lane = F.lane, c31 = lane & 31, hh = lane >> 5; const int ci = unit / 6, h = unit % 6; const int rr0 = ci * 64;
    const int T = hf ? 16384 : 8192; const int sbase = hf ? 0 : (rr0 & ~8191);
    const bf16* PX = WSP(bf16, WS_PX); const bf16* RY = WSP(bf16, WS_RY); const bf16* Y0 = WSP(bf16, WS_Y0); const bf16* HC = WSP(bf16, WS_HC);
    f32x16 acc[2][2];
#pragma unroll
    for (int mt = 0; mt < 2; ++mt)
#pragma unroll
        for (int nt = 0; nt < 2; ++nt) { f32x16 a;
#pragma unroll
            for (int g = 0; g < 4; ++g) { float s4[4] = {0.f, 0.f, 0.f, 0.f};
#pragma unroll
                for (int d = 0; d < 2; ++d) { const size_t inst = ((size_t)ci * 6 + h) * 2 + d; const v2u w = *(const GAS v2u*)(Y0 + inst * 4096 + (32 * nt + c31) * 64 + 32 * mt + 8 * g + 4 * hh);
                    s4[0] += bflo(w.x); s4[1] += bfhi(w.x); s4[2] += bflo(w.y); s4[3] += bfhi(w.y); }
                a[4 * g] = s4[0]; a[4 * g + 1] = s4[1]; a[4 * g + 2] = s4[2]; a[4 * g + 3] = s4[3]; }
            acc[mt][nt] = a; }
#pragma unroll
    for (int d = 0; d < 2; ++d) { const size_t inst = ((size_t)ci * 6 + h) * 2 + d;
#pragma unroll
        for (int ks = 0; ks < 4; ++ks) { bf16x8 af[2], bf_[2];
#pragma unroll
            for (int x = 0; x < 2; ++x) { af[x] = *(const GAS bf16x8*)(HC + inst * 4096 + (32 * x + c31) * 64 + 16 * ks + 8 * hh); bf_[x] = *(const GAS bf16x8*)(RY + inst * 4096 + (32 * x + c31) * 64 + 16 * ks + 8 * hh); }
#pragma unroll
            for (int mt = 0; mt < 2; ++mt)
#pragma unroll
                for (int nt = 0; nt < 2; ++nt) acc[mt][nt] = mfma32(af[mt], bf_[nt], acc[mt][nt]); } }
    f32x16 gacc[2][2] = {};
    { const bf16* GUT = WSP(bf16, WS_SMALL) + (size_t)l * RW * 128;
#pragma unroll
      for (int ks = 0; ks < 8; ++ks) { bf16x8 af[2], bf_[2];
#pragma unroll
          for (int x = 0; x < 2; ++x) { af[x] = *(const GAS bf16x8*)(GUT + (size_t)(h * 64 + 32 * x + c31) * 128 + 16 * ks + 8 * hh);
              const v4u w = *(const GAS v4u*)(PX + (size_t)(rr0 + 32 * x + c31) * PXW + 1280 + 16 * ks + 8 * hh); v4u o;
              o.x = cvtpk(sigmoidf_(bflo(w.x)), sigmoidf_(bfhi(w.x))); o.y = cvtpk(sigmoidf_(bflo(w.y)), sigmoidf_(bfhi(w.y))); o.z = cvtpk(sigmoidf_(bflo(w.z)), sigmoidf_(bfhi(w.z))); o.w = cvtpk(sigmoidf_(bflo(w.w)), sigmoidf_(bfhi(w.w)));
              bf_[x] = __builtin_bit_cast(bf16x8, o); }
#pragma unroll
          for (int mt = 0; mt < 2; ++mt)
#pragma unroll
              for (int nt = 0; nt < 2; ++nt) gacc[mt][nt] = mfma32(af[mt], bf_[nt], gacc[mt][nt]); } }
    const float* gng = KA.in[I_GNG] + l * RW + h * 64; const float* gnb = KA.in[I_GNB] + l * RW + h * 64; const float* cw = KA.in[I_CONV] + (size_t)l * 3 * 1152 + 768 + h * 64;
    bf16* MIX = WSP(bf16, WS_MIX);
#pragma unroll
    for (int nt = 0; nt < 2; ++nt) { const int t = 32 * nt + c31; const int tl = rr0 - sbase + t;
        float s1 = 0.f;
#pragma unroll
        for (int mt = 0; mt < 2; ++mt)
#pragma unroll
            for (int i = 0; i < 16; ++i) s1 += acc[mt][nt][i];
        s1 += shx(s1, 32, lane); const float mu = s1 * (1.0f / 64.0f); float s2 = 0.f;
#pragma unroll
        for (int mt = 0; mt < 2; ++mt)
#pragma unroll
            for (int i = 0; i < 16; ++i) { const float dlt = acc[mt][nt][i] - mu; s2 += dlt * dlt; }
        s2 += shx(s2, 32, lane); const float rstd = 1.0f / sqrtf(s2 * (1.0f / 64.0f) + GN_EPS);
        const float bon = WSP(float, WS_BON)[(size_t)unit * 64 + t];
#pragma unroll
        for (int mt = 0; mt < 2; ++mt)
#pragma unroll
            for (int g = 0; g < 4; ++g) { const int j0 = 32 * mt + 8 * g + 4 * hh; float vv[4] = {0.f, 0.f, 0.f, 0.f};
#pragma unroll
                for (int tap = 0; tap < 3; ++tap) { const int tq = tl + tap - 1; if (tq >= 0 && tq < T) { const v2u w = *(const GAS v2u*)(PX + (size_t)(sbase + tq) * PXW + 768 + h * 64 + j0); const f32x4 cwv = *(const GAS f32x4*)(cw + tap * 1152 + j0);
                    vv[0] += bflo(w.x) * cwv[0]; vv[1] += bfhi(w.x) * cwv[1]; vv[2] += bflo(w.y) * cwv[2]; vv[3] += bfhi(w.y) * cwv[3]; } }
                const f32x4 gg = *(const GAS f32x4*)(gng + j0), gb = *(const GAS f32x4*)(gnb + j0); float o4[4];
#pragma unroll
                for (int e = 0; e < 4; ++e) { const float y = (acc[mt][nt][4 * g + e] - mu) * rstd * gg[e] + gb[e] + bon * vv[e]; o4[e] = y * gacc[mt][nt][4 * g + e]; }
                v2u o; o.x = pk2(o4[0], o4[1]); o.y = pk2(o4[2], o4[3]); *(GAS v2u*)(MIX + (size_t)(rr0 + t) * D + 256 + h * 64 + j0) = o; } }
}
__device__ __forceinline__ void phase_passC(KARG, Frame& F, int hf, int l) {
    const int gw = F.vcu * NWAVES + F.wave, NGW = F.G * NWAVES;
    for (int u = gw; u < (MH / 64) * 6; u += NGW) passC_unit(KA, F, hf, l, u);
}
constexpr int NPHASE = 47;
__global__ void __launch_bounds__(NWAVES * 64, 2) mega_fwd(Args args) {
    const Args& KA = args;
    extern __shared__ __attribute__((aligned(16))) unsigned char lds[];
    Frame F;
    F.lds = (LAS unsigned char*)lds; F.MISC = (volatile LAS unsigned*)(F.lds + MISC_OFF);
    F.tid = threadIdx.x; F.lane = F.tid & 63; F.wave = __builtin_amdgcn_readfirstlane(F.tid >> 6);
    F.G = gridDim.x; { const int bx = blockIdx.x; F.vcu = (F.G % 8 == 0) ? (bx % 8) * (F.G / 8) + bx / 8 : bx; }
    F.ws = args.ws; F.ctl = (gu32*)(args.ws + WS_CTL); F.out = args.out;
    for (int u = F.tid; u < (LDS_BYTES - LDSCTL_OFF) / 4; u += NWAVES * 64) ((LAS unsigned*)(F.lds + LDSCTL_OFF))[u] = 0u;
    __syncthreads();
    XcdBarrier bar; bar.bar = (unsigned*)(F.ctl + CW_BAR) + args.li * XCD_BAR_WORDS; bar.x = 0; bar.st = nullptr;
    const bool multi = (args.ph_hi - args.ph_lo) > 1;
    if (multi) bar = xcd_barrier_post((unsigned*)(F.ctl + CW_BAR) + args.li * XCD_BAR_WORDS, F.MISC + 8);
    for (int p = args.ph_lo; p < args.ph_hi; ++p) {
        { int tv = threadIdx.x; asm volatile("" : "+v"(tv)); F.tid = tv; F.lane = tv & 63; F.wave = __builtin_amdgcn_readfirstlane(tv >> 6); }
        if (p == 0) { if ((PHM >> 11) & 1) phase_weights(args, F); }
        else {
            const int qq = p - 1, hf = qq / 23, r = qq % 23;
            if (r == 0) { if ((PHM >> 12) & 1) phase_xn_init(args, F, hf); }
            else {
                const int l = (r - 1) / 11, k = (r - 1) % 11;
                unsigned char* wl = F.ws + WS_W + (size_t)l * W_LAYER;
                const int nrep = (k == REPK) ? 2 : 1;
                for (int rep = 0; rep < nrep; ++rep) {
                if (rep) xcd_barrier(bar);
                { int tv = threadIdx.x; asm volatile("" : "+v"(tv)); F.tid = tv; F.lane = tv & 63; F.wave = __builtin_amdgcn_readfirstlane(tv >> 6); }
                if (k == 0 || k == 6 || k == 8 || k == 9) {
                    const bf16* Aop; const bf16* Bop; int Nn, Kk; pg8::EpiGen E;
                    if (k == 0) { Aop = WSP(bf16, WS_XN); Bop = (const bf16*)(wl + W_IN); Nn = NIN; Kk = D; E = pg8::EpiGen{WSP(bf16, WS_PY), WSP(bf16, WS_PX), 1408, PXW, PXW, 0}; }
                    else if (k == 6) { Aop = WSP(bf16, WS_MIX); Bop = (const bf16*)(wl + W_OUT); Nn = D; Kk = D; E = pg8::EpiGen{WSP(bf16, WS_F1), WSP(bf16, WS_F1), 1 << 30, D, D, 0}; }
                    else if (k == 8) { Aop = WSP(bf16, WS_XN); Bop = (const bf16*)(wl + W_FFI); Nn = FF; Kk = D; E = pg8::EpiGen{WSP(bf16, WS_H), WSP(bf16, WS_H), 1 << 30, FF, FF, 2}; }
                    else { Aop = WSP(bf16, WS_H); Bop = (const bf16*)(wl + W_FFO); Nn = D; Kk = FF; E = pg8::EpiGen{WSP(bf16, WS_XN), WSP(bf16, WS_XN), 1 << 30, D, D, 0}; }
                    pg8::Gemm g{Aop, Bop, MH, Nn, Kk}; pg8::StaticOrder S; S.init(MH, Nn, F.G, (int)blockIdx.x);
                    pg8::gemm_phase<pg8::EpiGen, pg8::StaticOrder, true, true>(F.lds + RING_OFF, g, S, E, F.tid);
                } else
                switch (k) {
                case 1: if ((PHM >> 1) & 1) phase_pool_attn(args, F, hf, l); break;
                case 2: if ((PHM >> 2) & 1) phase_attn_merge(F); break;
                case 3: if ((PHM >> 3) & 1) phase_passA(args, F, hf, l); break;
                case 4: if ((PHM >> 4) & 1) phase_passB(F, hf); break;
                case 5: if ((PHM >> 5) & 1) phase_passC(args, F, hf, l); break;
                case 7: if ((PHM >> 7) & 1) { const float* base = (l == 0) ? KA.in[hf ? I_XS : I_XP] : (F.out + (size_t)hf * MH * D);
                          phase_rowpass(args, F, hf, WSP(bf16, WS_F1), base, KA.in[I_NMPOST] + l * D, KA.in[I_NFPRE] + l * D); } break;
                default: if ((PHM >> 10) & 1) { phase_rowpass(args, F, hf, WSP(bf16, WS_XN), F.out + (size_t)hf * MH * D, KA.in[I_NFPOST] + l * D, (l == 0) ? (KA.in[I_NMPRE] + D) : nullptr); } break;
                }
                }
            }
        }
        if (p + 1 < args.ph_hi) xcd_barrier(bar);
    }
}

extern "C" void kernel_launch(void* const* d_in, const int* in_sizes, int n_in, void* d_out, int out_size, void* d_ws, size_t ws_size, hipStream_t stream) {
    static int grid = 0;
    if (grid == 0) {
        if (n_in != 24 || out_size != 2 * MH * D || ws_size < WS_END) { fprintf(stderr, "kernel_launch: unexpected problem shape (n_in %d out %d ws %zu)\n", n_in, out_size, ws_size); grid = -1; return; }
        int dev = 0, cus = 0;
        if (hipGetDevice(&dev) != hipSuccess || hipDeviceGetAttribute(&cus, hipDeviceAttributeMultiprocessorCount, dev) != hipSuccess) { grid = -1; return; }
        if (hipFuncSetAttribute((const void*)mega_fwd, hipFuncAttributeMaxDynamicSharedMemorySize, LDS_BYTES) != hipSuccess) { fprintf(stderr, "kernel_launch: hipFuncSetAttribute failed\n"); grid = -1; return; }
        int per_cu = 0; (void)hipOccupancyMaxActiveBlocksPerMultiprocessor(&per_cu, (const void*)mega_fwd, NWAVES * 64, LDS_BYTES); (void)hipGetLastError();
        grid = cus;
    }
    if (grid < 0) return;
    (void)hipMemsetAsync((char*)d_ws + WS_CTL, 0, CTL_ZERO_BYTES, stream);
    Args a{};
    for (int i = 0; i < 24; ++i) a.in[i] = (const float*)d_in[i];
    a.out = (float*)d_out; a.ws = (unsigned char*)d_ws;
#if MK_N_LAUNCHES == 1
    a.ph_lo = 0; a.ph_hi = NPHASE; a.li = 0;
    hipLaunchKernelGGL(mega_fwd, dim3(grid), dim3(NWAVES * 64), LDS_BYTES, stream, a);
#else
    for (int p = 0; p < NPHASE; ++p) { a.ph_lo = p; a.ph_hi = p + 1; a.li = 0; hipLaunchKernelGGL(mega_fwd, dim3(grid), dim3(NWAVES * 64), LDS_BYTES, stream, a); }
#endif
}
```

```cpp
#include <hip/hip_runtime.h>
#include <cstdio>
#include <cstdint>
#ifndef PROBE_PA
#define PROBE_PA 0
#endif
#define PA_REPEAT(k) for (int rp_ = 0; rp_ < ((PROBE_PA == (k)) ? 5 : 1); ++rp_)
#ifndef REPK
#define REPK -1
#endif
#ifndef PHM
#define PHM 0xFFFF
#endif
#ifndef MK_N_LAUNCHES
#define MK_N_LAUNCHES 1
#endif
namespace pg8 {
#define PG8_LAS __attribute__((address_space(3)))
typedef unsigned short bf16_t;
typedef short bf16x8 __attribute__((ext_vector_type(8)));
typedef float f32x4 __attribute__((ext_vector_type(4)));
typedef unsigned u32x4 __attribute__((ext_vector_type(4)));
constexpr int BM = 256, BK = 64, HALF = 128, HTB = HALF * BK * 2  , STAGE_BYTES = 8 * HTB, NXCD = 8, WGM = 8;

__host__ __device__ __forceinline__ int lds_byte(int r, int c) { const int st = (r >> 4) * 2 + (c >> 5), rr = r & 15, cc = c & 31, ob = rr * 64 + cc * 2; return st * 1024 + (ob ^ (((ob >> 9) & 1) << 5)); }
__host__ __device__ __forceinline__ void stage_rc(int b, int& R, int& C) { const int st = b / 1024, sb = b % 1024, swz = sb ^ (((sb >> 9) & 1) << 5); R = (st >> 1) * 16 + swz / 64; C = (st & 1) * 32 + (swz % 64) / 2; }
__host__ __device__ __forceinline__ int perm32(int rho) { const int n = rho >> 4, i = rho & 15; return 8 * (i >> 2) + 4 * n + (i & 3); }

struct Unit { int pm, pn; };
struct Gemm { const bf16_t* A; const bf16_t* Bt; int M, N, K; };

struct StaticOrder {
    int nM, nN, nwg, G, c;
    __host__ __device__ void init(int M, int N, int G_, int c_) { nM = M / BM; nN = N / BM; nwg = nM * nN; G = G_; c = c_; }
    __host__ __device__ bool next(int i, Unit& u) const {
        const long L = (long)i * G + c; if (L >= nwg) return false;
        int wgid = (int)L; { const int q = nwg / NXCD, r = nwg % NXCD, xcd = wgid % NXCD, off = wgid / NXCD; wgid = (xcd < r ? xcd * (q + 1) : r * (q + 1) + (xcd - r) * q) + off; }
        const int nig = WGM * nN, gid = wgid / nig, fm = gid * WGM, gsz = (nM - fm) < WGM ? (nM - fm) : WGM;
        u.pm = fm + ((wgid % nig) % gsz); u.pn = (wgid % nig) / gsz; return true;
    }
    __device__ __forceinline__ void a_ready(const Unit&) const {}
    __device__ __forceinline__ void done(const Unit&) const {}
};

__device__ __forceinline__ unsigned cvt_pk_bf16(float lo, float hi) { unsigned r; asm volatile("v_cvt_pk_bf16_f32 %0, %1, %2" : "=v"(r) : "v"(lo), "v"(hi)); return r; }
template <int ACT> struct EpiBf16 {
    static constexpr bool PERM = true, AFTER_DRAIN = false;
    bf16_t* O; int ldc;
    __device__ __forceinline__ void operator()(const f32x4 (&acc)[2][2][4][2], const Unit& u, int wr, int wc, int fr, int fq) const {
        const int row0 = u.pm * BM + wr * 64 + fr; const int col0 = u.pn * BM + wc * 32 + 8 * fq;
#pragma unroll
        for (int ai = 0; ai < 2; ++ai)
#pragma unroll
            for (int m = 0; m < 4; ++m) { bf16_t* rowp = O + (size_t)(row0 + ai * HALF + m * 16) * ldc + col0;
#pragma unroll
                for (int bj = 0; bj < 2; ++bj) { f32x4 v0 = acc[ai][bj][m][0], v1 = acc[ai][bj][m][1];
                    if (ACT == 2) {
#pragma unroll
                        for (int e = 0; e < 4; ++e) { float a = fmaxf(v0[e], 0.f), b = fmaxf(v1[e], 0.f); v0[e] = a * a; v1[e] = b * b; } }
                    u32x4 w; w.x = cvt_pk_bf16(v0[0], v0[1]); w.y = cvt_pk_bf16(v0[2], v0[3]); w.z = cvt_pk_bf16(v1[0], v1[1]); w.w = cvt_pk_bf16(v1[2], v1[3]);
                    *(u32x4*)(rowp + bj * HALF) = w; } }
    }
};
struct EpiGen {
    static constexpr bool PERM = true, AFTER_DRAIN = false;
    bf16_t* O0; bf16_t* O1; int split, ld0, ld1, act;
    __device__ __forceinline__ void operator()(const f32x4 (&acc)[2][2][4][2], const Unit& u, int wr, int wc, int fr, int fq) const {
        const int row0 = u.pm * BM + wr * 64 + fr;
#pragma unroll
        for (int bj = 0; bj < 2; ++bj) {
            const int g0 = u.pn * BM + bj * HALF; const bool lo = g0 < split; bf16_t* base = lo ? (O0 + g0) : (O1 + (g0 - split)); const int ld = lo ? ld0 : ld1;
            base += wc * 32 + 8 * fq;
#pragma unroll
            for (int ai = 0; ai < 2; ++ai)
#pragma unroll
                for (int m = 0; m < 4; ++m) { f32x4 v0 = acc[ai][bj][m][0], v1 = acc[ai][bj][m][1];
                    if (act) {
#pragma unroll
                        for (int e = 0; e < 4; ++e) { const float a = fmaxf(v0[e], 0.f), b = fmaxf(v1[e], 0.f); v0[e] = a * a; v1[e] = b * b; } }
                    u32x4 w; w.x = cvt_pk_bf16(v0[0], v0[1]); w.y = cvt_pk_bf16(v0[2], v0[3]); w.z = cvt_pk_bf16(v1[0], v1[1]); w.w = cvt_pk_bf16(v1[2], v1[3]);
                    *(u32x4*)(base + (size_t)(row0 + ai * HALF + m * 16) * ld) = w; } }
    }
};
struct EpiRoute {
    static constexpr bool PERM = true, AFTER_DRAIN = false;
    bf16_t* PY; bf16_t* PX;
    __device__ __forceinline__ void operator()(const f32x4 (&acc)[2][2][4][2], const Unit& u, int wr, int wc, int fr, int fq) const {
        const int row0 = u.pm * BM + wr * 64 + fr;
#pragma unroll
        for (int bj = 0; bj < 2; ++bj) {
            const int g0 = u.pn * BM + bj * HALF; bf16_t* base = (g0 < 1408) ? (PY + g0) : (PX + (g0 - 1408));
            base += wc * 32 + 8 * fq;
#pragma unroll
            for (int ai = 0; ai < 2; ++ai)
#pragma unroll
                for (int m = 0; m < 4; ++m) { const f32x4 v0 = acc[ai][bj][m][0], v1 = acc[ai][bj][m][1];
                    u32x4 w; w.x = cvt_pk_bf16(v0[0], v0[1]); w.y = cvt_pk_bf16(v0[2], v0[3]); w.z = cvt_pk_bf16(v1[0], v1[1]); w.w = cvt_pk_bf16(v1[2], v1[3]);
                    *(u32x4*)(base + (size_t)(row0 + ai * HALF + m * 16) * 1408) = w; } }
    }
};
template <class Epi, class Sched, bool ALIGN_EPI = false, bool SP2 = false>
__device__ __forceinline__ void gemm_phase(PG8_LAS unsigned char* lds, const Gemm g, const Sched& S, const Epi& E, const int tid) {
    const int wid = __builtin_amdgcn_readfirstlane(tid >> 6), lane = tid & 63, wr = wid >> 2, wc = wid & 3, fr = lane & 15, fq = lane >> 4;
    const int K = g.K, nt = K / BK;
    unsigned voffA[2], voffB[2];
#pragma unroll
    for (int i = 0; i < 2; ++i) { int R, C; stage_rc(tid * 16 + i * 8192, R, C); const int Rb = Epi::PERM ? ((R & ~31) + perm32(R & 31)) : R;
        voffA[i] = (unsigned)(R * K + C) * 2u; voffB[i] = (unsigned)(Rb * K + C) * 2u; }
    const size_t kstep = (size_t)(BK * 2);
    const size_t hstep = (size_t)HALF * K * 2;
    const size_t tstep = 2 * hstep;
    const unsigned ldsw = (unsigned)wid * 1024u;
    const int aoff = lds_byte(wr * 64 + fr, fq * 8), boff = lds_byte(wc * 32 + fr, fq * 8);
#define PG8_SA(b, h) (((b) * 2 + (h)) * HTB)
#define PG8_SB(b, h) ((4 + (b) * 2 + (h)) * HTB)
#define PG8_STAGE(bufoff, gbase, voff) do { _Pragma("unroll") for (int _i = 0; _i < 2; ++_i) \
        __builtin_amdgcn_global_load_lds((const unsigned*)((const char*)(gbase) + (voff)[_i]), (PG8_LAS unsigned*)(lds + (bufoff) + ldsw + _i * 8192), 16, 0, 0); } while (0)
#define PG8_LDA(dst, b, h) do { _Pragma("unroll") for (int m = 0; m < 4; ++m) _Pragma("unroll") for (int k = 0; k < 2; ++k) dst[m][k] = *(const PG8_LAS bf16x8*)(lds + PG8_SA(b, h) + aoff + m * 2048 + k * 1024); } while (0)
#define PG8_LDB(dst, b, h) do { _Pragma("unroll") for (int n = 0; n < 2; ++n) _Pragma("unroll") for (int k = 0; k < 2; ++k) dst[n][k] = *(const PG8_LAS bf16x8*)(lds + PG8_SB(b, h) + boff + n * 2048 + k * 1024); } while (0)
#define PG8_MMA(ai, bj, At, Bt) do { __builtin_amdgcn_s_setprio(1); _Pragma("unroll") for (int m = 0; m < 4; ++m) _Pragma("unroll") for (int n = 0; n < 2; ++n) _Pragma("unroll") for (int k = 0; k < 2; ++k) \
        acc[ai][bj][m][n] = __builtin_amdgcn_mfma_f32_16x16x32_bf16(Bt[n][k], At[m][k], acc[ai][bj][m][n], 0, 0, 0); __builtin_amdgcn_s_setprio(0); } while (0)
#define PG8_WAIT_V(n) asm volatile("s_waitcnt vmcnt(" #n ")" ::: "memory")
#define PG8_WAIT_L(n) asm volatile("s_waitcnt lgkmcnt(" #n ")" ::: "memory")
#define PG8_BAR __builtin_amdgcn_s_barrier()
#define PG8_SCHED __builtin_amdgcn_sched_barrier(0)
    Unit cur, nxt; int ui = 0;
    if (!S.next(0, cur)) return;
    f32x4 acc[2][2][4][2];
#pragma unroll
    for (int a = 0; a < 2; ++a)
#pragma unroll
        for (int b = 0; b < 2; ++b)
#pragma unroll
            for (int m = 0; m < 4; ++m)
#pragma unroll
                for (int n = 0; n < 2; ++n) acc[a][b][m][n] = (f32x4){0.f, 0.f, 0.f, 0.f};
    bf16x8 At[4][2], B0[2][2], B1[2][2];
    const char* cA = (const char*)g.A + (size_t)cur.pm * tstep; const char* cB = (const char*)g.Bt + (size_t)cur.pn * tstep;
    S.a_ready(cur);
    if constexpr (SP2) {
        PG8_STAGE(PG8_SB(0, 0), cB, voffB); PG8_STAGE(PG8_SB(0, 1), cB + hstep, voffB); PG8_STAGE(PG8_SA(0, 0), cA, voffA); PG8_STAGE(PG8_SA(0, 1), cA + hstep, voffA);
        if (wr == 1) PG8_BAR;
        PG8_WAIT_V(2); PG8_BAR;
        PG8_STAGE(PG8_SB(1, 0), cB + kstep, voffB); PG8_STAGE(PG8_SA(1, 0), cA + kstep, voffA); PG8_STAGE(PG8_SB(1, 1), cB + hstep + kstep, voffB);
        PG8_WAIT_V(6); PG8_BAR;
    } else {
        PG8_STAGE(PG8_SB(0, 0), cB, voffB); PG8_STAGE(PG8_SA(0, 0), cA, voffA); PG8_STAGE(PG8_SB(0, 1), cB + hstep, voffB); PG8_STAGE(PG8_SA(0, 1), cA + hstep, voffA);
        if (wr == 1) PG8_BAR;
        PG8_WAIT_V(4); PG8_BAR;
        PG8_STAGE(PG8_SB(1, 0), cB + kstep, voffB); PG8_STAGE(PG8_SA(1, 0), cA + kstep, voffA); PG8_STAGE(PG8_SB(1, 1), cB + hstep + kstep, voffB);
        PG8_WAIT_V(6); PG8_BAR;
    }
    for (;;) {
        const bool has_next = S.next(ui + 1, nxt);
        const char* nA = has_next ? (const char*)g.A + (size_t)nxt.pm * tstep : cA; const char* nB = has_next ? (const char*)g.Bt + (size_t)nxt.pn * tstep : cB;
        for (int t = 0; t < nt; t += 2) {
            const bool last = (t == nt - 2);
            const char* a1 = cA + (size_t)(t + 1) * kstep;
            const char* a2 = last ? nA : cA + (size_t)(t + 2) * kstep; const char* b2 = last ? nB : cB + (size_t)(t + 2) * kstep;
            const char* a3 = a2 + kstep; const char* b3 = b2 + kstep;
            if (last && has_next) S.a_ready(nxt);
            if constexpr (SP2) {
            PG8_LDB(B0, 0, 0); PG8_LDB(B1, 0, 1); PG8_SCHED; PG8_LDA(At, 0, 0); PG8_STAGE(PG8_SA(1, 1), a1 + hstep, voffA);
            PG8_WAIT_V(8); PG8_WAIT_L(0); PG8_BAR; PG8_MMA(0, 0, At, B0); PG8_MMA(0, 1, At, B1); PG8_BAR; PG8_SCHED;
            PG8_LDA(At, 0, 1); PG8_STAGE(PG8_SB(0, 0), b2, voffB); PG8_STAGE(PG8_SB(0, 1), b2 + hstep, voffB); PG8_STAGE(PG8_SA(0, 0), a2, voffA);
            PG8_WAIT_V(8); PG8_WAIT_L(0); PG8_BAR; PG8_MMA(1, 0, At, B0); PG8_MMA(1, 1, At, B1); PG8_BAR; PG8_SCHED;
            PG8_LDB(B0, 1, 0); PG8_LDB(B1, 1, 1); PG8_SCHED; PG8_LDA(At, 1, 0); PG8_STAGE(PG8_SA(0, 1), a2 + hstep, voffA);
            PG8_WAIT_V(8); PG8_WAIT_L(0); PG8_BAR; PG8_MMA(0, 0, At, B0); PG8_MMA(0, 1, At, B1); PG8_BAR; PG8_SCHED;
            PG8_LDA(At, 1, 1); PG8_STAGE(PG8_SB(1, 0), b3, voffB); PG8_STAGE(PG8_SB(1, 1), b3 + hstep, voffB); PG8_STAGE(PG8_SA(1, 0), a3, voffA);
            PG8_WAIT_V(8); PG8_WAIT_L(0); PG8_BAR; PG8_MMA(1, 0, At, B0); PG8_MMA(1, 1, At, B1); PG8_BAR; PG8_SCHED;
            } else {
            PG8_LDB(B0, 0, 0); PG8_SCHED; PG8_LDA(At, 0, 0); PG8_STAGE(PG8_SA(1, 1), a1 + hstep, voffA);
            PG8_WAIT_L(8); PG8_BAR; PG8_WAIT_L(0); PG8_MMA(0, 0, At, B0); PG8_BAR; PG8_SCHED;
            PG8_LDB(B1, 0, 1); PG8_STAGE(PG8_SB(0, 0), b2, voffB);
            PG8_BAR; PG8_WAIT_L(0); PG8_MMA(0, 1, At, B1); PG8_BAR;
            PG8_LDA(At, 0, 1); PG8_STAGE(PG8_SA(0, 0), a2, voffA);
            PG8_BAR; PG8_WAIT_L(0); PG8_MMA(1, 0, At, B0); PG8_BAR; PG8_SCHED;
            PG8_STAGE(PG8_SB(0, 1), b2 + hstep, voffB);
            PG8_WAIT_V(6); PG8_BAR; PG8_MMA(1, 1, At, B1); PG8_BAR;
            PG8_LDB(B0, 1, 0); PG8_SCHED; PG8_LDA(At, 1, 0); PG8_STAGE(PG8_SA(0, 1), a2 + hstep, voffA);
            PG8_WAIT_L(8); PG8_BAR; PG8_WAIT_L(0); PG8_MMA(0, 0, At, B0); PG8_BAR; PG8_SCHED;
            PG8_LDB(B1, 1, 1); PG8_STAGE(PG8_SB(1, 0), b3, voffB);
            PG8_BAR; PG8_WAIT_L(0); PG8_MMA(0, 1, At, B1); PG8_BAR;
            PG8_LDA(At, 1, 1); PG8_STAGE(PG8_SA(1, 0), a3, voffA);
            PG8_BAR; PG8_WAIT_L(0); PG8_MMA(1, 0, At, B0); PG8_BAR; PG8_SCHED;
            PG8_STAGE(PG8_SB(1, 1), b3 + hstep, voffB);
            PG8_WAIT_V(6); PG8_BAR; PG8_MMA(1, 1, At, B1); PG8_BAR;
            }
        }
        if constexpr (ALIGN_EPI) { if (wr == 0) PG8_BAR; }
        if constexpr (!Epi::AFTER_DRAIN) { E(acc, cur, wr, wc, fr, fq); S.done(cur); }
        if (!has_next) break;
#pragma unroll
        for (int a = 0; a < 2; ++a)
#pragma unroll
            for (int b = 0; b < 2; ++b)
#pragma unroll
                for (int m = 0; m < 4; ++m)
#pragma unroll
                    for (int n = 0; n < 2; ++n) acc[a][b][m][n] = (f32x4){0.f, 0.f, 0.f, 0.f};
        cur = nxt; cA = nA; cB = nB; ++ui;
        if constexpr (ALIGN_EPI) { if (wr == 1) PG8_BAR; }
    }
    PG8_WAIT_V(0);
    if constexpr (!ALIGN_EPI) { if (wr == 0) PG8_BAR; }
    PG8_BAR;
    if constexpr (Epi::AFTER_DRAIN) { E.fused(acc, cur, wr, wc, fr, fq, lds, wid, lane); S.done(cur); }
#undef PG8_SA
#undef PG8_SB
#undef PG8_STAGE
#undef PG8_LDA
#undef PG8_LDB
#undef PG8_MMA
#undef PG8_WAIT_V
#undef PG8_WAIT_L
#undef PG8_BAR
#undef PG8_SCHED
}
}
#define GAS __attribute__((address_space(1)))
#define LAS __attribute__((address_space(3)))
typedef unsigned short bf16;
typedef unsigned v4u __attribute__((ext_vector_type(4)));
typedef float f32x4 __attribute__((ext_vector_type(4)));
typedef short bf16x8 __attribute__((ext_vector_type(8)));
typedef GAS unsigned gu32;
typedef GAS unsigned long long gu64;
#define RLX_AGENT __ATOMIC_RELAXED, __HIP_MEMORY_SCOPE_AGENT
#define LDS_WAIT() asm volatile("s_waitcnt lgkmcnt(0)" ::: "memory")
#define VM_WAIT() asm volatile("s_waitcnt vmcnt(0)" ::: "memory")
__device__ __forceinline__ unsigned long long rt() { return __builtin_amdgcn_s_memrealtime(); }
__device__ __forceinline__ unsigned f2bf(float f) { unsigned u = __builtin_bit_cast(unsigned, f); return (u + 0x7fffu + ((u >> 16) & 1u)) >> 16; }
__device__ __forceinline__ unsigned pk2(float lo, float hi) { return f2bf(lo) | (f2bf(hi) << 16); }

#define XB_TMO      128
#define XB_XCNT(j)  (256  + 64 * (j))
#define XB_XSUB(j)  (1280 + 64 * (j))
#define XB_XGEN(j)  (2304 + 64 * (j))
#define XB_TOP      3328
#define XB_TOPGEN   3392
#define XCD_BAR_WORDS 3456
#define XB_SPIN_CAP (1u << 18)

__device__ __forceinline__ unsigned xb_ld(unsigned* p)              { return __hip_atomic_load(p, __ATOMIC_RELAXED, __HIP_MEMORY_SCOPE_AGENT); }
__device__ __forceinline__ unsigned xb_add(unsigned* p, unsigned v) { return __hip_atomic_fetch_add(p, v, __ATOMIC_RELAXED, __HIP_MEMORY_SCOPE_AGENT); }
__device__ __forceinline__ unsigned xb_xcc_id() { return (unsigned)__builtin_amdgcn_s_getreg((3 << 11) | 20) & 0xFu; }
#define XB_SPIN(cond, bar) do { unsigned _sp = 0; while (cond) { __builtin_amdgcn_s_sleep(1); \
    if ((++_sp & 255u) == 0u) { if (xb_ld(&(bar)[XB_TMO])) break; if (_sp > XB_SPIN_CAP) { atomicAdd(&(bar)[XB_TMO], 1u); break; } } } } while (0)

struct XcdBarrier {
    unsigned* bar; unsigned x;
    volatile LAS unsigned* st;
};

__device__ __forceinline__ XcdBarrier xcd_barrier_post(unsigned* bar, volatile LAS unsigned* st) {
    XcdBarrier b; b.bar = bar; b.x = xb_xcc_id(); b.st = st;
    if (threadIdx.x == 0) (void)xb_add(&bar[XB_XCNT(b.x)], 1u);
    return b;
}
__device__ __forceinline__ void xcd_barrier_complete(unsigned* bar, unsigned x, unsigned& nloc, unsigned& nx) {
    const unsigned G = gridDim.x * gridDim.y * gridDim.z;
    unsigned sum, cnt, mine, sp = 0u;
    for (;;) {
        sum = 0u; cnt = 0u; mine = 0u;
#pragma unroll
        for (unsigned j = 0; j < 16; ++j) { const unsigned c = xb_ld(&bar[XB_XCNT(j)]); sum += c; cnt += (c > 0u) ? 1u : 0u; mine = (j == x) ? c : mine; }
        if (sum == G) break;
        __builtin_amdgcn_s_sleep(1);
        if ((++sp & 255u) == 0u) { if (xb_ld(&bar[XB_TMO])) break; if (sp > XB_SPIN_CAP) { atomicAdd(&bar[XB_TMO], 1u); break; } }
    }
    nloc = mine > 0u ? mine : 1u; nx = cnt > 0u ? cnt : 1u;
}

__device__ __forceinline__ void xcd_barrier(const XcdBarrier& b) {
    asm volatile("s_waitcnt vmcnt(0)" ::: "memory");
    __syncthreads();
    if (threadIdx.x == 0) {
        unsigned* bar = b.bar;
        __builtin_amdgcn_s_waitcnt(0);
        unsigned nloc = b.st[0], nx = b.st[1];
        if (nloc == 0u) { xcd_barrier_complete(bar, b.x, nloc, nx); b.st[0] = nloc; b.st[1] = nx; }
        const unsigned old = xb_add(&bar[XB_XSUB(b.x)], 1u);
        const unsigned gen = old / nloc;
        if (old + 1u == (gen + 1u) * nloc) {
            __builtin_amdgcn_fence(__ATOMIC_RELEASE, "agent");
            asm volatile("s_waitcnt vmcnt(0)" ::: "memory");
            const unsigned og = xb_add(&bar[XB_TOP], 1u);
            const unsigned tg = og / nx;
            if (og + 1u == (tg + 1u) * nx) xb_add(&bar[XB_TOPGEN], 1u);
            else XB_SPIN(xb_ld(&bar[XB_TOPGEN]) == tg, bar);
            __builtin_amdgcn_fence(__ATOMIC_ACQUIRE, "agent");
            xb_add(&bar[XB_XGEN(b.x)], 1u);
            asm volatile("s_waitcnt vmcnt(0)" ::: "memory");
        } else {
            XB_SPIN(xb_ld(&bar[XB_XGEN(b.x)]) == gen, bar);
            __builtin_amdgcn_fence(__ATOMIC_ACQUIRE, "agent");
            asm volatile("s_waitcnt vmcnt(0)" ::: "memory");
        }
    }
    __syncthreads();
}
constexpr int NWAVES = 8;
constexpr int D = 1024, MH = 16384, NIN = 2816, FF = 4096, RW = 384, NH = 6, PXW = 1408;
constexpr float NORM_EPS = 1e-6f, GN_EPS = 64e-5f, LOG2E = 1.4426950408889634f, LN2 = 0.6931471805599453f;
enum { I_XP = 0, I_XS, I_NMPRE, I_NMPOST, I_NFPRE, I_NFPOST, I_WIN, I_WOUT, I_POOLW, I_POOLS, I_CONV, I_DW0, I_DUP, I_IA0, I_IUP, I_GUP, I_KK, I_KA, I_BRK, I_GNG, I_GNB, I_RELB, I_WFI, I_WFO };
constexpr size_t MiB = 1u << 20;
constexpr size_t WS_CTL = 0, CTL_ZERO_BYTES = 1 * MiB;
constexpr size_t WS_SMALL = 1 * MiB;
constexpr size_t WS_W = 2 * MiB, W_LAYER = 47 * MiB / 2;
constexpr size_t W_IN = 0, W_OUT = 11 * MiB / 2, W_FFI = 15 * MiB / 2, W_FFO = 31 * MiB / 2;
constexpr size_t WS_XN = 51 * MiB, WS_MIX = 83 * MiB, WS_PX = 115 * MiB, WS_PY = 159 * MiB, WS_FREE = 203 * MiB, WS_END = 256 * MiB;
constexpr size_t WS_H = 115 * MiB;
constexpr size_t WS_F1 = 159 * MiB;
constexpr size_t WS_OB = 203 * MiB, WS_LSE = 239 * MiB;
constexpr size_t WS_GP = 159 * MiB, WS_H0T = 183 * MiB, WS_RY = 207 * MiB, WS_Y0 = 231 * MiB, WS_HC = 51 * MiB, WS_DC = 75 * MiB, WS_BON = 76 * MiB;
constexpr int CW_TMO = 0, CW_CODE = 1, CW_BAR = 4096;
constexpr int RING_OFF = 0, RING_BYTES = 131072, LDSCTL_OFF = RING_BYTES, MISC_OFF = LDSCTL_OFF + 320, LDS_BYTES = 147456;
typedef float f32x16 __attribute__((ext_vector_type(16)));
typedef unsigned v2u __attribute__((ext_vector_type(2)));
typedef float f32x2_t __attribute__((ext_vector_type(2))); typedef __bf16 bf16x2_t __attribute__((ext_vector_type(2)));
__device__ __forceinline__ unsigned cvtpk(float lo, float hi) { f32x2_t v = {lo, hi}; bf16x2_t b = __builtin_convertvector(v, bf16x2_t); return __builtin_bit_cast(unsigned, b); }
__device__ __forceinline__ float bf2f(unsigned u) { return __builtin_bit_cast(float, u << 16); }
__device__ __forceinline__ float bflo(unsigned w) { return __builtin_bit_cast(float, w << 16); }
__device__ __forceinline__ float bfhi(unsigned w) { return __builtin_bit_cast(float, w & 0xffff0000u); }
__device__ __forceinline__ f32x16 mfma32(bf16x8 a, bf16x8 b, f32x16 c) { return __builtin_amdgcn_mfma_f32_32x32x16_bf16(a, b, c, 0, 0, 0); }
__device__ __forceinline__ f32x4 mfma16(bf16x8 a, bf16x8 b, f32x4 c) { return __builtin_amdgcn_mfma_f32_16x16x32_bf16(a, b, c, 0, 0, 0); }
__device__ __forceinline__ int crow(int i, int hh) { return (i & 3) + 8 * (i >> 2) + 4 * hh; }
__device__ __forceinline__ bf16x8 pack8(const f32x16& x, int s) {
    v4u p; p.x = cvtpk(x[8 * s], x[8 * s + 1]); p.y = cvtpk(x[8 * s + 2], x[8 * s + 3]); p.z = cvtpk(x[8 * s + 4], x[8 * s + 5]); p.w = cvtpk(x[8 * s + 6], x[8 * s + 7]);
    return __builtin_bit_cast(bf16x8, p);
}
__device__ __forceinline__ float sigmoidf_(float x) { return __builtin_amdgcn_rcpf(1.0f + __builtin_amdgcn_exp2f(-1.4426950408889634f * x)); }
__device__ __forceinline__ float tanhf_(float x) { return 1.0f - 2.0f * __builtin_amdgcn_rcpf(1.0f + __builtin_amdgcn_exp2f(2.8853900817779268f * x)); }
__device__ __forceinline__ float shx(float v, int m, int lane) { return __builtin_bit_cast(float, __builtin_amdgcn_ds_bpermute((lane ^ m) << 2, __builtin_bit_cast(int, v))); }
__device__ __forceinline__ float wave_sum(float v, int lane) {
#pragma unroll
    for (int o = 1; o < 64; o <<= 1) v += shx(v, o, lane);
    return v;
}

struct Frame {
    LAS unsigned char* lds;
    volatile LAS unsigned* MISC;
    gu32* ctl;
    int tid, lane, wave, G, vcu;
    float* out; unsigned char* ws;
};
#define WSP(T, off) ((T*)(F.ws + (off)))
struct Args { const float* in[24]; float* out; unsigned char* ws; int ph_lo, ph_hi, li, pad; };
#define KARG const Args& KA
#define INP(i) (KA.in[i])

__device__ __forceinline__ void transpose_item(const float* W, int ldw, int K, bf16* WT, int n0, int srccol0, int k0, LAS float* scr, int lane) {
#pragma unroll 8
    for (int i = 0; i < 32; ++i) { const int kk = 2 * i + (lane >> 5); scr[kk * 33 + (lane & 31)] = W[(size_t)(k0 + kk) * ldw + srccol0 + (lane & 31)]; }
    LDS_WAIT(); asm volatile("" ::: "memory");
    const int c = lane & 7;
#pragma unroll
    for (int j = 0; j < 4; ++j) { const int n = (lane >> 3) + 8 * j; const LAS float* s = scr + (8 * c) * 33 + n;
        v4u o; o.x = pk2(s[0 * 33], s[1 * 33]); o.y = pk2(s[2 * 33], s[3 * 33]); o.z = pk2(s[4 * 33], s[5 * 33]); o.w = pk2(s[6 * 33], s[7 * 33]);
        *(GAS v4u*)(WT + (size_t)(n0 + n) * K + k0 + 8 * c) = o; }
    LDS_WAIT(); asm volatile("" ::: "memory");
}
__device__ __forceinline__ int win_src(int n) { return n < 256 ? n : (n < 1408 ? 1664 + (n - 256) : (n < 2560 ? 256 + (n - 1408) : 1408 + (n - 2560))); }
__device__ __forceinline__ void phase_weights(KARG, Frame& F) {
    LAS float* scr = (LAS float*)(F.lds + RING_OFF + F.wave * 16384);
    const int gw = F.vcu * NWAVES + F.wave, NGW = F.G * NWAVES;
    constexpr int I_IN = (D / 64) * (NIN / 32), I_OUT = (D / 64) * (D / 32), I_FI = (D / 64) * (FF / 32), I_FO = (FF / 64) * (D / 32), I_G = (128 / 64) * (RW / 32);
    constexpr int I_U = 4 * (RW / 32);
    constexpr int PER_L = I_IN + I_OUT + I_FI + I_FO + I_G + I_U;
    for (int it = gw; it < 2 * PER_L; it += NGW) {
        const int l = it / PER_L; int r = it % PER_L;
        unsigned char* wl = F.ws + WS_W + (size_t)l * W_LAYER;
        if (r < I_IN) { const int nb = r % (NIN / 32), kb = r / (NIN / 32); transpose_item(KA.in[I_WIN] + (size_t)l * D * NIN, NIN, D, (bf16*)(wl + W_IN), 32 * nb, win_src(32 * nb), 64 * kb, scr, F.lane); continue; } r -= I_IN;
        if (r < I_OUT) { const int nb = r % (D / 32), kb = r / (D / 32); transpose_item(KA.in[I_WOUT] + (size_t)l * D * D, D, D, (bf16*)(wl + W_OUT), 32 * nb, 32 * nb, 64 * kb, scr, F.lane); continue; } r -= I_OUT;
        if (r < I_FI) { const int nb = r % (FF / 32), kb = r / (FF / 32); transpose_item(KA.in[I_WFI] + (size_t)l * D * FF, FF, D, (bf16*)(wl + W_FFI), 32 * nb, 32 * nb, 64 * kb, scr, F.lane); continue; } r -= I_FI;
        if (r < I_FO) { const int nb = r % (D / 32), kb = r / (D / 32); transpose_item(KA.in[I_WFO] + (size_t)l * FF * D, D, FF, (bf16*)(wl + W_FFO), 32 * nb, 32 * nb, 64 * kb, scr, F.lane); continue; } r -= I_FO;
        if (r < I_G) { const int nb = r % (RW / 32), kb = r / (RW / 32); transpose_item(KA.in[I_GUP] + (size_t)l * 128 * RW, RW, 128, WSP(bf16, WS_SMALL) + (size_t)l * RW * 128, 32 * nb, 32 * nb, 64 * kb, scr, F.lane); continue; } r -= I_G;
        { const int nb = r % (RW / 32), which = r / (RW / 32), d = which & 1, isI = which >> 1;
          transpose_item(KA.in[isI ? I_IUP : I_DUP] + (size_t)(l * 2 + d) * 64 * RW, RW, 64, WSP(bf16, WS_SMALL) + 98304 * (1 + isI) + (size_t)(l * 2 + d) * RW * 64, 32 * nb, 32 * nb, 0, scr, F.lane); }
    }
}
__device__ __forceinline__ void phase_xn_init(KARG, Frame& F, int hf) {
    const int gw = F.vcu * NWAVES + F.wave, NGW = F.G * NWAVES;
    const float* X = KA.in[hf ? I_XS : I_XP]; const GAS f32x4* gp = (const GAS f32x4*)KA.in[I_NMPRE] + F.lane;
    f32x4 g[4];
#pragma unroll
    for (int j = 0; j < 4; ++j) g[j] = gp[64 * j];
    for (int m = gw; m < MH; m += NGW) {
        const GAS f32x4* xr = (const GAS f32x4*)(X + (size_t)m * D) + F.lane; f32x4 v[4]; float s = 0.f;
#pragma unroll
        for (int j = 0; j < 4; ++j) { v[j] = xr[64 * j]; s += (v[j].x * v[j].x + v[j].y * v[j].y) + (v[j].z * v[j].z + v[j].w * v[j].w); }
        const float rstd = 1.0f / sqrtf(wave_sum(s, F.lane) * (1.f / D) + NORM_EPS);
        GAS v2u* o8 = (GAS v2u*)(WSP(bf16, WS_XN) + (size_t)m * D) + F.lane;
#pragma unroll
        for (int j = 0; j < 4; ++j) { v2u w; w.x = pk2(v[j].x * rstd * g[j].x, v[j].y * rstd * g[j].y); w.y = pk2(v[j].z * rstd * g[j].z, v[j].w * rstd * g[j].w); o8[64 * j] = w; }
    }
}
__device__ __forceinline__ void phase_rowpass(KARG, Frame& F, int hf, const bf16* Fm, const float* base, const float* gpost, const float* gnext) {
    const int gw = F.vcu * NWAVES + F.wave, NGW = F.G * NWAVES;
    f32x4 gp[4], gn[4];
#pragma unroll
    for (int j = 0; j < 4; ++j) { gp[j] = ((const GAS f32x4*)gpost + F.lane)[64 * j]; gn[j] = gnext ? ((const GAS f32x4*)gnext + F.lane)[64 * j] : (f32x4){0.f, 0.f, 0.f, 0.f}; }
    float* out = F.out + (size_t)hf * MH * D;
    for (int m = gw; m < MH; m += NGW) {
        const GAS v2u* fr = (const GAS v2u*)(Fm + (size_t)m * D) + F.lane; const GAS f32x4* xr = (const GAS f32x4*)(base + (size_t)m * D) + F.lane;
        f32x4 f[4], x[4]; float s = 0.f;
#pragma unroll
        for (int j = 0; j < 4; ++j) { const v2u w = fr[64 * j]; x[j] = xr[64 * j]; f[j] = (f32x4){bflo(w.x), bfhi(w.x), bflo(w.y), bfhi(w.y)}; s += (f[j].x * f[j].x + f[j].y * f[j].y) + (f[j].z * f[j].z + f[j].w * f[j].w); }
        const float rstd = 1.0f / sqrtf(wave_sum(s, F.lane) * (1.f / D) + NORM_EPS); float s2 = 0.f;
        GAS f32x4* orow = (GAS f32x4*)(out + (size_t)m * D) + F.lane;
#pragma unroll
        for (int j = 0; j < 4; ++j) { x[j] = x[j] + f[j] * rstd * gp[j]; orow[64 * j] = x[j]; s2 += (x[j].x * x[j].x + x[j].y * x[j].y) + (x[j].z * x[j].z + x[j].w * x[j].w); }
        if (gnext) {
            const float r2 = 1.0f / sqrtf(wave_sum(s2, F.lane) * (1.f / D) + NORM_EPS);
            GAS v2u* o8 = (GAS v2u*)(WSP(bf16, WS_XN) + (size_t)m * D) + F.lane;
#pragma unroll
            for (int j = 0; j < 4; ++j) { v2u w; w.x = pk2(x[j].x * r2 * gn[j].x, x[j].y * r2 * gn[j].y); w.y = pk2(x[j].z * r2 * gn[j].z, x[j].w * r2 * gn[j].w); o8[64 * j] = w; }
        }
    }
}
__device__ __forceinline__ void pool_tile(KARG, Frame& F, int hf, int l, int tile) {
    LAS float* U = (LAS float*)(F.lds + RING_OFF);
    LAS float* Pd = U + 48 * 256;
    const bf16* PY = WSP(bf16, WS_PY); bf16* MIX = WSP(bf16, WS_MIX);
    const int T = hf ? 16384 : 8192; const int r0 = tile * 32; const int sbase = hf ? 0 : (r0 & ~8191); const int t0 = r0 - sbase;
    __syncthreads();
    for (int i = F.tid; i < 48 * 32; i += 512) { const int rr = i >> 5, c8 = (i & 31) * 8; const int t = t0 - 8 + rr;
        if (t >= 0 && t < T) { const v4u w = *(const GAS v4u*)(PY + (size_t)(sbase + t) * PXW + c8); LAS float* u = U + rr * 256 + c8;
            u[0] = bflo(w.x); u[1] = bfhi(w.x); u[2] = bflo(w.y); u[3] = bfhi(w.y); u[4] = bflo(w.z); u[5] = bfhi(w.z); u[6] = bflo(w.w); u[7] = bfhi(w.w); } }
    __syncthreads();
    { const int ch = F.tid & 255, g = ch >> 6, win = 2 << g, hw = win >> 1;
      for (int tt = F.tid >> 8; tt < 32; tt += 2) { const int t = t0 + tt; int lo = t - hw; if (lo < 0) lo = 0; int hi = t + win - hw; if (hi > T) hi = T;
          float s = 0.f; for (int q = lo; q < hi; ++q) s += U[(q - t0 + 8) * 256 + ch];
          Pd[tt * 256 + ch] = s / (float)(hi - lo) - U[(tt + 8) * 256 + ch]; } }
    __syncthreads();
    { const int d = F.tid & 63, g = (F.tid >> 6) & 3, tg = F.tid >> 8;
      const float* pw = KA.in[I_POOLW] + (size_t)l * 4 * 64 * 64 + g * 4096 + d; const float sc = KA.in[I_POOLS][l * 256 + g * 64 + d];
      float acc[16];
#pragma unroll
      for (int i = 0; i < 16; ++i) acc[i] = 0.f;
      for (int c = 0; c < 64; ++c) { const float w = pw[c * 64];
#pragma unroll
          for (int i = 0; i < 16; ++i) acc[i] += Pd[(tg * 16 + i) * 256 + g * 64 + c] * w; }
#pragma unroll
      for (int i = 0; i < 16; ++i) MIX[(size_t)(r0 + tg * 16 + i) * D + g * 64 + d] = (bf16)f2bf(acc[i] * sc); }
}
constexpr int BT_STRIDE = 192;
__device__ __forceinline__ void attn_bias_table(KARG, Frame& F, LAS float* bt) {
    const float* rb = KA.in[I_RELB];
    for (int i = F.tid; i < 18 * BT_STRIDE; i += 512) { const int bh = i / BT_STRIDE, o = i % BT_STRIDE, b = bh / 6, h = bh % 6; const int rel = o - 96; float val = 0.f;
        if (rel >= -64 && rel <= 64) { const int rp = rel * (1 << (2 * b)); int ret = rp > 0 ? 16 : 0; const int n = rp < 0 ? -rp : rp;
            if (n < 8) ret += n; else { const float nf = (float)n; int large = 8 + (int)(logf(nf / 8.0f) / logf(128.0f) * 8.0f); if (large > 15) large = 15; ret += large; }
            val = rb[ret * 6 + h] * LOG2E; }
        bt[i] = val; }
}
__device__ __forceinline__ void attn_unit(Frame& F, int hf, int uidx, const LAS float* btab) {
    const int lane = F.lane, c31 = lane & 31, hh = lane >> 5;
    const int T = hf ? 16384 : 8192, nblk = T >> 6, nseq = hf ? 1 : 2;
    const int qt = uidx & 1; int g = uidx >> 1; const int blk = g % nblk; g /= nblk; const int s = g % nseq; g /= nseq; const int h = g % 6, b = g / 6;
    const int dsh = 2 * b, L = T >> dsh, nbs = L >> 6, r = blk / nbs, n = blk % nbs, row0 = s * 8192 + r;
    const bf16* PY = WSP(bf16, WS_PY);
    bf16x8 idf[2];
#pragma unroll
    for (int p = 0; p < 2; ++p)
#pragma unroll
        for (int e = 0; e < 8; ++e) idf[p][e] = (c31 - 16 * p - 8 * hh == e) ? (short)0x3F80 : (short)0;
    const int qi = 32 * qt + c31; const int qrow = row0 + ((64 * n + qi) << dsh);
    bf16x8 qf[4];
#pragma unroll
    for (int ks = 0; ks < 4; ++ks) qf[ks] = *(const GAS bf16x8*)(PY + (size_t)qrow * PXW + 256 + h * 64 + 8 * hh + 16 * ks);
    f32x16 sacc[5];
#pragma unroll
    for (int k5 = 0; k5 < 5; ++k5) { int kp = 64 * (n - 1) + 32 * (qt + k5) + c31; kp = kp < 0 ? 0 : (kp > L - 1 ? L - 1 : kp);
        const bf16* kptr = PY + (size_t)(row0 + (kp << dsh)) * PXW + 640 + h * 64 + 8 * hh; f32x16 a = {};
#pragma unroll
        for (int ks = 0; ks < 4; ++ks) a = mfma32(*(const GAS bf16x8*)(kptr + 16 * ks), qf[ks], a);
        sacc[k5] = a; }
    const LAS float* bt = btab + (b * 6 + h) * BT_STRIDE + 32 - qi;
    const float SC = 0.125f * LOG2E; float m = -3.0e38f;
#pragma unroll
    for (int k5 = 0; k5 < 5; ++k5)
#pragma unroll
        for (int i = 0; i < 16; ++i) { const int j = 32 * (qt + k5) + crow(i, hh); const int rel = j - 64 - qi, kp = 64 * (n - 1) + j;
            const bool valid = (rel >= -64) && (rel <= 64) && (kp >= 0) && (kp < L);
            float t = sacc[k5][i] * SC + bt[j]; t = valid ? t : -1.0e30f; sacc[k5][i] = t; m = fmaxf(m, t); }
    m = fmaxf(m, shx(m, 32, lane)); float lsum = 0.f;
#pragma unroll
    for (int k5 = 0; k5 < 5; ++k5)
#pragma unroll
        for (int i = 0; i < 16; ++i) { const float p = __builtin_amdgcn_exp2f(sacc[k5][i] - m); sacc[k5][i] = p; lsum += p; }
    lsum += shx(lsum, 32, lane); const float inv = 1.0f / lsum;
    f32x16 o[2] = {};
#pragma unroll
    for (int k5 = 0; k5 < 5; ++k5) { int kp = 64 * (n - 1) + 32 * (qt + k5) + c31; kp = kp < 0 ? 0 : (kp > L - 1 ? L - 1 : kp);
        const bf16* vptr = PY + (size_t)(row0 + (kp << dsh)) * PXW + 1024 + h * 64 + 8 * hh; bf16x8 vf[4];
#pragma unroll
        for (int ks = 0; ks < 4; ++ks) vf[ks] = *(const GAS bf16x8*)(vptr + 16 * ks);
#pragma unroll
        for (int i = 0; i < 16; ++i) sacc[k5][i] *= inv;
#pragma unroll
        for (int dt = 0; dt < 2; ++dt) { f32x16 vt = {}; vt = mfma32(vf[2 * dt], idf[0], vt); vt = mfma32(vf[2 * dt + 1], idf[1], vt);
#pragma unroll
            for (int s2 = 0; s2 < 2; ++s2) o[dt] = mfma32(pack8(sacc[k5], s2), pack8(vt, s2), o[dt]); } }
    bf16* OB = WSP(bf16, WS_OB) + (size_t)b * MH * RW; float* LSE = WSP(float, WS_LSE) + (size_t)b * MH * NH;
#pragma unroll
    for (int dt = 0; dt < 2; ++dt)
#pragma unroll
        for (int i = 0; i < 16; ++i) { const int orow = row0 + ((64 * n + 32 * qt + crow(i, hh)) << dsh); OB[(size_t)orow * RW + h * 64 + 32 * dt + c31] = (bf16)f2bf(o[dt][i]); }
    if (hh == 0) LSE[(size_t)qrow * NH + h] = (m + log2f(lsum)) * LN2;
}
__device__ __forceinline__ void phase_pool_attn(KARG, Frame& F, int hf, int l) {
    for (int t = F.vcu; t < MH / 32; t += F.G) pool_tile(KA, F, hf, l, t);
    __syncthreads();
    LAS float* bt = (LAS float*)(F.lds + RING_OFF);
    attn_bias_table(KA, F, bt);
    __syncthreads();
    const int gw = F.vcu * NWAVES + F.wave, NGW = F.G * NWAVES;
    for (int u = gw; u < 9216; u += NGW) attn_unit(F, hf, u, bt);
}
__device__ __forceinline__ void phase_attn_merge(Frame& F) {
    const bf16* OB = WSP(bf16, WS_OB); const float* LSE = WSP(float, WS_LSE); bf16* MIX = WSP(bf16, WS_MIX);
    const int gt = F.vcu * 512 + F.tid, NT = F.G * 512;
    for (int it = gt; it < MH * 48; it += NT) { const int row = it / 48, cg = it % 48, h = cg >> 3;
        float ls[3], mx = -3.0e38f;
#pragma unroll
        for (int b = 0; b < 3; ++b) { ls[b] = LSE[((size_t)b * MH + row) * NH + h]; mx = fmaxf(mx, ls[b]); }
        float al[3], sum = 0.f;
#pragma unroll
        for (int b = 0; b < 3; ++b) { al[b] = __expf(ls[b] - mx); sum += al[b]; }
        const float inv = 1.0f / sum; float acc[8];
#pragma unroll
        for (int e = 0; e < 8; ++e) acc[e] = 0.f;
#pragma unroll
        for (int b = 0; b < 3; ++b) { const v4u w = *(const GAS v4u*)(OB + ((size_t)b * MH + row) * RW + cg * 8); const float a = al[b] * inv;
            acc[0] += a * bflo(w.x); acc[1] += a * bfhi(w.x); acc[2] += a * bflo(w.y); acc[3] += a * bfhi(w.y); acc[4] += a * bflo(w.z); acc[5] += a * bfhi(w.z); acc[6] += a * bflo(w.w); acc[7] += a * bfhi(w.w); }
        v4u o; o.x = pk2(acc[0], acc[1]); o.y = pk2(acc[2], acc[3]); o.z = pk2(acc[4], acc[5]); o.w = pk2(acc[6], acc[7]);
        *(GAS v4u*)(MIX + (size_t)row * D + 640 + cg * 8) = o; }
}
constexpr int LB = 72;
constexpr int LS = 40;
constexpr int LF = 65;
constexpr int MATB = 64 * LB * 2;
template <int KS, bool SWA = false, bool SWB = false> __device__ __forceinline__ f32x4 mm16(const LAS bf16* A, int lda, const LAS bf16* BT, int ldb, int mi, int nj, int lane, f32x4 acc) {
    const int ra = 16 * mi + (lane & 15), rb = 16 * nj + (lane & 15), ch = lane >> 4;
    const LAS bf16* ap = A + ra * lda; const LAS bf16* bp = BT + rb * ldb;
#pragma unroll
    for (int ks = 0; ks < KS; ++ks) { const int ca = SWA ? ((ch + 4 * ks) ^ ((ra >> 3) & 7)) : (ch + 4 * ks), cb = SWB ? ((ch + 4 * ks) ^ ((rb >> 3) & 7)) : (ch + 4 * ks);
        acc = mfma16(*(const LAS bf16x8*)(ap + 8 * ca), *(const LAS bf16x8*)(bp + 8 * cb), acc); }
    return acc;
}
template <int N, int S, int J> __device__ __forceinline__ void rl_fma(float& acc, const float (&Tr)[32], const float (&vL)[32]) {
    if constexpr (N == 4) { unsigned t0, t1, t2, t3;
        asm volatile("v_readlane_b32 %1, %5, %13\n\tv_readlane_b32 %2, %6, %13\n\tv_readlane_b32 %3, %7, %13\n\tv_readlane_b32 %4, %8, %13\n\tv_fmac_f32 %0, %1, %9\n\tv_fmac_f32 %0, %2, %10\n\tv_fmac_f32 %0, %3, %11\n\tv_fmac_f32 %0, %4, %12"
                     : "+v"(acc), "=&s"(t0), "=&s"(t1), "=&s"(t2), "=&s"(t3) : "v"(vL[S]), "v"(vL[S + 1]), "v"(vL[S + 2]), "v"(vL[S + 3]), "v"(Tr[S]), "v"(Tr[S + 1]), "v"(Tr[S + 2]), "v"(Tr[S + 3]), "n"(J)); }
    else if constexpr (N == 3) { unsigned t0, t1, t2;
        asm volatile("v_readlane_b32 %1, %4, %10\n\tv_readlane_b32 %2, %5, %10\n\tv_readlane_b32 %3, %6, %10\n\tv_fmac_f32 %0, %1, %7\n\tv_fmac_f32 %0, %2, %8\n\tv_fmac_f32 %0, %3, %9"
                     : "+v"(acc), "=&s"(t0), "=&s"(t1), "=&s"(t2) : "v"(vL[S]), "v"(vL[S + 1]), "v"(vL[S + 2]), "v"(Tr[S]), "v"(Tr[S + 1]), "v"(Tr[S + 2]), "n"(J)); }
    else if constexpr (N == 2) { unsigned t0, t1;
        asm volatile("v_readlane_b32 %1, %3, %7\n\tv_readlane_b32 %2, %4, %7\n\ts_nop 0\n\tv_fmac_f32 %0, %1, %5\n\tv_fmac_f32 %0, %2, %6"
                     : "+v"(acc), "=&s"(t0), "=&s"(t1) : "v"(vL[S]), "v"(vL[S + 1]), "v"(Tr[S]), "v"(Tr[S + 1]), "n"(J)); }
    else if constexpr (N == 1) { unsigned t0;
        asm volatile("v_readlane_b32 %1, %2, %4\n\ts_nop 1\n\tv_fmac_f32 %0, %1, %3" : "+v"(acc), "=&s"(t0) : "v"(vL[S]), "v"(Tr[S]), "n"(J)); }
}
template <int S, int J> __device__ __forceinline__ void rl_fma_all(float& acc, const float (&Tr)[32], const float (&vL)[32]) {
    constexpr int REM = 32 - S;
    if constexpr (REM >= 4) { rl_fma<4, S, J>(acc, Tr, vL); rl_fma_all<S + 4, J>(acc, Tr, vL); }
    else if constexpr (REM > 0) { rl_fma<REM, S, J>(acc, Tr, vL); }
}
template <int J> struct SolveStep {
    static __device__ __forceinline__ void run(float (&Tr)[32], const float (&vL)[32], int r_) {
        float acc = (J == r_) ? 1.f : 0.f;
        rl_fma_all<J + 1, J>(acc, Tr, vL);
        Tr[J] = (J <= r_) ? acc : 0.f;
        SolveStep<J - 1>::run(Tr, vL, r_);
    }
};
template <> struct SolveStep<-1> { static __device__ __forceinline__ void run(float (&)[32], const float (&)[32], int) {} };
__device__ __forceinline__ v2u pk4(const f32x4 v) { v2u o; o.x = cvtpk(v[0], v[1]); o.y = cvtpk(v[2], v[3]); return o; }
__device__ __forceinline__ void passA_unit(KARG, Frame& F, int hf, int l, int unit) {
    int tid = F.tid; asm volatile("" : "+v"(tid)); int t = tid >> 3, cg = tid & 7, c0 = cg * 8;
    const int ci = unit / 6, h = unit % 6; const int rr0 = ci * 64; const int T = hf ? 16384 : 8192; const int sbase = hf ? 0 : (rr0 & ~8191);
    int tl = rr0 - sbase + t;
    const bf16* PX = WSP(bf16, WS_PX);
    LAS unsigned char* L0 = F.lds + RING_OFF;
#define MAT(i) ((LAS bf16*)(L0 + (i) * MATB))
    LAS bf16* mAt = MAT(0); LAS bf16* mBt = MAT(1); LAS bf16* mKt = MAT(2); LAS bf16* mRt = MAT(3); LAS bf16* mAtT = MAT(4); LAS bf16* mBtT = MAT(5); LAS bf16* mKtT = MAT(6); LAS bf16* mVT = MAT(7);
    LAS bf16* mLak = MAT(8); LAS bf16* mLrb = MAT(9); LAS bf16* mLrk = MAT(10); LAS bf16* mT = MAT(11); LAS bf16* mX1T = MAT(12); LAS bf16* mWT = MAT(13); LAS bf16* mU0T = MAT(8);
    LAS float* fC = (LAS float*)(L0 + 8 * MATB);
    LAS bf16* sLogd = (LAS bf16*)(L0 + 8 * MATB + 16640);
    LAS bf16* sIcl = sLogd + 64 * LB;
    LAS bf16* mActW = MAT(12); LAS bf16* mActA = MAT(13);
    LAS float* sLs = (LAS float*)(L0 + 12 * MATB);
    LAS bf16* sL21 = (LAS bf16*)(L0 + 12 * MATB + 8448);
    LAS bf16* sT11T = sL21 + 32 * LS;
    LAS bf16* sQT = sT11T + 32 * LS;
    LAS float* sDC = (LAS float*)(L0 + 14 * MATB);
    float bonus = 0.f;
    for (int d = 0; d < 2; ++d) {
        asm volatile("" : "+v"(tid)); t = tid >> 3; cg = tid & 7; c0 = cg * 8; tl = rr0 - sbase + t;
        const int lane = tid & 63, wave = __builtin_amdgcn_readfirstlane(tid >> 6);
        const int tau = d ? 63 - t : t; const size_t inst = ((size_t)ci * 6 + h) * 2 + d;
    float cr[8], ck[8], cv[8];
    { const float* cw = KA.in[I_CONV] + (size_t)l * 3 * 1152;
#pragma unroll
      for (int e = 0; e < 8; ++e) { cr[e] = 0.f; ck[e] = 0.f; cv[e] = 0.f; }
#pragma unroll
      for (int tap = 0; tap < 3; ++tap) { const int tq = tl + tap - 1; if (tq >= 0 && tq < T) { const bf16* row = PX + (size_t)(sbase + tq) * PXW + h * 64 + c0;
          const v4u wr_ = *(const GAS v4u*)(row), wk_ = *(const GAS v4u*)(row + 384), wv_ = *(const GAS v4u*)(row + 768); const float* w = cw + tap * 1152 + h * 64 + c0;
          const unsigned ur[4] = {wr_.x, wr_.y, wr_.z, wr_.w}, uk[4] = {wk_.x, wk_.y, wk_.z, wk_.w}, uv[4] = {wv_.x, wv_.y, wv_.z, wv_.w};
#pragma unroll
          for (int e = 0; e < 8; ++e) { const float xr = (e & 1) ? bfhi(ur[e >> 1]) : bflo(ur[e >> 1]), xk = (e & 1) ? bfhi(uk[e >> 1]) : bflo(uk[e >> 1]), xv = (e & 1) ? bfhi(uv[e >> 1]) : bflo(uv[e >> 1]);
              cr[e] += xr * w[e]; ck[e] += xk * w[384 + e]; cv[e] += xv * w[768 + e]; } } } }
    float kkv[8];
    { float ss = 0.f; const float* kkw = KA.in[I_KK] + l * RW + h * 64 + c0;
#pragma unroll
      for (int e = 0; e < 8; ++e) { kkv[e] = ck[e] * kkw[e]; ss += kkv[e] * kkv[e]; }
      ss += shx(ss, 1, lane); ss += shx(ss, 2, lane); ss += shx(ss, 4, lane);
      const float inv = 1.0f / fmaxf(sqrtf(ss), 1e-12f);
#pragma unroll
      for (int e = 0; e < 8; ++e) kkv[e] *= inv; }
        __syncthreads();
        { const bf16* row = PX + (size_t)(rr0 + t) * PXW + 1152 + c0; const v4u ww = *(const GAS v4u*)(row), wa = *(const GAS v4u*)(row + 64);
          v4u o; o.x = pk2(tanhf_(bflo(ww.x)), tanhf_(bfhi(ww.x))); o.y = pk2(tanhf_(bflo(ww.y)), tanhf_(bfhi(ww.y))); o.z = pk2(tanhf_(bflo(ww.z)), tanhf_(bfhi(ww.z))); o.w = pk2(tanhf_(bflo(ww.w)), tanhf_(bfhi(ww.w)));
          *(LAS v4u*)(mActW + tau * LB + c0) = o; *(LAS v4u*)(mActA + tau * LB + c0) = wa; }
        __syncthreads();
        { const int prod = wave >> 2, nj = wave & 3, cl = lane & 15, ql = lane >> 4; const int c = 16 * nj + cl;
          const bf16* UT = WSP(bf16, WS_SMALL) + 98304 * (1 + prod) + (size_t)(l * 2 + d) * RW * 64 + (size_t)(h * 64 + c) * 64 + 8 * ql;
          const bf16x8 b0 = *(const GAS bf16x8*)(UT), b1 = *(const GAS bf16x8*)(UT + 32);
          const float bias = KA.in[prod ? I_IA0 : I_DW0][(size_t)(l * 2 + d) * RW + h * 64 + c];
          f32x4 v[4];
#pragma unroll
          for (int mi = 0; mi < 4; ++mi) { const LAS bf16* ap = (prod ? mActA : mActW) + (16 * mi + cl) * LB + 8 * ql; f32x4 a = {bias, bias, bias, bias};
              a = mfma16(*(const LAS bf16x8*)(ap), b0, a); a = mfma16(*(const LAS bf16x8*)(ap + 32), b1, a); v[mi] = a; }
          if (prod) {
#pragma unroll
              for (int mi = 0; mi < 4; ++mi)
#pragma unroll
                  for (int e = 0; e < 4; ++e) sIcl[(16 * mi + 4 * ql + e) * LB + c] = (bf16)f2bf(sigmoidf_(v[mi][e]));
          } else { float base = 0.f;
#pragma unroll
              for (int mi = 0; mi < 4; ++mi) { float ld_[4], p[4];
#pragma unroll
                  for (int e = 0; e < 4; ++e) { ld_[e] = -0.6065306597126334f * sigmoidf_(v[mi][e]); p[e] = ld_[e] + (e ? p[e - 1] : 0.f); }
                  const float g0 = shx(p[3], 0, cl), g1 = shx(p[3], 0, cl + 16), g2 = shx(p[3], 0, cl + 32), g3 = shx(p[3], 0, cl + 48);
                  const float off = base + (ql > 0 ? g0 : 0.f) + (ql > 1 ? g1 : 0.f) + (ql > 2 ? g2 : 0.f); base += (g0 + g1) + (g2 + g3);
#pragma unroll
                  for (int e = 0; e < 4; ++e) { fC[(16 * mi + 4 * ql + e) * LF + c] = off + p[e]; sLogd[(16 * mi + 4 * ql + e) * LB + c] = (bf16)f2bf(ld_[e]); } } } }
        __syncthreads();
        float logd[8], ic[8];
        { const v4u wl_ = *(const LAS v4u*)(sLogd + tau * LB + c0), wi_ = *(const LAS v4u*)(sIcl + tau * LB + c0);
          logd[0] = bflo(wl_.x); logd[1] = bfhi(wl_.x); logd[2] = bflo(wl_.y); logd[3] = bfhi(wl_.y); logd[4] = bflo(wl_.z); logd[5] = bfhi(wl_.z); logd[6] = bflo(wl_.w); logd[7] = bfhi(wl_.w);
          ic[0] = bflo(wi_.x); ic[1] = bfhi(wi_.x); ic[2] = bflo(wi_.y); ic[3] = bfhi(wi_.y); ic[4] = bflo(wi_.z); ic[5] = bfhi(wi_.z); ic[6] = bflo(wi_.w); ic[7] = bfhi(wi_.w); }
        { const float* ka = KA.in[I_KA] + l * RW + h * 64 + c0; const float* brk = KA.in[I_BRK] + l * RW + h * 64 + c0;
          float at[8], bt_[8], kt[8], rt[8]; float bs = 0.f;
#pragma unroll
          for (int e = 0; e < 8; ++e) { const float cum = fC[tau * LF + c0 + e], cumx = cum - logd[e]; const float keff = ck[e] * (1.0f + (ic[e] - 1.0f) * ka[e]);
              bs += cr[e] * keff * brk[e];
              const float en = __expf(-cum);
              at[e] = -kkv[e] * __expf(cumx); bt_[e] = kkv[e] * ic[e] * en; kt[e] = keff * en; rt[e] = cr[e] * __expf(cum); }
          bs += shx(bs, 1, lane); bs += shx(bs, 2, lane); bs += shx(bs, 4, lane); bonus += bs;
          v4u o;
          o.x = pk2(at[0], at[1]); o.y = pk2(at[2], at[3]); o.z = pk2(at[4], at[5]); o.w = pk2(at[6], at[7]); *(LAS v4u*)(mAt + tau * LB + c0) = o;
          o.x = pk2(bt_[0], bt_[1]); o.y = pk2(bt_[2], bt_[3]); o.z = pk2(bt_[4], bt_[5]); o.w = pk2(bt_[6], bt_[7]); *(LAS v4u*)(mBt + tau * LB + c0) = o;
          o.x = pk2(kt[0], kt[1]); o.y = pk2(kt[2], kt[3]); o.z = pk2(kt[4], kt[5]); o.w = pk2(kt[6], kt[7]); *(LAS v4u*)(mKt + tau * LB + c0) = o;
          o.x = pk2(rt[0], rt[1]); o.y = pk2(rt[2], rt[3]); o.z = pk2(rt[4], rt[5]); o.w = pk2(rt[6], rt[7]); *(LAS v4u*)(mRt + tau * LB + c0) = o;
          { const int tsw = tau ^ (cg << 3);
#pragma unroll
          for (int e = 0; e < 8; ++e) { mAtT[(c0 + e) * LB + tsw] = (bf16)f2bf(at[e]); mBtT[(c0 + e) * LB + tsw] = (bf16)f2bf(bt_[e]); mKtT[(c0 + e) * LB + tsw] = (bf16)f2bf(kt[e]); mVT[(c0 + e) * LB + tsw] = (bf16)f2bf(cv[e]); } }
          if (t == 0) {
#pragma unroll
              for (int e = 0; e < 8; ++e) { const float dc = __expf(fC[63 * LF + c0 + e]); const int k_ = c0 + e; sDC[k_] = dc; WSP(float, WS_DC)[inst * 64 + 16 * ((k_ >> 2) & 3) + 4 * (k_ >> 4) + (k_ & 3)] = dc; } } }
        __syncthreads();
        int lnv = lane, cc, qq;
#define FRESH_LANE() do { asm volatile("" : "+v"(lnv)); cc = lnv & 15; qq = lnv >> 4; } while (0)
        FRESH_LANE();
        PA_REPEAT(1) {
        for (int tt = wave; tt < 64; tt += 8) { const int prod = tt >> 4, mi = (tt >> 2) & 3, nj = tt & 3; const f32x4 z = {0.f, 0.f, 0.f, 0.f};
            if (prod == 0) { const f32x4 a = mm16<2>(mAt, LB, mBt, LB, mi, nj, lnv, z);
                const int sg = 16 * nj + cc; const int blk = mi >> 1;
                if ((mi >> 1) == (nj >> 1)) {
#pragma unroll
                    for (int e = 0; e < 4; ++e) { const int ta = 16 * mi + 4 * qq + e; sLs[blk * 32 * 33 + (ta & 31) * 33 + (sg & 31)] = (sg < ta) ? a[e] : 0.f; } }
                else if (mi >= 2) {
#pragma unroll
                    for (int e = 0; e < 4; ++e) { const int ta = 16 * mi + 4 * qq + e; sL21[(ta - 32) * LS + sg] = (bf16)f2bf(a[e]); } } }
            else { const LAS bf16* Am = (prod == 2) ? mBt : mKt; const LAS bf16* Bm = (prod == 1) ? mAt : mRt; LAS bf16* Om = (prod == 1) ? mLak : (prod == 2 ? mLrb : mLrk);
                f32x4 a = mm16<2>(Am, LB, Bm, LB, mi, nj, lnv, z);
                const int ta = 16 * nj + cc;
#pragma unroll
                for (int e = 0; e < 4; ++e) { const int sg = 16 * mi + 4 * qq + e; const bool keep = (prod == 1) ? (sg < ta) : (sg <= ta); a[e] = keep ? a[e] : 0.f; }
                *(LAS v2u*)(Om + ta * LB + 16 * mi + 4 * qq) = pk4(a); } }
        __syncthreads();
        }
        PA_REPEAT(2) {
        FRESH_LANE();
        if (wave < 2) { const int blk = wave, r_ = lnv & 31; const LAS float* Lb = sLs + blk * 32 * 33; float Tr[32], vL[32];
#pragma unroll
            for (int s = 0; s < 32; ++s) vL[s] = Lb[s * 33 + r_];
            SolveStep<31>::run(Tr, vL, r_);
            if (lnv < 32) {
            LAS bf16* trow = mT + (32 * blk + r_) * LB + 32 * blk; LAS bf16* zrow = mT + r_ * LB + 32;
#pragma unroll
            for (int g = 0; g < 4; ++g) { v4u o; o.x = pk2(Tr[8 * g], Tr[8 * g + 1]); o.y = pk2(Tr[8 * g + 2], Tr[8 * g + 3]); o.z = pk2(Tr[8 * g + 4], Tr[8 * g + 5]); o.w = pk2(Tr[8 * g + 6], Tr[8 * g + 7]);
                *(LAS v4u*)(trow + 8 * g) = o; if (blk == 0) *(LAS v4u*)(zrow + 8 * g) = (v4u){0u, 0u, 0u, 0u}; }
            if (blk == 0) {
#pragma unroll
                for (int j = 0; j < 32; ++j) sT11T[j * LS + r_] = (bf16)f2bf(Tr[j]); } } }
        __syncthreads();
        }
        PA_REPEAT(3) {
        FRESH_LANE();
        if (wave < 4) { const int mi = wave >> 1, nj = wave & 1; const f32x4 a = mm16<1>(sL21, LS, sT11T, LS, mi, nj, lnv, (f32x4){0.f, 0.f, 0.f, 0.f});
            *(LAS v2u*)(sQT + (16 * nj + cc) * LS + 16 * mi + 4 * qq) = pk4(a); }
        __syncthreads();
        }
        PA_REPEAT(3) {
        FRESH_LANE();
        if (wave < 4) { const int mi = wave >> 1, nj = wave & 1; const f32x4 a = mm16<1>(mT + 32 * LB + 32, LB, sQT, LS, mi, nj, lnv, (f32x4){0.f, 0.f, 0.f, 0.f});
#pragma unroll
            for (int e = 0; e < 4; ++e) mT[(32 + 16 * mi + 4 * qq + e) * LB + 16 * nj + cc] = (bf16)f2bf(a[e]); }
        __syncthreads();
        }
        PA_REPEAT(4) {
        FRESH_LANE();
        for (int tt = wave; tt < 32; tt += 8) { const int prod = tt >> 4, mi = (tt >> 2) & 3, nj = tt & 3; const f32x4 z = {0.f, 0.f, 0.f, 0.f};
            const f32x4 a = prod ? mm16<2, false, true>(mT, LB, mAtT, LB, mi, nj, lnv, z) : mm16<2, false, true>(mLak, LB, mVT, LB, mi, nj, lnv, z);
            *(LAS v2u*)((prod ? mWT : mX1T) + (16 * nj + cc) * LB + 16 * mi + 4 * qq) = pk4(a); }
        __syncthreads();
        }
        PA_REPEAT(5) {
        FRESH_LANE();
        for (int tt = wave; tt < 16; tt += 8) { const int mi = tt >> 2, nj = tt & 3; const f32x4 a = mm16<2>(mT, LB, mX1T, LB, mi, nj, lnv, (f32x4){0.f, 0.f, 0.f, 0.f});
            *(LAS v2u*)(mU0T + (16 * nj + cc) * LB + 16 * mi + 4 * qq) = pk4(a); }
        __syncthreads();
        }
        PA_REPEAT(6) {
        FRESH_LANE();
        for (int tt = wave; tt < 64; tt += 8) { const int prod = tt >> 4, mi = (tt >> 2) & 3, nj = tt & 3; const int r4 = 16 * mi + 4 * qq, cn = 16 * nj + cc;
            if (prod == 0) {
                const v2u rv = *(const LAS v2u*)(mRt + cn * LB + r4); f32x4 a = {bflo(rv.x), bfhi(rv.x), bflo(rv.y), bfhi(rv.y)};
                a = mm16<2>(mWT, LB, mLrb, LB, mi, nj, lnv, a); const int treal = d ? 63 - cn : cn;
                *(GAS v2u*)(WSP(bf16, WS_RY) + inst * 4096 + treal * 64 + r4) = pk4(a); }
            else if (prod == 1) {
                f32x4 a = mm16<2>(mU0T, LB, mLrb, LB, mi, nj, lnv, (f32x4){0.f, 0.f, 0.f, 0.f}); a = mm16<2, true, false>(mVT, LB, mLrk, LB, mi, nj, lnv, a); const int treal = d ? 63 - cn : cn;
                *(GAS v2u*)(WSP(bf16, WS_Y0) + inst * 4096 + treal * 64 + r4) = pk4(a); }
            else if (prod == 2) {
                f32x4 a = mm16<2, false, true>(mWT, LB, mBtT, LB, mi, nj, lnv, (f32x4){0.f, 0.f, 0.f, 0.f}); const float dc = sDC[cn];
#pragma unroll
                for (int e = 0; e < 4; ++e) a[e] *= dc;
                *(GAS v2u*)(WSP(bf16, WS_GP) + inst * 4096 + cn * 64 + (r4 & 32) + 8 * qq + 4 * (mi & 1)) = pk4(a); }
            else {
                f32x4 a = mm16<2, true, false>(mBtT, LB, mU0T, LB, mi, nj, lnv, (f32x4){0.f, 0.f, 0.f, 0.f}); a = mm16<2, true, true>(mKtT, LB, mVT, LB, mi, nj, lnv, a);
#pragma unroll
                for (int e = 0; e < 4; ++e) a[e] *= sDC[r4 + e];
                *(GAS v2u*)(WSP(bf16, WS_H0T) + inst * 4096 + cn * 64 + 16 * qq + 4 * mi) = pk4(a); } }
        __syncthreads();
        }
    }
#undef MAT
#undef FRESH_LANE
    if (cg == 0) WSP(float, WS_BON)[(size_t)unit * 64 + t] = bonus;
}
__device__ __forceinline__ void phase_passA(KARG, Frame& F, int hf, int l) {
    for (int u = F.vcu; u < (MH / 64) * 6; u += F.G) passA_unit(KA, F, hf, l, u);
}
constexpr int PB_SLOT = 14 * 1024;
__device__ __forceinline__ void phase_passB(Frame& F, int hf) {
    const int nchain = hf ? 12 : 24, nck = hf ? 256 : 128;
    const int uu = F.vcu;
    if (uu >= nchain * 4) return;
    const int chain = uu >> 2, cgp = uu & 3; const int d = chain & 1, h = (chain >> 1) % 6, s = (chain >> 1) / 6;
    const int lane = F.lane, c16 = lane & 15, q = lane >> 4, v = 16 * cgp + c16;
    const bf16* GP = WSP(bf16, WS_GP); const bf16* H0T = WSP(bf16, WS_H0T); const float* DC = WSP(float, WS_DC); bf16* HC = WSP(bf16, WS_HC);
    LAS unsigned char* ring = F.lds + RING_OFF;
    volatile LAS int* full = (volatile LAS int*)(F.lds + RING_OFF + 7 * PB_SLOT);
    volatile LAS int* cons = full + 8;
    if (F.tid < 16) full[F.tid] = 0;
    __syncthreads();
    if (F.wave > 0) {
        const int slot = F.wave - 1; LAS unsigned char* sp = ring + slot * PB_SLOT + lane * 16; int k = 0;
        for (int st = slot; st < nck; st += 7, ++k) {
            const int cl_ = d ? nck - 1 - st : st; const size_t in_ = ((size_t)(s * nck + cl_) * 6 + h) * 2 + d;
            v4u x[14];
#pragma unroll
            for (int mo = 0; mo < 4; ++mo) { const bf16* gr = GP + in_ * 4096 + (16 * mo + c16) * 64 + 8 * q; x[2 * mo] = *(const GAS v4u*)(gr); x[2 * mo + 1] = *(const GAS v4u*)(gr + 32);
                x[10 + mo] = *(const GAS v4u*)(DC + in_ * 64 + 16 * q + 4 * mo); }
            x[8] = *(const GAS v4u*)(H0T + in_ * 4096 + v * 64 + 16 * q); x[9] = *(const GAS v4u*)(H0T + in_ * 4096 + v * 64 + 16 * q + 8);
            while (cons[slot] < k) __builtin_amdgcn_s_sleep(1);
            asm volatile("" ::: "memory");
#pragma unroll
            for (int i = 0; i < 14; ++i) *(LAS v4u*)(sp + i * 1024) = x[i];
            asm volatile("s_waitcnt lgkmcnt(0)" ::: "memory");
            if (lane == 0) full[slot] = k + 1;
        }
        return;
    }
    f32x4 hacc[4];
#pragma unroll
    for (int m = 0; m < 4; ++m) hacc[m] = (f32x4){0.f, 0.f, 0.f, 0.f};
    for (int step = 0; step < nck; ++step) {
        const int slot = step % 7, k = step / 7; const int cl = d ? nck - 1 - step : step; const size_t inst = ((size_t)(s * nck + cl) * 6 + h) * 2 + d;
        while (full[slot] < k + 1) __builtin_amdgcn_s_sleep(1);
        asm volatile("" ::: "memory");
        const LAS unsigned char* sp = ring + slot * PB_SLOT + lane * 16; v4u x[14];
#pragma unroll
        for (int i = 0; i < 14; ++i) x[i] = *(const LAS v4u*)(sp + i * 1024);
        asm volatile("s_waitcnt lgkmcnt(0)" ::: "memory");
        if (lane == 0) cons[slot] = k + 1;
        v2u hb[4];
#pragma unroll
        for (int m = 0; m < 4; ++m) { hb[m].x = cvtpk(hacc[m][0], hacc[m][1]); hb[m].y = cvtpk(hacc[m][2], hacc[m][3]); *(GAS v2u*)(HC + inst * 4096 + v * 64 + 16 * m + 4 * q) = hb[m]; }
        bf16x8 bfr[2];
#pragma unroll
        for (int ks = 0; ks < 2; ++ks) { v4u t4; t4.x = hb[2 * ks].x; t4.y = hb[2 * ks].y; t4.z = hb[2 * ks + 1].x; t4.w = hb[2 * ks + 1].y; bfr[ks] = __builtin_bit_cast(bf16x8, t4); }
        const unsigned hw[8] = {x[8].x, x[8].y, x[8].z, x[8].w, x[9].x, x[9].y, x[9].z, x[9].w};
#pragma unroll
        for (int mo = 0; mo < 4; ++mo) { const f32x4 dc = __builtin_bit_cast(f32x4, x[10 + mo]); f32x4 cin;
            cin[0] = dc[0] * hacc[mo][0] + bflo(hw[2 * mo]); cin[1] = dc[1] * hacc[mo][1] + bfhi(hw[2 * mo]); cin[2] = dc[2] * hacc[mo][2] + bflo(hw[2 * mo + 1]); cin[3] = dc[3] * hacc[mo][3] + bfhi(hw[2 * mo + 1]);
            cin = mfma16(__builtin_bit_cast(bf16x8, x[2 * mo]), bfr[0], cin); cin = mfma16(__builtin_bit_cast(bf16x8, x[2 * mo + 1]), bfr[1], cin); hacc[mo] = cin; }
    }
}
__device__ __forceinline__ void passC_unit(KARG, Frame& F, int hf, int l, int unit) {
    const int lane = F.lane, c31 = lane & 31, hh = lane >> 5; const int ci = unit / 6, h = unit % 6; const int rr0 = ci * 64;
    const int T = hf ? 16384 : 8192; const int sbase = hf ? 0 : (rr0 & ~8191);
    const bf16* PX = WSP(bf16, WS_PX); const bf16* RY = WSP(bf16, WS_RY); const bf16* Y0 = WSP(bf16, WS_Y0); const bf16* HC = WSP(bf16, WS_HC);
    f32x16 acc[2][2];
#pragma unroll
    for (int mt = 0; mt < 2; ++mt)
#pragma unroll
        for (int nt = 0; nt < 2; ++nt) { f32x16 a;
#pragma unroll
            for (int g = 0; g < 4; ++g) { float s4[4] = {0.f, 0.f, 0.f, 0.f};
#pragma unroll
                for (int d = 0; d < 2; ++d) { const size_t inst = ((size_t)ci * 6 + h) * 2 + d; const v2u w = *(const GAS v2u*)(Y0 + inst * 4096 + (32 * nt + c31) * 64 + 32 * mt + 8 * g + 4 * hh);
                    s4[0] += bflo(w.x); s4[1] += bfhi(w.x); s4[2] += bflo(w.y); s4[3] += bfhi(w.y); }
                a[4 * g] = s4[0]; a[4 * g + 1] = s4[1]; a[4 * g + 2] = s4[2]; a[4 * g + 3] = s4[3]; }
            acc[mt][nt] = a; }
#pragma unroll
    for (int d = 0; d < 2; ++d) { const size_t inst = ((size_t)ci * 6 + h) * 2 + d;
#pragma unroll
        for (int ks = 0; ks < 4; ++ks) { bf16x8 af[2], bf_[2];
#pragma unroll
            for (int x = 0; x < 2; ++x) { af[x] = *(const GAS bf16x8*)(HC + inst * 4096 + (32 * x + c31) * 64 + 16 * ks + 8 * hh); bf_[x] = *(const GAS bf16x8*)(RY + inst * 4096 + (32 * x + c31) * 64 + 16 * ks + 8 * hh); }
#pragma unroll
            for (int mt = 0; mt < 2; ++mt)
#pragma unroll
                for (int nt = 0; nt < 2; ++nt) acc[mt][nt] = mfma32(af[mt], bf_[nt], acc[mt][nt]); } }
    f32x16 gacc[2][2] = {};
    { const bf16* GUT = WSP(bf16, WS_SMALL) + (size_t)l * RW * 128;
#pragma unroll
      for (int ks = 0; ks < 8; ++ks) { bf16x8 af[2], bf_[2];
#pragma unroll
          for (int x = 0; x < 2; ++x) { af[x] = *(const GAS bf16x8*)(GUT + (size_t)(h * 64 + 32 * x + c31) * 128 + 16 * ks + 8 * hh);
              const v4u w = *(const GAS v4u*)(PX + (size_t)(rr0 + 32 * x + c31) * PXW + 1280 + 16 * ks + 8 * hh); v4u o;
              o.x = cvtpk(sigmoidf_(bflo(w.x)), sigmoidf_(bfhi(w.x))); o.y = cvtpk(sigmoidf_(bflo(w.y)), sigmoidf_(bfhi(w.y))); o.z = cvtpk(sigmoidf_(bflo(w.z)), sigmoidf_(bfhi(w.z))); o.w = cvtpk(sigmoidf_(bflo(w.w)), sigmoidf_(bfhi(w.w)));
              bf_[x] = __builtin_bit_cast(bf16x8, o); }
#pragma unroll
          for (int mt = 0; mt < 2; ++mt)
#pragma unroll
              for (int nt = 0; nt < 2; ++nt) gacc[mt][nt] = mfma32(af[mt], bf_[nt], gacc[mt][nt]); } }
    const float* gng = KA.in[I_GNG] + l * RW + h * 64; const float* gnb = KA.in[I_GNB] + l * RW + h * 64; const float* cw = KA.in[I_CONV] + (size_t)l * 3 * 1152 + 768 + h * 64;
    bf16* MIX = WSP(bf16, WS_MIX);
#pragma unroll
    for (int nt = 0; nt < 2; ++nt) { const int t = 32 * nt + c31; const int tl = rr0 - sbase + t;
        float s1 = 0.f;
#pragma unroll
        for (int mt = 0; mt < 2; ++mt)
#pragma unroll
            for (int i = 0; i < 16; ++i) s1 += acc[mt][nt][i];
        s1 += shx(s1, 32, lane); const float mu = s1 * (1.0f / 64.0f); float s2 = 0.f;
#pragma unroll
        for (int mt = 0; mt < 2; ++mt)
#pragma unroll
            for (int i = 0; i < 16; ++i) { const float dlt = acc[mt][nt][i] - mu; s2 += dlt * dlt; }
        s2 += shx(s2, 32, lane); const float rstd = 1.0f / sqrtf(s2 * (1.0f / 64.0f) + GN_EPS);
        const float bon = WSP(float, WS_BON)[(size_t)unit * 64 + t];
#pragma unroll
        for (int mt = 0; mt < 2; ++mt)
#pragma unroll
            for (int g = 0; g < 4; ++g) { const int j0 = 32 * mt + 8 * g + 4 * hh; float vv[4] = {0.f, 0.f, 0.f, 0.f};
#pragma unroll
                for (int tap = 0; tap < 3; ++tap) { const int tq = tl + tap - 1; if (tq >= 0 && tq < T) { const v2u w = *(const GAS v2u*)(PX + (size_t)(sbase + tq) * PXW + 768 + h * 64 + j0); const f32x4 cwv = *(const GAS f32x4*)(cw + tap * 1152 + j0);
                    vv[0] += bflo(w.x) * cwv[0]; vv[1] += bfhi(w.x) * cwv[1]; vv[2] += bflo(w.y) * cwv[2]; vv[3] += bfhi(w.y) * cwv[3]; } }
                const f32x4 gg = *(const GAS f32x4*)(gng + j0), gb = *(const GAS f32x4*)(gnb + j0); float o4[4];
#pragma unroll
                for (int e = 0; e < 4; ++e) { const float y = (acc[mt][nt][4 * g + e] - mu) * rstd * gg[e] + gb[e] + bon * vv[e]; o4[e] = y * gacc[mt][nt][4 * g + e]; }
                v2u o; o.x = pk2(o4[0], o4[1]); o.y = pk2(o4[2], o4[3]); *(GAS v2u*)(MIX + (size_t)(rr0 + t) * D + 256 + h * 64 + j0) = o; } }
}
__device__ __forceinline__ void phase_passC(KARG, Frame& F, int hf, int l) {
    const int gw = F.vcu * NWAVES + F.wave, NGW = F.G * NWAVES;
    for (int u = gw; u < (MH / 64) * 6; u += NGW) passC_unit(KA, F, hf, l, u);
}
constexpr int NPHASE = 47;
__global__ void __launch_bounds__(NWAVES * 64, 2) mega_fwd(Args args) {
    const Args& KA = args;
    extern __shared__ __attribute__((aligned(16))) unsigned char lds[];
    Frame F;
    F.lds = (LAS unsigned char*)lds; F.MISC = (volatile LAS unsigned*)(F.lds + MISC_OFF);
    F.tid = threadIdx.x; F.lane = F.tid & 63; F.wave = __builtin_amdgcn_readfirstlane(F.tid >> 6);
    F.G = gridDim.x; { const int bx = blockIdx.x; F.vcu = (F.G % 8 == 0) ? (bx % 8) * (F.G / 8) + bx / 8 : bx; }
    F.ws = args.ws; F.ctl = (gu32*)(args.ws + WS_CTL); F.out = args.out;
    for (int u = F.tid; u < (LDS_BYTES - LDSCTL_OFF) / 4; u += NWAVES * 64) ((LAS unsigned*)(F.lds + LDSCTL_OFF))[u] = 0u;
    __syncthreads();
    XcdBarrier bar; bar.bar = (unsigned*)(F.ctl + CW_BAR) + args.li * XCD_BAR_WORDS; bar.x = 0; bar.st = nullptr;
    const bool multi = (args.ph_hi - args.ph_lo) > 1;
    if (multi) bar = xcd_barrier_post((unsigned*)(F.ctl + CW_BAR) + args.li * XCD_BAR_WORDS, F.MISC + 8);
    for (int p = args.ph_lo; p < args.ph_hi; ++p) {
        { int tv = threadIdx.x; asm volatile("" : "+v"(tv)); F.tid = tv; F.lane = tv & 63; F.wave = __builtin_amdgcn_readfirstlane(tv >> 6); }
        if (p == 0) { if ((PHM >> 11) & 1) phase_weights(args, F); }
        else {
            const int qq = p - 1, hf = qq / 23, r = qq % 23;
            if (r == 0) { if ((PHM >> 12) & 1) phase_xn_init(args, F, hf); }
            else {
                const int l = (r - 1) / 11, k = (r - 1) % 11;
                unsigned char* wl = F.ws + WS_W + (size_t)l * W_LAYER;
                const int nrep = (k == REPK) ? 2 : 1;
                for (int rep = 0; rep < nrep; ++rep) {
                if (rep) xcd_barrier(bar);
                { int tv = threadIdx.x; asm volatile("" : "+v"(tv)); F.tid = tv; F.lane = tv & 63; F.wave = __builtin_amdgcn_readfirstlane(tv >> 6); }
                if (k == 0 || k == 6 || k == 8 || k == 9) {
                    const bf16* Aop; const bf16* Bop; int Nn, Kk; pg8::EpiGen E;
                    if (k == 0) { Aop = WSP(bf16, WS_XN); Bop = (const bf16*)(wl + W_IN); Nn = NIN; Kk = D; E = pg8::EpiGen{WSP(bf16, WS_PY), WSP(bf16, WS_PX), 1408, PXW, PXW, 0}; }
                    else if (k == 6) { Aop = WSP(bf16, WS_MIX); Bop = (const bf16*)(wl + W_OUT); Nn = D; Kk = D; E = pg8::EpiGen{WSP(bf16, WS_F1), WSP(bf16, WS_F1), 1 << 30, D, D, 0}; }
                    else if (k == 8) { Aop = WSP(bf16, WS_XN); Bop = (const bf16*)(wl + W_FFI); Nn = FF; Kk = D; E = pg8::EpiGen{WSP(bf16, WS_H), WSP(bf16, WS_H), 1 << 30, FF, FF, 2}; }
                    else { Aop = WSP(bf16, WS_H); Bop = (const bf16*)(wl + W_FFO); Nn = D; Kk = FF; E = pg8::EpiGen{WSP(bf16, WS_XN), WSP(bf16, WS_XN), 1 << 30, D, D, 0}; }
                    pg8::Gemm g{Aop, Bop, MH, Nn, Kk}; pg8::StaticOrder S; S.init(MH, Nn, F.G, (int)blockIdx.x);
                    pg8::gemm_phase<pg8::EpiGen, pg8::StaticOrder, true, true>(F.lds + RING_OFF, g, S, E, F.tid);
                } else
                switch (k) {
                case 1: if ((PHM >> 1) & 1) phase_pool_attn(args, F, hf, l); break;
                case 2: if ((PHM >> 2) & 1) phase_attn_merge(F); break;
                case 3: if ((PHM >> 3) & 1) phase_passA(args, F, hf, l); break;
                case 4: if ((PHM >> 4) & 1) phase_passB(F, hf); break;
                case 5: if ((PHM >> 5) & 1) phase_passC(args, F, hf, l); break;
                case 7: if ((PHM >> 7) & 1) { const float* base = (l == 0) ? KA.in[hf ? I_XS : I_XP] : (F.out + (size_t)hf * MH * D);
                          phase_rowpass(args, F, hf, WSP(bf16, WS_F1), base, KA.in[I_NMPOST] + l * D, KA.in[I_NFPRE] + l * D); } break;
                default: if ((PHM >> 10) & 1) { phase_rowpass(args, F, hf, WSP(bf16, WS_XN), F.out + (size_t)hf * MH * D, KA.in[I_NFPOST] + l * D, (l == 0) ? (KA.in[I_NMPRE] + D) : nullptr); } break;
                }
                }
            }
        }
        if (p + 1 < args.ph_hi) xcd_barrier(bar);
    }
}

extern "C" void kernel_launch(void* const* d_in, const int* in_sizes, int n_in, void* d_out, int out_size, void* d_ws, size_t ws_size, hipStream_t stream) {
    static int grid = 0;
    if (grid == 0) {
        if (n_in != 24 || out_size != 2 * MH * D || ws_size < WS_END) { fprintf(stderr, "kernel_launch: unexpected problem shape (n_in %d out %d ws %zu)\n", n_in, out_size, ws_size); grid = -1; return; }
        int dev = 0, cus = 0;
        if (hipGetDevice(&dev) != hipSuccess || hipDeviceGetAttribute(&cus, hipDeviceAttributeMultiprocessorCount, dev) != hipSuccess) { grid = -1; return; }
        if (hipFuncSetAttribute((const void*)mega_fwd, hipFuncAttributeMaxDynamicSharedMemorySize, LDS_BYTES) != hipSuccess) { fprintf(stderr, "kernel_launch: hipFuncSetAttribute failed\n"); grid = -1; return; }
        int per_cu = 0; (void)hipOccupancyMaxActiveBlocksPerMultiprocessor(&per_cu, (const void*)mega_fwd, NWAVES * 64, LDS_BYTES); (void)hipGetLastError();
        grid = cus;
    }
    if (grid < 0) return;
    (void)hipMemsetAsync((char*)d_ws + WS_CTL, 0, CTL_ZERO_BYTES, stream);
    Args a{};
    for (int i = 0; i < 24; ++i) a.in[i] = (const float*)d_in[i];
    a.out = (float*)d_out; a.ws = (unsigned char*)d_ws;
#if MK_N_LAUNCHES == 1
    a.ph_lo = 0; a.ph_hi = NPHASE; a.li = 0;
    hipLaunchKernelGGL(mega_fwd, dim3(grid), dim3(NWAVES * 64), LDS_BYTES, stream, a);
#else
    for (int p = 0; p < NPHASE; ++p) { a.ph_lo = p; a.ph_hi = p + 1; a.li = 0; hipLaunchKernelGGL(mega_fwd, dim3(grid), dim3(NWAVES * 64), LDS_BYTES, stream, a); }
#endif
}
```

```cpp
#include <hip/hip_runtime.h>
#include <cstdio>
#include <cstdint>
#ifndef USE_PA3
#define USE_PA3 1
#endif
#ifndef PROBE_PA
#define PROBE_PA 0
#endif
#define PA_REPEAT(k) for (int rp_ = 0; rp_ < ((PROBE_PA == (k)) ? 5 : 1); ++rp_)
#ifndef REPK
#define REPK -1
#endif
#ifndef PHM
#define PHM 0xFFFF
#endif
#ifndef MK_N_LAUNCHES
#define MK_N_LAUNCHES 1
#endif
namespace pg8 {
#define PG8_LAS __attribute__((address_space(3)))
typedef unsigned short bf16_t;
typedef short bf16x8 __attribute__((ext_vector_type(8)));
typedef float f32x4 __attribute__((ext_vector_type(4)));
typedef unsigned u32x4 __attribute__((ext_vector_type(4)));
constexpr int BM = 256, BK = 64, HALF = 128, HTB = HALF * BK * 2  , STAGE_BYTES = 8 * HTB, NXCD = 8, WGM = 8;

__host__ __device__ __forceinline__ int lds_byte(int r, int c) { const int st = (r >> 4) * 2 + (c >> 5), rr = r & 15, cc = c & 31, ob = rr * 64 + cc * 2; return st * 1024 + (ob ^ (((ob >> 9) & 1) << 5)); }
__host__ __device__ __forceinline__ void stage_rc(int b, int& R, int& C) { const int st = b / 1024, sb = b % 1024, swz = sb ^ (((sb >> 9) & 1) << 5); R = (st >> 1) * 16 + swz / 64; C = (st & 1) * 32 + (swz % 64) / 2; }
__host__ __device__ __forceinline__ int perm32(int rho) { const int n = rho >> 4, i = rho & 15; return 8 * (i >> 2) + 4 * n + (i & 3); }

struct Unit { int pm, pn; };
struct Gemm { const bf16_t* A; const bf16_t* Bt; int M, N, K; };

struct StaticOrder {
    int nM, nN, nwg, G, c;
    __host__ __device__ void init(int M, int N, int G_, int c_) { nM = M / BM; nN = N / BM; nwg = nM * nN; G = G_; c = c_; }
    __host__ __device__ bool next(int i, Unit& u) const {
        const long L = (long)i * G + c; if (L >= nwg) return false;
        int wgid = (int)L; { const int q = nwg / NXCD, r = nwg % NXCD, xcd = wgid % NXCD, off = wgid / NXCD; wgid = (xcd < r ? xcd * (q + 1) : r * (q + 1) + (xcd - r) * q) + off; }
        const int nig = WGM * nN, gid = wgid / nig, fm = gid * WGM, gsz = (nM - fm) < WGM ? (nM - fm) : WGM;
        u.pm = fm + ((wgid % nig) % gsz); u.pn = (wgid % nig) / gsz; return true;
    }
    __device__ __forceinline__ void a_ready(const Unit&) const {}
    __device__ __forceinline__ void done(const Unit&) const {}
};

__device__ __forceinline__ unsigned cvt_pk_bf16(float lo, float hi) { unsigned r; asm volatile("v_cvt_pk_bf16_f32 %0, %1, %2" : "=v"(r) : "v"(lo), "v"(hi)); return r; }
template <int ACT> struct EpiBf16 {
    static constexpr bool PERM = true, AFTER_DRAIN = false;
    bf16_t* O; int ldc;
    __device__ __forceinline__ void operator()(const f32x4 (&acc)[2][2][4][2], const Unit& u, int wr, int wc, int fr, int fq) const {
        const int row0 = u.pm * BM + wr * 64 + fr; const int col0 = u.pn * BM + wc * 32 + 8 * fq;
#pragma unroll
        for (int ai = 0; ai < 2; ++ai)
#pragma unroll
            for (int m = 0; m < 4; ++m) { bf16_t* rowp = O + (size_t)(row0 + ai * HALF + m * 16) * ldc + col0;
#pragma unroll
                for (int bj = 0; bj < 2; ++bj) { f32x4 v0 = acc[ai][bj][m][0], v1 = acc[ai][bj][m][1];
                    if (ACT == 2) {
#pragma unroll
                        for (int e = 0; e < 4; ++e) { float a = fmaxf(v0[e], 0.f), b = fmaxf(v1[e], 0.f); v0[e] = a * a; v1[e] = b * b; } }
                    u32x4 w; w.x = cvt_pk_bf16(v0[0], v0[1]); w.y = cvt_pk_bf16(v0[2], v0[3]); w.z = cvt_pk_bf16(v1[0], v1[1]); w.w = cvt_pk_bf16(v1[2], v1[3]);
                    *(u32x4*)(rowp + bj * HALF) = w; } }
    }
};
struct EpiGen {
    static constexpr bool PERM = true, AFTER_DRAIN = false;
    bf16_t* O0; bf16_t* O1; int split, ld0, ld1, act;
    __device__ __forceinline__ void operator()(const f32x4 (&acc)[2][2][4][2], const Unit& u, int wr, int wc, int fr, int fq) const {
        const int row0 = u.pm * BM + wr * 64 + fr;
#pragma unroll
        for (int bj = 0; bj < 2; ++bj) {
            const int g0 = u.pn * BM + bj * HALF; const bool lo = g0 < split; bf16_t* base = lo ? (O0 + g0) : (O1 + (g0 - split)); const int ld = lo ? ld0 : ld1;
            base += wc * 32 + 8 * fq;
#pragma unroll
            for (int ai = 0; ai < 2; ++ai)
#pragma unroll
                for (int m = 0; m < 4; ++m) { f32x4 v0 = acc[ai][bj][m][0], v1 = acc[ai][bj][m][1];
                    if (act) {
#pragma unroll
                        for (int e = 0; e < 4; ++e) { const float a = fmaxf(v0[e], 0.f), b = fmaxf(v1[e], 0.f); v0[e] = a * a; v1[e] = b * b; } }
                    u32x4 w; w.x = cvt_pk_bf16(v0[0], v0[1]); w.y = cvt_pk_bf16(v0[2], v0[3]); w.z = cvt_pk_bf16(v1[0], v1[1]); w.w = cvt_pk_bf16(v1[2], v1[3]);
                    *(u32x4*)(base + (size_t)(row0 + ai * HALF + m * 16) * ld) = w; } }
    }
};
struct EpiRoute {
    static constexpr bool PERM = true, AFTER_DRAIN = false;
    bf16_t* PY; bf16_t* PX;
    __device__ __forceinline__ void operator()(const f32x4 (&acc)[2][2][4][2], const Unit& u, int wr, int wc, int fr, int fq) const {
        const int row0 = u.pm * BM + wr * 64 + fr;
#pragma unroll
        for (int bj = 0; bj < 2; ++bj) {
            const int g0 = u.pn * BM + bj * HALF; bf16_t* base = (g0 < 1408) ? (PY + g0) : (PX + (g0 - 1408));
            base += wc * 32 + 8 * fq;
#pragma unroll
            for (int ai = 0; ai < 2; ++ai)
#pragma unroll
                for (int m = 0; m < 4; ++m) { const f32x4 v0 = acc[ai][bj][m][0], v1 = acc[ai][bj][m][1];
                    u32x4 w; w.x = cvt_pk_bf16(v0[0], v0[1]); w.y = cvt_pk_bf16(v0[2], v0[3]); w.z = cvt_pk_bf16(v1[0], v1[1]); w.w = cvt_pk_bf16(v1[2], v1[3]);
                    *(u32x4*)(base + (size_t)(row0 + ai * HALF + m * 16) * 1408) = w; } }
    }
};
template <class Epi, class Sched, bool ALIGN_EPI = false, bool SP2 = false>
__device__ __forceinline__ void gemm_phase(PG8_LAS unsigned char* lds, const Gemm g, const Sched& S, const Epi& E, const int tid) {
    const int wid = __builtin_amdgcn_readfirstlane(tid >> 6), lane = tid & 63, wr = wid >> 2, wc = wid & 3, fr = lane & 15, fq = lane >> 4;
    const int K = g.K, nt = K / BK;
    unsigned voffA[2], voffB[2];
#pragma unroll
    for (int i = 0; i < 2; ++i) { int R, C; stage_rc(tid * 16 + i * 8192, R, C); const int Rb = Epi::PERM ? ((R & ~31) + perm32(R & 31)) : R;
        voffA[i] = (unsigned)(R * K + C) * 2u; voffB[i] = (unsigned)(Rb * K + C) * 2u; }
    const size_t kstep = (size_t)(BK * 2);
    const size_t hstep = (size_t)HALF * K * 2;
    const size_t tstep = 2 * hstep;
    const unsigned ldsw = (unsigned)wid * 1024u;
    const int aoff = lds_byte(wr * 64 + fr, fq * 8), boff = lds_byte(wc * 32 + fr, fq * 8);
#define PG8_SA(b, h) (((b) * 2 + (h)) * HTB)
#define PG8_SB(b, h) ((4 + (b) * 2 + (h)) * HTB)
#define PG8_STAGE(bufoff, gbase, voff) do { _Pragma("unroll") for (int _i = 0; _i < 2; ++_i) \
        __builtin_amdgcn_global_load_lds((const unsigned*)((const char*)(gbase) + (voff)[_i]), (PG8_LAS unsigned*)(lds + (bufoff) + ldsw + _i * 8192), 16, 0, 0); } while (0)
#define PG8_LDA(dst, b, h) do { _Pragma("unroll") for (int m = 0; m < 4; ++m) _Pragma("unroll") for (int k = 0; k < 2; ++k) dst[m][k] = *(const PG8_LAS bf16x8*)(lds + PG8_SA(b, h) + aoff + m * 2048 + k * 1024); } while (0)
#define PG8_LDB(dst, b, h) do { _Pragma("unroll") for (int n = 0; n < 2; ++n) _Pragma("unroll") for (int k = 0; k < 2; ++k) dst[n][k] = *(const PG8_LAS bf16x8*)(lds + PG8_SB(b, h) + boff + n * 2048 + k * 1024); } while (0)
#define PG8_MMA(ai, bj, At, Bt) do { __builtin_amdgcn_s_setprio(1); _Pragma("unroll") for (int m = 0; m < 4; ++m) _Pragma("unroll") for (int n = 0; n < 2; ++n) _Pragma("unroll") for (int k = 0; k < 2; ++k) \
        acc[ai][bj][m][n] = __builtin_amdgcn_mfma_f32_16x16x32_bf16(Bt[n][k], At[m][k], acc[ai][bj][m][n], 0, 0, 0); __builtin_amdgcn_s_setprio(0); } while (0)
#define PG8_WAIT_V(n) asm volatile("s_waitcnt vmcnt(" #n ")" ::: "memory")
#define PG8_WAIT_L(n) asm volatile("s_waitcnt lgkmcnt(" #n ")" ::: "memory")
#define PG8_BAR __builtin_amdgcn_s_barrier()
#define PG8_SCHED __builtin_amdgcn_sched_barrier(0)
    Unit cur, nxt; int ui = 0;
    if (!S.next(0, cur)) return;
    f32x4 acc[2][2][4][2];
#pragma unroll
    for (int a = 0; a < 2; ++a)
#pragma unroll
        for (int b = 0; b < 2; ++b)
#pragma unroll
            for (int m = 0; m < 4; ++m)
#pragma unroll
                for (int n = 0; n < 2; ++n) acc[a][b][m][n] = (f32x4){0.f, 0.f, 0.f, 0.f};
    bf16x8 At[4][2], B0[2][2], B1[2][2];
    const char* cA = (const char*)g.A + (size_t)cur.pm * tstep; const char* cB = (const char*)g.Bt + (size_t)cur.pn * tstep;
    S.a_ready(cur);
    if constexpr (SP2) {
        PG8_STAGE(PG8_SB(0, 0), cB, voffB); PG8_STAGE(PG8_SB(0, 1), cB + hstep, voffB); PG8_STAGE(PG8_SA(0, 0), cA, voffA); PG8_STAGE(PG8_SA(0, 1), cA + hstep, voffA);
        if (wr == 1) PG8_BAR;
        PG8_WAIT_V(2); PG8_BAR;
        PG8_STAGE(PG8_SB(1, 0), cB + kstep, voffB); PG8_STAGE(PG8_SA(1, 0), cA + kstep, voffA); PG8_STAGE(PG8_SB(1, 1), cB + hstep + kstep, voffB);
        PG8_WAIT_V(6); PG8_BAR;
    } else {
        PG8_STAGE(PG8_SB(0, 0), cB, voffB); PG8_STAGE(PG8_SA(0, 0), cA, voffA); PG8_STAGE(PG8_SB(0, 1), cB + hstep, voffB); PG8_STAGE(PG8_SA(0, 1), cA + hstep, voffA);
        if (wr == 1) PG8_BAR;
        PG8_WAIT_V(4); PG8_BAR;
        PG8_STAGE(PG8_SB(1, 0), cB + kstep, voffB); PG8_STAGE(PG8_SA(1, 0), cA + kstep, voffA); PG8_STAGE(PG8_SB(1, 1), cB + hstep + kstep, voffB);
        PG8_WAIT_V(6); PG8_BAR;
    }
    for (;;) {
        const bool has_next = S.next(ui + 1, nxt);
        const char* nA = has_next ? (const char*)g.A + (size_t)nxt.pm * tstep : cA; const char* nB = has_next ? (const char*)g.Bt + (size_t)nxt.pn * tstep : cB;
        for (int t = 0; t < nt; t += 2) {
            const bool last = (t == nt - 2);
            const char* a1 = cA + (size_t)(t + 1) * kstep;
            const char* a2 = last ? nA : cA + (size_t)(t + 2) * kstep; const char* b2 = last ? nB : cB + (size_t)(t + 2) * kstep;
            const char* a3 = a2 + kstep; const char* b3 = b2 + kstep;
            if (last && has_next) S.a_ready(nxt);
            if constexpr (SP2) {
            PG8_LDB(B0, 0, 0); PG8_LDB(B1, 0, 1); PG8_SCHED; PG8_LDA(At, 0, 0); PG8_STAGE(PG8_SA(1, 1), a1 + hstep, voffA);
            PG8_WAIT_V(8); PG8_WAIT_L(0); PG8_BAR; PG8_MMA(0, 0, At, B0); PG8_MMA(0, 1, At, B1); PG8_BAR; PG8_SCHED;
            PG8_LDA(At, 0, 1); PG8_STAGE(PG8_SB(0, 0), b2, voffB); PG8_STAGE(PG8_SB(0, 1), b2 + hstep, voffB); PG8_STAGE(PG8_SA(0, 0), a2, voffA);
            PG8_WAIT_V(8); PG8_WAIT_L(0); PG8_BAR; PG8_MMA(1, 0, At, B0); PG8_MMA(1, 1, At, B1); PG8_BAR; PG8_SCHED;
            PG8_LDB(B0, 1, 0); PG8_LDB(B1, 1, 1); PG8_SCHED; PG8_LDA(At, 1, 0); PG8_STAGE(PG8_SA(0, 1), a2 + hstep, voffA);
            PG8_WAIT_V(8); PG8_WAIT_L(0); PG8_BAR; PG8_MMA(0, 0, At, B0); PG8_MMA(0, 1, At, B1); PG8_BAR; PG8_SCHED;
            PG8_LDA(At, 1, 1); PG8_STAGE(PG8_SB(1, 0), b3, voffB); PG8_STAGE(PG8_SB(1, 1), b3 + hstep, voffB); PG8_STAGE(PG8_SA(1, 0), a3, voffA);
            PG8_WAIT_V(8); PG8_WAIT_L(0); PG8_BAR; PG8_MMA(1, 0, At, B0); PG8_MMA(1, 1, At, B1); PG8_BAR; PG8_SCHED;
            } else {
            PG8_LDB(B0, 0, 0); PG8_SCHED; PG8_LDA(At, 0, 0); PG8_STAGE(PG8_SA(1, 1), a1 + hstep, voffA);
            PG8_WAIT_L(8); PG8_BAR; PG8_WAIT_L(0); PG8_MMA(0, 0, At, B0); PG8_BAR; PG8_SCHED;
            PG8_LDB(B1, 0, 1); PG8_STAGE(PG8_SB(0, 0), b2, voffB);
            PG8_BAR; PG8_WAIT_L(0); PG8_MMA(0, 1, At, B1); PG8_BAR;
            PG8_LDA(At, 0, 1); PG8_STAGE(PG8_SA(0, 0), a2, voffA);
            PG8_BAR; PG8_WAIT_L(0); PG8_MMA(1, 0, At, B0); PG8_BAR; PG8_SCHED;
            PG8_STAGE(PG8_SB(0, 1), b2 + hstep, voffB);
            PG8_WAIT_V(6); PG8_BAR; PG8_MMA(1, 1, At, B1); PG8_BAR;
            PG8_LDB(B0, 1, 0); PG8_SCHED; PG8_LDA(At, 1, 0); PG8_STAGE(PG8_SA(0, 1), a2 + hstep, voffA);
            PG8_WAIT_L(8); PG8_BAR; PG8_WAIT_L(0); PG8_MMA(0, 0, At, B0); PG8_BAR; PG8_SCHED;
            PG8_LDB(B1, 1, 1); PG8_STAGE(PG8_SB(1, 0), b3, voffB);
            PG8_BAR; PG8_WAIT_L(0); PG8_MMA(0, 1, At, B1); PG8_BAR;
            PG8_LDA(At, 1, 1); PG8_STAGE(PG8_SA(1, 0), a3, voffA);
            PG8_BAR; PG8_WAIT_L(0); PG8_MMA(1, 0, At, B0); PG8_BAR; PG8_SCHED;
            PG8_STAGE(PG8_SB(1, 1), b3 + hstep, voffB);
            PG8_WAIT_V(6); PG8_BAR; PG8_MMA(1, 1, At, B1); PG8_BAR;
            }
        }
        if constexpr (ALIGN_EPI) { if (wr == 0) PG8_BAR; }
        if constexpr (!Epi::AFTER_DRAIN) { E(acc, cur, wr, wc, fr, fq); S.done(cur); }
        if (!has_next) break;
#pragma unroll
        for (int a = 0; a < 2; ++a)
#pragma unroll
            for (int b = 0; b < 2; ++b)
#pragma unroll
                for (int m = 0; m < 4; ++m)
#pragma unroll
                    for (int n = 0; n < 2; ++n) acc[a][b][m][n] = (f32x4){0.f, 0.f, 0.f, 0.f};
        cur = nxt; cA = nA; cB = nB; ++ui;
        if constexpr (ALIGN_EPI) { if (wr == 1) PG8_BAR; }
    }
    PG8_WAIT_V(0);
    if constexpr (!ALIGN_EPI) { if (wr == 0) PG8_BAR; }
    PG8_BAR;
    if constexpr (Epi::AFTER_DRAIN) { E.fused(acc, cur, wr, wc, fr, fq, lds, wid, lane); S.done(cur); }
#undef PG8_SA
#undef PG8_SB
#undef PG8_STAGE
#undef PG8_LDA
#undef PG8_LDB
#undef PG8_MMA
#undef PG8_WAIT_V
#undef PG8_WAIT_L
#undef PG8_BAR
#undef PG8_SCHED
}
}
#define GAS __attribute__((address_space(1)))
#define LAS __attribute__((address_space(3)))
typedef unsigned short bf16;
typedef unsigned v4u __attribute__((ext_vector_type(4)));
typedef float f32x4 __attribute__((ext_vector_type(4)));
typedef short bf16x8 __attribute__((ext_vector_type(8)));
typedef GAS unsigned gu32;
typedef GAS unsigned long long gu64;
#define RLX_AGENT __ATOMIC_RELAXED, __HIP_MEMORY_SCOPE_AGENT
#define LDS_WAIT() asm volatile("s_waitcnt lgkmcnt(0)" ::: "memory")
#define VM_WAIT() asm volatile("s_waitcnt vmcnt(0)" ::: "memory")
__device__ __forceinline__ unsigned long long rt() { return __builtin_amdgcn_s_memrealtime(); }
__device__ __forceinline__ unsigned f2bf(float f) { unsigned u = __builtin_bit_cast(unsigned, f); return (u + 0x7fffu + ((u >> 16) & 1u)) >> 16; }
__device__ __forceinline__ unsigned pk2(float lo, float hi) { return f2bf(lo) | (f2bf(hi) << 16); }

#define XB_TMO      128
#define XB_XCNT(j)  (256  + 64 * (j))
#define XB_XSUB(j)  (1280 + 64 * (j))
#define XB_XGEN(j)  (2304 + 64 * (j))
#define XB_TOP      3328
#define XB_TOPGEN   3392
#define XCD_BAR_WORDS 3456
#define XB_SPIN_CAP (1u << 18)

__device__ __forceinline__ unsigned xb_ld(unsigned* p)              { return __hip_atomic_load(p, __ATOMIC_RELAXED, __HIP_MEMORY_SCOPE_AGENT); }
__device__ __forceinline__ unsigned xb_add(unsigned* p, unsigned v) { return __hip_atomic_fetch_add(p, v, __ATOMIC_RELAXED, __HIP_MEMORY_SCOPE_AGENT); }
__device__ __forceinline__ unsigned xb_xcc_id() { return (unsigned)__builtin_amdgcn_s_getreg((3 << 11) | 20) & 0xFu; }
#define XB_SPIN(cond, bar) do { unsigned _sp = 0; while (cond) { __builtin_amdgcn_s_sleep(1); \
    if ((++_sp & 255u) == 0u) { if (xb_ld(&(bar)[XB_TMO])) break; if (_sp > XB_SPIN_CAP) { atomicAdd(&(bar)[XB_TMO], 1u); break; } } } } while (0)

struct XcdBarrier {
    unsigned* bar; unsigned x;
    volatile LAS unsigned* st;
};

__device__ __forceinline__ XcdBarrier xcd_barrier_post(unsigned* bar, volatile LAS unsigned* st) {
    XcdBarrier b; b.bar = bar; b.x = xb_xcc_id(); b.st = st;
    if (threadIdx.x == 0) (void)xb_add(&bar[XB_XCNT(b.x)], 1u);
    return b;
}
__device__ __forceinline__ void xcd_barrier_complete(unsigned* bar, unsigned x, unsigned& nloc, unsigned& nx) {
    const unsigned G = gridDim.x * gridDim.y * gridDim.z;
    unsigned sum, cnt, mine, sp = 0u;
    for (;;) {
        sum = 0u; cnt = 0u; mine = 0u;
#pragma unroll
        for (unsigned j = 0; j < 16; ++j) { const unsigned c = xb_ld(&bar[XB_XCNT(j)]); sum += c; cnt += (c > 0u) ? 1u : 0u; mine = (j == x) ? c : mine; }
        if (sum == G) break;
        __builtin_amdgcn_s_sleep(1);
        if ((++sp & 255u) == 0u) { if (xb_ld(&bar[XB_TMO])) break; if (sp > XB_SPIN_CAP) { atomicAdd(&bar[XB_TMO], 1u); break; } }
    }
    nloc = mine > 0u ? mine : 1u; nx = cnt > 0u ? cnt : 1u;
}

__device__ __forceinline__ void xcd_barrier(const XcdBarrier& b) {
    asm volatile("s_waitcnt vmcnt(0)" ::: "memory");
    __syncthreads();
    if (threadIdx.x == 0) {
        unsigned* bar = b.bar;
        __builtin_amdgcn_s_waitcnt(0);
        unsigned nloc = b.st[0], nx = b.st[1];
        if (nloc == 0u) { xcd_barrier_complete(bar, b.x, nloc, nx); b.st[0] = nloc; b.st[1] = nx; }
        const unsigned old = xb_add(&bar[XB_XSUB(b.x)], 1u);
        const unsigned gen = old / nloc;
        if (old + 1u == (gen + 1u) * nloc) {
            __builtin_amdgcn_fence(__ATOMIC_RELEASE, "agent");
            asm volatile("s_waitcnt vmcnt(0)" ::: "memory");
            const unsigned og = xb_add(&bar[XB_TOP], 1u);
            const unsigned tg = og / nx;
            if (og + 1u == (tg + 1u) * nx) xb_add(&bar[XB_TOPGEN], 1u);
            else XB_SPIN(xb_ld(&bar[XB_TOPGEN]) == tg, bar);
            __builtin_amdgcn_fence(__ATOMIC_ACQUIRE, "agent");
            xb_add(&bar[XB_XGEN(b.x)], 1u);
            asm volatile("s_waitcnt vmcnt(0)" ::: "memory");
        } else {
            XB_SPIN(xb_ld(&bar[XB_XGEN(b.x)]) == gen, bar);
            __builtin_amdgcn_fence(__ATOMIC_ACQUIRE, "agent");
            asm volatile("s_waitcnt vmcnt(0)" ::: "memory");
        }
    }
    __syncthreads();
}
constexpr int NWAVES = 8;
constexpr int D = 1024, MH = 16384, NIN = 2816, FF = 4096, RW = 384, NH = 6, PXW = 1408;
constexpr float NORM_EPS = 1e-6f, GN_EPS = 64e-5f, LOG2E = 1.4426950408889634f, LN2 = 0.6931471805599453f;
enum { I_XP = 0, I_XS, I_NMPRE, I_NMPOST, I_NFPRE, I_NFPOST, I_WIN, I_WOUT, I_POOLW, I_POOLS, I_CONV, I_DW0, I_DUP, I_IA0, I_IUP, I_GUP, I_KK, I_KA, I_BRK, I_GNG, I_GNB, I_RELB, I_WFI, I_WFO };
constexpr size_t MiB = 1u << 20;
constexpr size_t WS_CTL = 0, CTL_ZERO_BYTES = 1 * MiB;
constexpr size_t WS_SMALL = 1 * MiB;
constexpr size_t WS_W = 2 * MiB, W_LAYER = 47 * MiB / 2;
constexpr size_t W_IN = 0, W_OUT = 11 * MiB / 2, W_FFI = 15 * MiB / 2, W_FFO = 31 * MiB / 2;
constexpr size_t WS_XN = 51 * MiB, WS_MIX = 83 * MiB, WS_PX = 115 * MiB, WS_PY = 159 * MiB, WS_FREE = 203 * MiB, WS_END = 256 * MiB;
constexpr size_t WS_H = 115 * MiB;
constexpr size_t WS_F1 = 159 * MiB;
constexpr size_t WS_OB = 203 * MiB, WS_LSE = 239 * MiB;
constexpr size_t WS_GP = 159 * MiB, WS_H0T = 183 * MiB, WS_RY = 207 * MiB, WS_Y0 = 231 * MiB, WS_HC = 51 * MiB, WS_DC = 75 * MiB, WS_BON = 76 * MiB;
constexpr int CW_TMO = 0, CW_CODE = 1, CW_BAR = 4096;
constexpr int RING_OFF = 0, RING_BYTES = 139264, LDSCTL_OFF = RING_BYTES, MISC_OFF = LDSCTL_OFF + 320, LDS_BYTES = 147456;
typedef float f32x16 __attribute__((ext_vector_type(16)));
typedef unsigned v2u __attribute__((ext_vector_type(2)));
typedef float f32x2_t __attribute__((ext_vector_type(2))); typedef __bf16 bf16x2_t __attribute__((ext_vector_type(2)));
__device__ __forceinline__ unsigned cvtpk(float lo, float hi) { f32x2_t v = {lo, hi}; bf16x2_t b = __builtin_convertvector(v, bf16x2_t); return __builtin_bit_cast(unsigned, b); }
__device__ __forceinline__ float bf2f(unsigned u) { return __builtin_bit_cast(float, u << 16); }
__device__ __forceinline__ float bflo(unsigned w) { return __builtin_bit_cast(float, w << 16); }
__device__ __forceinline__ float bfhi(unsigned w) { return __builtin_bit_cast(float, w & 0xffff0000u); }
__device__ __forceinline__ f32x16 mfma32(bf16x8 a, bf16x8 b, f32x16 c) { return __builtin_amdgcn_mfma_f32_32x32x16_bf16(a, b, c, 0, 0, 0); }
__device__ __forceinline__ f32x4 mfma16(bf16x8 a, bf16x8 b, f32x4 c) { return __builtin_amdgcn_mfma_f32_16x16x32_bf16(a, b, c, 0, 0, 0); }
__device__ __forceinline__ int crow(int i, int hh) { return (i & 3) + 8 * (i >> 2) + 4 * hh; }
__device__ __forceinline__ bf16x8 pack8(const f32x16& x, int s) {
    v4u p; p.x = cvtpk(x[8 * s], x[8 * s + 1]); p.y = cvtpk(x[8 * s + 2], x[8 * s + 3]); p.z = cvtpk(x[8 * s + 4], x[8 * s + 5]); p.w = cvtpk(x[8 * s + 6], x[8 * s + 7]);
    return __builtin_bit_cast(bf16x8, p);
}
__device__ __forceinline__ float sigmoidf_(float x) { return __builtin_amdgcn_rcpf(1.0f + __builtin_amdgcn_exp2f(-1.4426950408889634f * x)); }
__device__ __forceinline__ float tanhf_(float x) { return 1.0f - 2.0f * __builtin_amdgcn_rcpf(1.0f + __builtin_amdgcn_exp2f(2.8853900817779268f * x)); }
__device__ __forceinline__ float shx(float v, int m, int lane) { return __builtin_bit_cast(float, __builtin_amdgcn_ds_bpermute((lane ^ m) << 2, __builtin_bit_cast(int, v))); }
__device__ __forceinline__ float wave_sum(float v, int lane) {
#pragma unroll
    for (int o = 1; o < 64; o <<= 1) v += shx(v, o, lane);
    return v;
}

struct Frame {
    LAS unsigned char* lds;
    volatile LAS unsigned* MISC;
    gu32* ctl;
    int tid, lane, wave, G, vcu;
    float* out; unsigned char* ws;
};
#define WSP(T, off) ((T*)(F.ws + (off)))
struct Args { const float* in[24]; float* out; unsigned char* ws; int ph_lo, ph_hi, li, pad; };
#define KARG const Args& KA
#define INP(i) (KA.in[i])

__device__ __forceinline__ void transpose_item(const float* W, int ldw, int K, bf16* WT, int n0, int srccol0, int k0, LAS float* scr, int lane) {
#pragma unroll 8
    for (int i = 0; i < 32; ++i) { const int kk = 2 * i + (lane >> 5); scr[kk * 33 + (lane & 31)] = W[(size_t)(k0 + kk) * ldw + srccol0 + (lane & 31)]; }
    LDS_WAIT(); asm volatile("" ::: "memory");
    const int c = lane & 7;
#pragma unroll
    for (int j = 0; j < 4; ++j) { const int n = (lane >> 3) + 8 * j; const LAS float* s = scr + (8 * c) * 33 + n;
        v4u o; o.x = pk2(s[0 * 33], s[1 * 33]); o.y = pk2(s[2 * 33], s[3 * 33]); o.z = pk2(s[4 * 33], s[5 * 33]); o.w = pk2(s[6 * 33], s[7 * 33]);
        *(GAS v4u*)(WT + (size_t)(n0 + n) * K + k0 + 8 * c) = o; }
    LDS_WAIT(); asm volatile("" ::: "memory");
}
__device__ __forceinline__ int win_src(int n) { return n < 256 ? n : (n < 1408 ? 1664 + (n - 256) : (n < 2560 ? 256 + (n - 1408) : 1408 + (n - 2560))); }
constexpr int SM_CWB = 294912, SM_KKB = SM_CWB + 6912, SM_KAB = SM_KKB + 768, SM_BRB = SM_KAB + 768;
__device__ __forceinline__ void phase_weights(KARG, Frame& F) {
    { bf16* sm = WSP(bf16, WS_SMALL); const int gt = F.vcu * 512 + F.tid, NT = F.G * 512;
      for (int i = gt; i < 6912; i += NT) sm[SM_CWB + i] = (bf16)f2bf(KA.in[I_CONV][i]);
      for (int i = gt; i < 768; i += NT) { sm[SM_KKB + i] = (bf16)f2bf(KA.in[I_KK][i]); sm[SM_KAB + i] = (bf16)f2bf(KA.in[I_KA][i]); sm[SM_BRB + i] = (bf16)f2bf(KA.in[I_BRK][i]); } }
    LAS float* scr = (LAS float*)(F.lds + RING_OFF + F.wave * 16384);
    const int gw = F.vcu * NWAVES + F.wave, NGW = F.G * NWAVES;
    constexpr int I_IN = (D / 64) * (NIN / 32), I_OUT = (D / 64) * (D / 32), I_FI = (D / 64) * (FF / 32), I_FO = (FF / 64) * (D / 32), I_G = (128 / 64) * (RW / 32);
    constexpr int I_U = 4 * (RW / 32);
    constexpr int PER_L = I_IN + I_OUT + I_FI + I_FO + I_G + I_U;
    for (int it = gw; it < 2 * PER_L; it += NGW) {
        const int l = it / PER_L; int r = it % PER_L;
        unsigned char* wl = F.ws + WS_W + (size_t)l * W_LAYER;
        if (r < I_IN) { const int nb = r % (NIN / 32), kb = r / (NIN / 32); transpose_item(KA.in[I_WIN] + (size_t)l * D * NIN, NIN, D, (bf16*)(wl + W_IN), 32 * nb, win_src(32 * nb), 64 * kb, scr, F.lane); continue; } r -= I_IN;
        if (r < I_OUT) { const int nb = r % (D / 32), kb = r / (D / 32); transpose_item(KA.in[I_WOUT] + (size_t)l * D * D, D, D, (bf16*)(wl + W_OUT), 32 * nb, 32 * nb, 64 * kb, scr, F.lane); continue; } r -= I_OUT;
        if (r < I_FI) { const int nb = r % (FF / 32), kb = r / (FF / 32); transpose_item(KA.in[I_WFI] + (size_t)l * D * FF, FF, D, (bf16*)(wl + W_FFI), 32 * nb, 32 * nb, 64 * kb, scr, F.lane); continue; } r -= I_FI;
        if (r < I_FO) { const int nb = r % (D / 32), kb = r / (D / 32); transpose_item(KA.in[I_WFO] + (size_t)l * FF * D, D, FF, (bf16*)(wl + W_FFO), 32 * nb, 32 * nb, 64 * kb, scr, F.lane); continue; } r -= I_FO;
        if (r < I_G) { const int nb = r % (RW / 32), kb = r / (RW / 32); transpose_item(KA.in[I_GUP] + (size_t)l * 128 * RW, RW, 128, WSP(bf16, WS_SMALL) + (size_t)l * RW * 128, 32 * nb, 32 * nb, 64 * kb, scr, F.lane); continue; } r -= I_G;
        { const int nb = r % (RW / 32), which = r / (RW / 32), d = which & 1, isI = which >> 1;
          transpose_item(KA.in[isI ? I_IUP : I_DUP] + (size_t)(l * 2 + d) * 64 * RW, RW, 64, WSP(bf16, WS_SMALL) + 98304 * (1 + isI) + (size_t)(l * 2 + d) * RW * 64, 32 * nb, 32 * nb, 0, scr, F.lane); }
    }
}
__device__ __forceinline__ void phase_xn_init(KARG, Frame& F, int hf) {
    const int gw = F.vcu * NWAVES + F.wave, NGW = F.G * NWAVES;
    const float* X = KA.in[hf ? I_XS : I_XP]; const GAS f32x4* gp = (const GAS f32x4*)KA.in[I_NMPRE] + F.lane;
    f32x4 g[4];
#pragma unroll
    for (int j = 0; j < 4; ++j) g[j] = gp[64 * j];
    for (int m = gw; m < MH; m += NGW) {
        const GAS f32x4* xr = (const GAS f32x4*)(X + (size_t)m * D) + F.lane; f32x4 v[4]; float s = 0.f;
#pragma unroll
        for (int j = 0; j < 4; ++j) { v[j] = xr[64 * j]; s += (v[j].x * v[j].x + v[j].y * v[j].y) + (v[j].z * v[j].z + v[j].w * v[j].w); }
        const float rstd = 1.0f / sqrtf(wave_sum(s, F.lane) * (1.f / D) + NORM_EPS);
        GAS v2u* o8 = (GAS v2u*)(WSP(bf16, WS_XN) + (size_t)m * D) + F.lane;
#pragma unroll
        for (int j = 0; j < 4; ++j) { v2u w; w.x = pk2(v[j].x * rstd * g[j].x, v[j].y * rstd * g[j].y); w.y = pk2(v[j].z * rstd * g[j].z, v[j].w * rstd * g[j].w); o8[64 * j] = w; }
    }
}
__device__ __forceinline__ void phase_rowpass(KARG, Frame& F, int hf, const bf16* Fm, const float* base, const float* gpost, const float* gnext) {
    const int gw = F.vcu * NWAVES + F.wave, NGW = F.G * NWAVES;
    f32x4 gp[4], gn[4];
#pragma unroll
    for (int j = 0; j < 4; ++j) { gp[j] = ((const GAS f32x4*)gpost + F.lane)[64 * j]; gn[j] = gnext ? ((const GAS f32x4*)gnext + F.lane)[64 * j] : (f32x4){0.f, 0.f, 0.f, 0.f}; }
    float* out = F.out + (size_t)hf * MH * D;
    for (int m = gw; m < MH; m += NGW) {
        const GAS v2u* fr = (const GAS v2u*)(Fm + (size_t)m * D) + F.lane; const GAS f32x4* xr = (const GAS f32x4*)(base + (size_t)m * D) + F.lane;
        f32x4 f[4], x[4]; float s = 0.f;
#pragma unroll
        for (int j = 0; j < 4; ++j) { const v2u w = fr[64 * j]; x[j] = xr[64 * j]; f[j] = (f32x4){bflo(w.x), bfhi(w.x), bflo(w.y), bfhi(w.y)}; s += (f[j].x * f[j].x + f[j].y * f[j].y) + (f[j].z * f[j].z + f[j].w * f[j].w); }
        const float rstd = 1.0f / sqrtf(wave_sum(s, F.lane) * (1.f / D) + NORM_EPS); float s2 = 0.f;
        GAS f32x4* orow = (GAS f32x4*)(out + (size_t)m * D) + F.lane;
#pragma unroll
        for (int j = 0; j < 4; ++j) { x[j] = x[j] + f[j] * rstd * gp[j]; orow[64 * j] = x[j]; s2 += (x[j].x * x[j].x + x[j].y * x[j].y) + (x[j].z * x[j].z + x[j].w * x[j].w); }
        if (gnext) {
            const float r2 = 1.0f / sqrtf(wave_sum(s2, F.lane) * (1.f / D) + NORM_EPS);
            GAS v2u* o8 = (GAS v2u*)(WSP(bf16, WS_XN) + (size_t)m * D) + F.lane;
#pragma unroll
            for (int j = 0; j < 4; ++j) { v2u w; w.x = pk2(x[j].x * r2 * gn[j].x, x[j].y * r2 * gn[j].y); w.y = pk2(x[j].z * r2 * gn[j].z, x[j].w * r2 * gn[j].w); o8[64 * j] = w; }
        }
    }
}
__device__ __forceinline__ void pool_tile(KARG, Frame& F, int hf, int l, int tile) {
    LAS float* U = (LAS float*)(F.lds + RING_OFF);
    LAS float* Pd = U + 48 * 256;
    const bf16* PY = WSP(bf16, WS_PY); bf16* MIX = WSP(bf16, WS_MIX);
    const int T = hf ? 16384 : 8192; const int r0 = tile * 32; const int sbase = hf ? 0 : (r0 & ~8191); const int t0 = r0 - sbase;
    __syncthreads();
    for (int i = F.tid; i < 48 * 32; i += 512) { const int rr = i >> 5, c8 = (i & 31) * 8; const int t = t0 - 8 + rr;
        if (t >= 0 && t < T) { const v4u w = *(const GAS v4u*)(PY + (size_t)(sbase + t) * PXW + c8); LAS float* u = U + rr * 256 + c8;
            u[0] = bflo(w.x); u[1] = bfhi(w.x); u[2] = bflo(w.y); u[3] = bfhi(w.y); u[4] = bflo(w.z); u[5] = bfhi(w.z); u[6] = bflo(w.w); u[7] = bfhi(w.w); } }
    __syncthreads();
    { const int ch = F.tid & 255, g = ch >> 6, win = 2 << g, hw = win >> 1;
      for (int tt = F.tid >> 8; tt < 32; tt += 2) { const int t = t0 + tt; int lo = t - hw; if (lo < 0) lo = 0; int hi = t + win - hw; if (hi > T) hi = T;
          float s = 0.f; for (int q = lo; q < hi; ++q) s += U[(q - t0 + 8) * 256 + ch];
          Pd[tt * 256 + ch] = s / (float)(hi - lo) - U[(tt + 8) * 256 + ch]; } }
    __syncthreads();
    { const int d = F.tid & 63, g = (F.tid >> 6) & 3, tg = F.tid >> 8;
      const float* pw = KA.in[I_POOLW] + (size_t)l * 4 * 64 * 64 + g * 4096 + d; const float sc = KA.in[I_POOLS][l * 256 + g * 64 + d];
      float acc[16];
#pragma unroll
      for (int i = 0; i < 16; ++i) acc[i] = 0.f;
      for (int c = 0; c < 64; ++c) { const float w = pw[c * 64];
#pragma unroll
          for (int i = 0; i < 16; ++i) acc[i] += Pd[(tg * 16 + i) * 256 + g * 64 + c] * w; }
#pragma unroll
      for (int i = 0; i < 16; ++i) MIX[(size_t)(r0 + tg * 16 + i) * D + g * 64 + d] = (bf16)f2bf(acc[i] * sc); }
}
constexpr int BT_STRIDE = 192;
__device__ __forceinline__ void attn_bias_table(KARG, Frame& F, LAS float* bt) {
    const float* rb = KA.in[I_RELB];
    for (int i = F.tid; i < 18 * BT_STRIDE; i += 512) { const int bh = i / BT_STRIDE, o = i % BT_STRIDE, b = bh / 6, h = bh % 6; const int rel = o - 96; float val = 0.f;
        if (rel >= -64 && rel <= 64) { const int rp = rel * (1 << (2 * b)); int ret = rp > 0 ? 16 : 0; const int n = rp < 0 ? -rp : rp;
            if (n < 8) ret += n; else { const float nf = (float)n; int large = 8 + (int)(logf(nf / 8.0f) / logf(128.0f) * 8.0f); if (large > 15) large = 15; ret += large; }
            val = rb[ret * 6 + h] * LOG2E; }
        bt[i] = val; }
}
__device__ __forceinline__ void attn_unit(Frame& F, int hf, int uidx, const LAS float* btab) {
    const int lane = F.lane, c31 = lane & 31, hh = lane >> 5;
    const int T = hf ? 16384 : 8192, nblk = T >> 6, nseq = hf ? 1 : 2;
    const int qt = uidx & 1; int g = uidx >> 1; const int blk = g % nblk; g /= nblk; const int s = g % nseq; g /= nseq; const int h = g % 6, b = g / 6;
    const int dsh = 2 * b, L = T >> dsh, nbs = L >> 6, r = blk / nbs, n = blk % nbs, row0 = s * 8192 + r;
    const bf16* PY = WSP(bf16, WS_PY);
    bf16x8 idf[2];
#pragma unroll
    for (int p = 0; p < 2; ++p)
#pragma unroll
        for (int e = 0; e < 8; ++e) idf[p][e] = (c31 - 16 * p - 8 * hh == e) ? (short)0x3F80 : (short)0;
    const int qi = 32 * qt + c31; const int qrow = row0 + ((64 * n + qi) << dsh);
    bf16x8 qf[4];
#pragma unroll
    for (int ks = 0; ks < 4; ++ks) qf[ks] = *(const GAS bf16x8*)(PY + (size_t)qrow * PXW + 256 + h * 64 + 8 * hh + 16 * ks);
    f32x16 sacc[5];
#pragma unroll
    for (int k5 = 0; k5 < 5; ++k5) { int kp = 64 * (n - 1) + 32 * (qt + k5) + c31; kp = kp < 0 ? 0 : (kp > L - 1 ? L - 1 : kp);
        const bf16* kptr = PY + (size_t)(row0 + (kp << dsh)) * PXW + 640 + h * 64 + 8 * hh; f32x16 a = {};
#pragma unroll
        for (int ks = 0; ks < 4; ++ks) a = mfma32(*(const GAS bf16x8*)(kptr + 16 * ks), qf[ks], a);
        sacc[k5] = a; }
    const LAS float* bt = btab + (b * 6 + h) * BT_STRIDE + 32 - qi;
    const float SC = 0.125f * LOG2E; float m = -3.0e38f;
#pragma unroll
    for (int k5 = 0; k5 < 5; ++k5)
#pragma unroll
        for (int i = 0; i < 16; ++i) { const int j = 32 * (qt + k5) + crow(i, hh); const int rel = j - 64 - qi, kp = 64 * (n - 1) + j;
            const bool valid = (rel >= -64) && (rel <= 64) && (kp >= 0) && (kp < L);
            float t = sacc[k5][i] * SC + bt[j]; t = valid ? t : -1.0e30f; sacc[k5][i] = t; m = fmaxf(m, t); }
    m = fmaxf(m, shx(m, 32, lane)); float lsum = 0.f;
#pragma unroll
    for (int k5 = 0; k5 < 5; ++k5)
#pragma unroll
        for (int i = 0; i < 16; ++i) { const float p = __builtin_amdgcn_exp2f(sacc[k5][i] - m); sacc[k5][i] = p; lsum += p; }
    lsum += shx(lsum, 32, lane); const float inv = 1.0f / lsum;
    f32x16 o[2] = {};
#pragma unroll
    for (int k5 = 0; k5 < 5; ++k5) { int kp = 64 * (n - 1) + 32 * (qt + k5) + c31; kp = kp < 0 ? 0 : (kp > L - 1 ? L - 1 : kp);
        const bf16* vptr = PY + (size_t)(row0 + (kp << dsh)) * PXW + 1024 + h * 64 + 8 * hh; bf16x8 vf[4];
#pragma unroll
        for (int ks = 0; ks < 4; ++ks) vf[ks] = *(const GAS bf16x8*)(vptr + 16 * ks);
#pragma unroll
        for (int i = 0; i < 16; ++i) sacc[k5][i] *= inv;
#pragma unroll
        for (int dt = 0; dt < 2; ++dt) { f32x16 vt = {}; vt = mfma32(vf[2 * dt], idf[0], vt); vt = mfma32(vf[2 * dt + 1], idf[1], vt);
#pragma unroll
            for (int s2 = 0; s2 < 2; ++s2) o[dt] = mfma32(pack8(sacc[k5], s2), pack8(vt, s2), o[dt]); } }
    bf16* OB = WSP(bf16, WS_OB) + (size_t)b * MH * RW; float* LSE = WSP(float, WS_LSE) + (size_t)b * MH * NH;
#pragma unroll
    for (int dt = 0; dt < 2; ++dt)
#pragma unroll
        for (int i = 0; i < 16; ++i) { const int orow = row0 + ((64 * n + 32 * qt + crow(i, hh)) << dsh); OB[(size_t)orow * RW + h * 64 + 32 * dt + c31] = (bf16)f2bf(o[dt][i]); }
    if (hh == 0) LSE[(size_t)qrow * NH + h] = (m + log2f(lsum)) * LN2;
}
__device__ __forceinline__ void phase_pool_attn(KARG, Frame& F, int hf, int l) {
    for (int t = F.vcu; t < MH / 32; t += F.G) pool_tile(KA, F, hf, l, t);
    __syncthreads();
    LAS float* bt = (LAS float*)(F.lds + RING_OFF);
    attn_bias_table(KA, F, bt);
    __syncthreads();
    const int gw = F.vcu * NWAVES + F.wave, NGW = F.G * NWAVES;
    for (int u = gw; u < 9216; u += NGW) attn_unit(F, hf, u, bt);
}
__device__ __forceinline__ void phase_attn_merge(Frame& F) {
    const bf16* OB = WSP(bf16, WS_OB); const float* LSE = WSP(float, WS_LSE); bf16* MIX = WSP(bf16, WS_MIX);
    const int gt = F.vcu * 512 + F.tid, NT = F.G * 512;
    for (int it = gt; it < MH * 48; it += NT) { const int row = it / 48, cg = it % 48, h = cg >> 3;
        float ls[3], mx = -3.0e38f;
#pragma unroll
        for (int b = 0; b < 3; ++b) { ls[b] = LSE[((size_t)b * MH + row) * NH + h]; mx = fmaxf(mx, ls[b]); }
        float al[3], sum = 0.f;
#pragma unroll
        for (int b = 0; b < 3; ++b) { al[b] = __expf(ls[b] - mx); sum += al[b]; }
        const float inv = 1.0f / sum; float acc[8];
#pragma unroll
        for (int e = 0; e < 8; ++e) acc[e] = 0.f;
#pragma unroll
        for (int b = 0; b < 3; ++b) { const v4u w = *(const GAS v4u*)(OB + ((size_t)b * MH + row) * RW + cg * 8); const float a = al[b] * inv;
            acc[0] += a * bflo(w.x); acc[1] += a * bfhi(w.x); acc[2] += a * bflo(w.y); acc[3] += a * bfhi(w.y); acc[4] += a * bflo(w.z); acc[5] += a * bfhi(w.z); acc[6] += a * bflo(w.w); acc[7] += a * bfhi(w.w); }
        v4u o; o.x = pk2(acc[0], acc[1]); o.y = pk2(acc[2], acc[3]); o.z = pk2(acc[4], acc[5]); o.w = pk2(acc[6], acc[7]);
        *(GAS v4u*)(MIX + (size_t)row * D + 640 + cg * 8) = o; }
}
constexpr int LB = 72;
constexpr int LS = 40;
constexpr int LF = 65;
constexpr int MATB = 64 * LB * 2;
template <int KS, bool SWA = false, bool SWB = false> __device__ __forceinline__ f32x4 mm16(const LAS bf16* A, int lda, const LAS bf16* BT, int ldb, int mi, int nj, int lane, f32x4 acc) {
    const int ra = 16 * mi + (lane & 15), rb = 16 * nj + (lane & 15), ch = lane >> 4;
    const LAS bf16* ap = A + ra * lda; const LAS bf16* bp = BT + rb * ldb;
#pragma unroll
    for (int ks = 0; ks < KS; ++ks) { const int ca = SWA ? ((ch + 4 * ks) ^ ((ra >> 3) & 7)) : (ch + 4 * ks), cb = SWB ? ((ch + 4 * ks) ^ ((rb >> 3) & 7)) : (ch + 4 * ks);
        acc = mfma16(*(const LAS bf16x8*)(ap + 8 * ca), *(const LAS bf16x8*)(bp + 8 * cb), acc); }
    return acc;
}
template <int N, int S, int J> __device__ __forceinline__ void rl_fma(float& acc, const float (&Tr)[32], const float (&vL)[32]) {
    if constexpr (N == 4) { unsigned t0, t1, t2, t3;
        asm volatile("v_readlane_b32 %1, %5, %13\n\tv_readlane_b32 %2, %6, %13\n\tv_readlane_b32 %3, %7, %13\n\tv_readlane_b32 %4, %8, %13\n\tv_fmac_f32 %0, %1, %9\n\tv_fmac_f32 %0, %2, %10\n\tv_fmac_f32 %0, %3, %11\n\tv_fmac_f32 %0, %4, %12"
                     : "+v"(acc), "=&s"(t0), "=&s"(t1), "=&s"(t2), "=&s"(t3) : "v"(vL[S]), "v"(vL[S + 1]), "v"(vL[S + 2]), "v"(vL[S + 3]), "v"(Tr[S]), "v"(Tr[S + 1]), "v"(Tr[S + 2]), "v"(Tr[S + 3]), "n"(J)); }
    else if constexpr (N == 3) { unsigned t0, t1, t2;
        asm volatile("v_readlane_b32 %1, %4, %10\n\tv_readlane_b32 %2, %5, %10\n\tv_readlane_b32 %3, %6, %10\n\tv_fmac_f32 %0, %1, %7\n\tv_fmac_f32 %0, %2, %8\n\tv_fmac_f32 %0, %3, %9"
                     : "+v"(acc), "=&s"(t0), "=&s"(t1), "=&s"(t2) : "v"(vL[S]), "v"(vL[S + 1]), "v"(vL[S + 2]), "v"(Tr[S]), "v"(Tr[S + 1]), "v"(Tr[S + 2]), "n"(J)); }
    else if constexpr (N == 2) { unsigned t0, t1;
        asm volatile("v_readlane_b32 %1, %3, %7\n\tv_readlane_b32 %2, %4, %7\n\ts_nop 0\n\tv_fmac_f32 %0, %1, %5\n\tv_fmac_f32 %0, %2, %6"
                     : "+v"(acc), "=&s"(t0), "=&s"(t1) : "v"(vL[S]), "v"(vL[S + 1]), "v"(Tr[S]), "v"(Tr[S + 1]), "n"(J)); }
    else if constexpr (N == 1) { unsigned t0;
        asm volatile("v_readlane_b32 %1, %2, %4\n\ts_nop 1\n\tv_fmac_f32 %0, %1, %3" : "+v"(acc), "=&s"(t0) : "v"(vL[S]), "v"(Tr[S]), "n"(J)); }
}
template <int S, int J> __device__ __forceinline__ void rl_fma_all(float& acc, const float (&Tr)[32], const float (&vL)[32]) {
    constexpr int REM = 32 - S;
    if constexpr (REM >= 4) { rl_fma<4, S, J>(acc, Tr, vL); rl_fma_all<S + 4, J>(acc, Tr, vL); }
    else if constexpr (REM > 0) { rl_fma<REM, S, J>(acc, Tr, vL); }
}
template <int J> struct SolveStep {
    static __device__ __forceinline__ void run(float (&Tr)[32], const float (&vL)[32], int r_) {
        float acc = (J == r_) ? 1.f : 0.f;
        rl_fma_all<J + 1, J>(acc, Tr, vL);
        Tr[J] = (J <= r_) ? acc : 0.f;
        SolveStep<J - 1>::run(Tr, vL, r_);
    }
};
template <> struct SolveStep<-1> { static __device__ __forceinline__ void run(float (&)[32], const float (&)[32], int) {} };
__device__ __forceinline__ v2u pk4(const f32x4 v) { v2u o; o.x = cvtpk(v[0], v[1]); o.y = cvtpk(v[2], v[3]); return o; }
__device__ __forceinline__ void passA_unit(KARG, Frame& F, int hf, int l, int unit) {
    int tid = F.tid; asm volatile("" : "+v"(tid)); int t = tid >> 3, cg = tid & 7, c0 = cg * 8;
    const int ci = unit / 6, h = unit % 6; const int rr0 = ci * 64; const int T = hf ? 16384 : 8192; const int sbase = hf ? 0 : (rr0 & ~8191);
    int tl = rr0 - sbase + t;
    const bf16* PX = WSP(bf16, WS_PX);
    LAS unsigned char* L0 = F.lds + RING_OFF;
#define MAT(i) ((LAS bf16*)(L0 + (i) * MATB))
    LAS bf16* mAt = MAT(0); LAS bf16* mBt = MAT(1); LAS bf16* mKt = MAT(2); LAS bf16* mRt = MAT(3); LAS bf16* mAtT = MAT(4); LAS bf16* mBtT = MAT(5); LAS bf16* mKtT = MAT(6); LAS bf16* mVT = MAT(7);
    LAS bf16* mLak = MAT(8); LAS bf16* mLrb = MAT(9); LAS bf16* mLrk = MAT(10); LAS bf16* mT = MAT(11); LAS bf16* mX1T = MAT(12); LAS bf16* mWT = MAT(13); LAS bf16* mU0T = MAT(8);
    LAS float* fC = (LAS float*)(L0 + 8 * MATB);
    LAS bf16* sLogd = (LAS bf16*)(L0 + 8 * MATB + 16640);
    LAS bf16* sIcl = sLogd + 64 * LB;
    LAS bf16* mActW = MAT(12); LAS bf16* mActA = MAT(13);
    LAS float* sLs = (LAS float*)(L0 + 12 * MATB);
    LAS bf16* sL21 = (LAS bf16*)(L0 + 12 * MATB + 8448);
    LAS bf16* sT11T = sL21 + 32 * LS;
    LAS bf16* sQT = sT11T + 32 * LS;
    LAS float* sDC = (LAS float*)(L0 + 14 * MATB);
    float bonus = 0.f;
    for (int d = 0; d < 2; ++d) {
        asm volatile("" : "+v"(tid)); t = tid >> 3; cg = tid & 7; c0 = cg * 8; tl = rr0 - sbase + t;
        const int lane = tid & 63, wave = __builtin_amdgcn_readfirstlane(tid >> 6);
        const int tau = d ? 63 - t : t; const size_t inst = ((size_t)ci * 6 + h) * 2 + d;
    float cr[8], ck[8], cv[8];
    { const float* cw = KA.in[I_CONV] + (size_t)l * 3 * 1152;
#pragma unroll
      for (int e = 0; e < 8; ++e) { cr[e] = 0.f; ck[e] = 0.f; cv[e] = 0.f; }
#pragma unroll
      for (int tap = 0; tap < 3; ++tap) { const int tq = tl + tap - 1; if (tq >= 0 && tq < T) { const bf16* row = PX + (size_t)(sbase + tq) * PXW + h * 64 + c0;
          const v4u wr_ = *(const GAS v4u*)(row), wk_ = *(const GAS v4u*)(row + 384), wv_ = *(const GAS v4u*)(row + 768); const float* w = cw + tap * 1152 + h * 64 + c0;
          const unsigned ur[4] = {wr_.x, wr_.y, wr_.z, wr_.w}, uk[4] = {wk_.x, wk_.y, wk_.z, wk_.w}, uv[4] = {wv_.x, wv_.y, wv_.z, wv_.w};
#pragma unroll
          for (int e = 0; e < 8; ++e) { const float xr = (e & 1) ? bfhi(ur[e >> 1]) : bflo(ur[e >> 1]), xk = (e & 1) ? bfhi(uk[e >> 1]) : bflo(uk[e >> 1]), xv = (e & 1) ? bfhi(uv[e >> 1]) : bflo(uv[e >> 1]);
              cr[e] += xr * w[e]; ck[e] += xk * w[384 + e]; cv[e] += xv * w[768 + e]; } } } }
    float kkv[8];
    { float ss = 0.f; const float* kkw = KA.in[I_KK] + l * RW + h * 64 + c0;
#pragma unroll
      for (int e = 0; e < 8; ++e) { kkv[e] = ck[e] * kkw[e]; ss += kkv[e] * kkv[e]; }
      ss += shx(ss, 1, lane); ss += shx(ss, 2, lane); ss += shx(ss, 4, lane);
      const float inv = 1.0f / fmaxf(sqrtf(ss), 1e-12f);
#pragma unroll
      for (int e = 0; e < 8; ++e) kkv[e] *= inv; }
        __syncthreads();
        { const bf16* row = PX + (size_t)(rr0 + t) * PXW + 1152 + c0; const v4u ww = *(const GAS v4u*)(row), wa = *(const GAS v4u*)(row + 64);
          v4u o; o.x = pk2(tanhf_(bflo(ww.x)), tanhf_(bfhi(ww.x))); o.y = pk2(tanhf_(bflo(ww.y)), tanhf_(bfhi(ww.y))); o.z = pk2(tanhf_(bflo(ww.z)), tanhf_(bfhi(ww.z))); o.w = pk2(tanhf_(bflo(ww.w)), tanhf_(bfhi(ww.w)));
          *(LAS v4u*)(mActW + tau * LB + c0) = o; *(LAS v4u*)(mActA + tau * LB + c0) = wa; }
        __syncthreads();
        { const int prod = wave >> 2, nj = wave & 3, cl = lane & 15, ql = lane >> 4; const int c = 16 * nj + cl;
          const bf16* UT = WSP(bf16, WS_SMALL) + 98304 * (1 + prod) + (size_t)(l * 2 + d) * RW * 64 + (size_t)(h * 64 + c) * 64 + 8 * ql;
          const bf16x8 b0 = *(const GAS bf16x8*)(UT), b1 = *(const GAS bf16x8*)(UT + 32);
          const float bias = KA.in[prod ? I_IA0 : I_DW0][(size_t)(l * 2 + d) * RW + h * 64 + c];
          f32x4 v[4];
#pragma unroll
          for (int mi = 0; mi < 4; ++mi) { const LAS bf16* ap = (prod ? mActA : mActW) + (16 * mi + cl) * LB + 8 * ql; f32x4 a = {bias, bias, bias, bias};
              a = mfma16(*(const LAS bf16x8*)(ap), b0, a); a = mfma16(*(const LAS bf16x8*)(ap + 32), b1, a); v[mi] = a; }
          if (prod) {
#pragma unroll
              for (int mi = 0; mi < 4; ++mi)
#pragma unroll
                  for (int e = 0; e < 4; ++e) sIcl[(16 * mi + 4 * ql + e) * LB + c] = (bf16)f2bf(sigmoidf_(v[mi][e]));
          } else { float base = 0.f;
#pragma unroll
              for (int mi = 0; mi < 4; ++mi) { float ld_[4], p[4];
#pragma unroll
                  for (int e = 0; e < 4; ++e) { ld_[e] = -0.6065306597126334f * sigmoidf_(v[mi][e]); p[e] = ld_[e] + (e ? p[e - 1] : 0.f); }
                  const float g0 = shx(p[3], 0, cl), g1 = shx(p[3], 0, cl + 16), g2 = shx(p[3], 0, cl + 32), g3 = shx(p[3], 0, cl + 48);
                  const float off = base + (ql > 0 ? g0 : 0.f) + (ql > 1 ? g1 : 0.f) + (ql > 2 ? g2 : 0.f); base += (g0 + g1) + (g2 + g3);
#pragma unroll
                  for (int e = 0; e < 4; ++e) { fC[(16 * mi + 4 * ql + e) * LF + c] = off + p[e]; sLogd[(16 * mi + 4 * ql + e) * LB + c] = (bf16)f2bf(ld_[e]); } } } }
        __syncthreads();
        float logd[8], ic[8];
        { const v4u wl_ = *(const LAS v4u*)(sLogd + tau * LB + c0), wi_ = *(const LAS v4u*)(sIcl + tau * LB + c0);
          logd[0] = bflo(wl_.x); logd[1] = bfhi(wl_.x); logd[2] = bflo(wl_.y); logd[3] = bfhi(wl_.y); logd[4] = bflo(wl_.z); logd[5] = bfhi(wl_.z); logd[6] = bflo(wl_.w); logd[7] = bfhi(wl_.w);
          ic[0] = bflo(wi_.x); ic[1] = bfhi(wi_.x); ic[2] = bflo(wi_.y); ic[3] = bfhi(wi_.y); ic[4] = bflo(wi_.z); ic[5] = bfhi(wi_.z); ic[6] = bflo(wi_.w); ic[7] = bfhi(wi_.w); }
        { const float* ka = KA.in[I_KA] + l * RW + h * 64 + c0; const float* brk = KA.in[I_BRK] + l * RW + h * 64 + c0;
          float at[8], bt_[8], kt[8], rt[8]; float bs = 0.f;
#pragma unroll
          for (int e = 0; e < 8; ++e) { const float cum = fC[tau * LF + c0 + e], cumx = cum - logd[e]; const float keff = ck[e] * (1.0f + (ic[e] - 1.0f) * ka[e]);
              bs += cr[e] * keff * brk[e];
              const float en = __expf(-cum);
              at[e] = -kkv[e] * __expf(cumx); bt_[e] = kkv[e] * ic[e] * en; kt[e] = keff * en; rt[e] = cr[e] * __expf(cum); }
          bs += shx(bs, 1, lane); bs += shx(bs, 2, lane); bs += shx(bs, 4, lane); bonus += bs;
          v4u o;
          o.x = pk2(at[0], at[1]); o.y = pk2(at[2], at[3]); o.z = pk2(at[4], at[5]); o.w = pk2(at[6], at[7]); *(LAS v4u*)(mAt + tau * LB + c0) = o;
          o.x = pk2(bt_[0], bt_[1]); o.y = pk2(bt_[2], bt_[3]); o.z = pk2(bt_[4], bt_[5]); o.w = pk2(bt_[6], bt_[7]); *(LAS v4u*)(mBt + tau * LB + c0) = o;
          o.x = pk2(kt[0], kt[1]); o.y = pk2(kt[2], kt[3]); o.z = pk2(kt[4], kt[5]); o.w = pk2(kt[6], kt[7]); *(LAS v4u*)(mKt + tau * LB + c0) = o;
          o.x = pk2(rt[0], rt[1]); o.y = pk2(rt[2], rt[3]); o.z = pk2(rt[4], rt[5]); o.w = pk2(rt[6], rt[7]); *(LAS v4u*)(mRt + tau * LB + c0) = o;
          { const int tsw = tau ^ (cg << 3);
#pragma unroll
          for (int e = 0; e < 8; ++e) { mAtT[(c0 + e) * LB + tsw] = (bf16)f2bf(at[e]); mBtT[(c0 + e) * LB + tsw] = (bf16)f2bf(bt_[e]); mKtT[(c0 + e) * LB + tsw] = (bf16)f2bf(kt[e]); mVT[(c0 + e) * LB + tsw] = (bf16)f2bf(cv[e]); } }
          if (t == 0) {
#pragma unroll
              for (int e = 0; e < 8; ++e) { const float dc = __expf(fC[63 * LF + c0 + e]); const int k_ = c0 + e; sDC[k_] = dc; WSP(float, WS_DC)[inst * 64 + 16 * ((k_ >> 2) & 3) + 4 * (k_ >> 4) + (k_ & 3)] = dc; } } }
        __syncthreads();
        int lnv = lane, cc, qq;
#define FRESH_LANE() do { asm volatile("" : "+v"(lnv)); cc = lnv & 15; qq = lnv >> 4; } while (0)
        FRESH_LANE();
        PA_REPEAT(1) {
        for (int tt = wave; tt < 64; tt += 8) { const int prod = tt >> 4, mi = (tt >> 2) & 3, nj = tt & 3; const f32x4 z = {0.f, 0.f, 0.f, 0.f};
            if (prod == 0) { const f32x4 a = mm16<2>(mAt, LB, mBt, LB, mi, nj, lnv, z);
                const int sg = 16 * nj + cc; const int blk = mi >> 1;
                if ((mi >> 1) == (nj >> 1)) {
#pragma unroll
                    for (int e = 0; e < 4; ++e) { const int ta = 16 * mi + 4 * qq + e; sLs[blk * 32 * 33 + (ta & 31) * 33 + (sg & 31)] = (sg < ta) ? a[e] : 0.f; } }
                else if (mi >= 2) {
#pragma unroll
                    for (int e = 0; e < 4; ++e) { const int ta = 16 * mi + 4 * qq + e; sL21[(ta - 32) * LS + sg] = (bf16)f2bf(a[e]); } } }
            else { const LAS bf16* Am = (prod == 2) ? mBt : mKt; const LAS bf16* Bm = (prod == 1) ? mAt : mRt; LAS bf16* Om = (prod == 1) ? mLak : (prod == 2 ? mLrb : mLrk);
                f32x4 a = mm16<2>(Am, LB, Bm, LB, mi, nj, lnv, z);
                const int ta = 16 * nj + cc;
#pragma unroll
                for (int e = 0; e < 4; ++e) { const int sg = 16 * mi + 4 * qq + e; const bool keep = (prod == 1) ? (sg < ta) : (sg <= ta); a[e] = keep ? a[e] : 0.f; }
                *(LAS v2u*)(Om + ta * LB + 16 * mi + 4 * qq) = pk4(a); } }
        __syncthreads();
        }
        PA_REPEAT(2) {
        FRESH_LANE();
        if (wave < 2) { const int blk = wave, r_ = lnv & 31; const LAS float* Lb = sLs + blk * 32 * 33; float Tr[32], vL[32];
#pragma unroll
            for (int s = 0; s < 32; ++s) vL[s] = Lb[s * 33 + r_];
            SolveStep<31>::run(Tr, vL, r_);
            if (lnv < 32) {
            LAS bf16* trow = mT + (32 * blk + r_) * LB + 32 * blk; LAS bf16* zrow = mT + r_ * LB + 32;
#pragma unroll
            for (int g = 0; g < 4; ++g) { v4u o; o.x = pk2(Tr[8 * g], Tr[8 * g + 1]); o.y = pk2(Tr[8 * g + 2], Tr[8 * g + 3]); o.z = pk2(Tr[8 * g + 4], Tr[8 * g + 5]); o.w = pk2(Tr[8 * g + 6], Tr[8 * g + 7]);
                *(LAS v4u*)(trow + 8 * g) = o; if (blk == 0) *(LAS v4u*)(zrow + 8 * g) = (v4u){0u, 0u, 0u, 0u}; }
            if (blk == 0) {
#pragma unroll
                for (int j = 0; j < 32; ++j) sT11T[j * LS + r_] = (bf16)f2bf(Tr[j]); } } }
        __syncthreads();
        }
        PA_REPEAT(3) {
        FRESH_LANE();
        if (wave < 4) { const int mi = wave >> 1, nj = wave & 1; const f32x4 a = mm16<1>(sL21, LS, sT11T, LS, mi, nj, lnv, (f32x4){0.f, 0.f, 0.f, 0.f});
            *(LAS v2u*)(sQT + (16 * nj + cc) * LS + 16 * mi + 4 * qq) = pk4(a); }
        __syncthreads();
        }
        PA_REPEAT(3) {
        FRESH_LANE();
        if (wave < 4) { const int mi = wave >> 1, nj = wave & 1; const f32x4 a = mm16<1>(mT + 32 * LB + 32, LB, sQT, LS, mi, nj, lnv, (f32x4){0.f, 0.f, 0.f, 0.f});
#pragma unroll
            for (int e = 0; e < 4; ++e) mT[(32 + 16 * mi + 4 * qq + e) * LB + 16 * nj + cc] = (bf16)f2bf(a[e]); }
        __syncthreads();
        }
        PA_REPEAT(4) {
        FRESH_LANE();
        for (int tt = wave; tt < 32; tt += 8) { const int prod = tt >> 4, mi = (tt >> 2) & 3, nj = tt & 3; const f32x4 z = {0.f, 0.f, 0.f, 0.f};
            const f32x4 a = prod ? mm16<2, false, true>(mT, LB, mAtT, LB, mi, nj, lnv, z) : mm16<2, false, true>(mLak, LB, mVT, LB, mi, nj, lnv, z);
            *(LAS v2u*)((prod ? mWT : mX1T) + (16 * nj + cc) * LB + 16 * mi + 4 * qq) = pk4(a); }
        __syncthreads();
        }
        PA_REPEAT(5) {
        FRESH_LANE();
        for (int tt = wave; tt < 16; tt += 8) { const int mi = tt >> 2, nj = tt & 3; const f32x4 a = mm16<2>(mT, LB, mX1T, LB, mi, nj, lnv, (f32x4){0.f, 0.f, 0.f, 0.f});
            *(LAS v2u*)(mU0T + (16 * nj + cc) * LB + 16 * mi + 4 * qq) = pk4(a); }
        __syncthreads();
        }
        PA_REPEAT(6) {
        FRESH_LANE();
        for (int tt = wave; tt < 64; tt += 8) { const int prod = tt >> 4, mi = (tt >> 2) & 3, nj = tt & 3; const int r4 = 16 * mi + 4 * qq, cn = 16 * nj + cc;
            if (prod == 0) {
                const v2u rv = *(const LAS v2u*)(mRt + cn * LB + r4); f32x4 a = {bflo(rv.x), bfhi(rv.x), bflo(rv.y), bfhi(rv.y)};
                a = mm16<2>(mWT, LB, mLrb, LB, mi, nj, lnv, a); const int treal = d ? 63 - cn : cn;
                *(GAS v2u*)(WSP(bf16, WS_RY) + inst * 4096 + treal * 64 + r4) = pk4(a); }
            else if (prod == 1) {
                f32x4 a = mm16<2>(mU0T, LB, mLrb, LB, mi, nj, lnv, (f32x4){0.f, 0.f, 0.f, 0.f}); a = mm16<2, true, false>(mVT, LB, mLrk, LB, mi, nj, lnv, a); const int treal = d ? 63 - cn : cn;
                *(GAS v2u*)(WSP(bf16, WS_Y0) + inst * 4096 + treal * 64 + r4) = pk4(a); }
            else if (prod == 2) {
                f32x4 a = mm16<2, false, true>(mWT, LB, mBtT, LB, mi, nj, lnv, (f32x4){0.f, 0.f, 0.f, 0.f}); const float dc = sDC[cn];
#pragma unroll
                for (int e = 0; e < 4; ++e) a[e] *= dc;
                *(GAS v2u*)(WSP(bf16, WS_GP) + inst * 4096 + cn * 64 + (r4 & 32) + 8 * qq + 4 * (mi & 1)) = pk4(a); }
            else {
                f32x4 a = mm16<2, true, false>(mBtT, LB, mU0T, LB, mi, nj, lnv, (f32x4){0.f, 0.f, 0.f, 0.f}); a = mm16<2, true, true>(mKtT, LB, mVT, LB, mi, nj, lnv, a);
#pragma unroll
                for (int e = 0; e < 4; ++e) a[e] *= sDC[r4 + e];
                *(GAS v2u*)(WSP(bf16, WS_H0T) + inst * 4096 + cn * 64 + 16 * qq + 4 * mi) = pk4(a); } }
        __syncthreads();
        }
    }
#undef MAT
#undef FRESH_LANE
    if (cg == 0) WSP(float, WS_BON)[(size_t)unit * 64 + t] = bonus;
}
__device__ __forceinline__ void phase_passA(KARG, Frame& F, int hf, int l) {
    for (int u = F.vcu; u < (MH / 64) * 6; u += F.G) passA_unit(KA, F, hf, l, u);
}
typedef v4u frag;
constexpr int PA3_WAVE_LDS = 34048;
__device__ __forceinline__ frag pack8u(const f32x16& x, int s) { frag p; p.x = cvtpk(x[8 * s], x[8 * s + 1]); p.y = cvtpk(x[8 * s + 2], x[8 * s + 3]); p.z = cvtpk(x[8 * s + 4], x[8 * s + 5]); p.w = cvtpk(x[8 * s + 6], x[8 * s + 7]); return p; }
__device__ __forceinline__ f32x16 mf(frag a, frag b, f32x16 c) { return __builtin_amdgcn_mfma_f32_32x32x16_bf16(__builtin_bit_cast(bf16x8, a), __builtin_bit_cast(bf16x8, b), c, 0, 0, 0); }
__device__ __forceinline__ int krow_(int s, int hh, int e) { return 16 * s + 8 * (e >> 2) + 4 * hh + (e & 3); }
__device__ __forceinline__ frag cfrag(int s, int hh, int c31, int mode) {
    unsigned w[4];
#pragma unroll
    for (int p = 0; p < 4; ++p) { const int k0 = krow_(s, hh, 2 * p), k1 = krow_(s, hh, 2 * p + 1);
        const bool b0 = mode == 0 ? (k0 == c31) : (mode == 1 ? (k0 <= c31) : (k0 < c31)), b1 = mode == 0 ? (k1 == c31) : (mode == 1 ? (k1 <= c31) : (k1 < c31));
        w[p] = (b0 ? 0x3F80u : 0u) | (b1 ? 0x3F800000u : 0u); }
    return (frag){w[0], w[1], w[2], w[3]};
}
__device__ __forceinline__ void park8(LAS unsigned char* slot, int lane, const frag (&f)[8]) {
#pragma unroll
    for (int i = 0; i < 8; ++i) *(LAS v4u*)(slot + i * 1024 + lane * 16) = f[i];
}
__device__ __forceinline__ void unpark8(const LAS unsigned char* slot, int lane, frag (&f)[8]) {
#pragma unroll
    for (int i = 0; i < 8; ++i) f[i] = *(const LAS v4u*)(slot + i * 1024 + lane * 16);
}
__device__ __forceinline__ f32x16 conv_tl(const bf16* PX, const bf16* cw, int colbase, int rowc, int tlc, int T, int hh) {
    f32x16 o = {};
#pragma unroll
    for (int tap = 0; tap < 3; ++tap) { const int tq = tlc + tap - 1; const bool ok = (tq >= 0) && (tq < T); const bf16* rp = PX + (size_t)(rowc + (ok ? tap - 1 : 0)) * PXW + colbase + 4 * hh;
#pragma unroll
        for (int g = 0; g < 4; ++g) { const v2u w = *(const GAS v2u*)(rp + 8 * g); const v2u cq = *(const GAS v2u*)(cw + tap * 1152 + colbase + 4 * hh + 8 * g); const f32x4 cv = {bflo(cq.x), bfhi(cq.x), bflo(cq.y), bfhi(cq.y)};
            const float m = ok ? 1.f : 0.f;
            o[4 * g] += m * bflo(w.x) * cv[0]; o[4 * g + 1] += m * bfhi(w.x) * cv[1]; o[4 * g + 2] += m * bflo(w.y) * cv[2]; o[4 * g + 3] += m * bfhi(w.y) * cv[3]; } }
    return o;
}
__device__ __forceinline__ f32x4 conv_tl4(const bf16* PX, const bf16* cw, int colbase, int rowc, int tlc, int T, int hh, int g) {
    f32x4 o = {0.f, 0.f, 0.f, 0.f};
#pragma unroll
    for (int tap = 0; tap < 3; ++tap) { const int tq = tlc + tap - 1; const bool ok = (tq >= 0) && (tq < T); const bf16* rp = PX + (size_t)(rowc + (ok ? tap - 1 : 0)) * PXW + colbase + 4 * hh + 8 * g;
        const v2u w = *(const GAS v2u*)(rp); const v2u cq = *(const GAS v2u*)(cw + tap * 1152 + colbase + 4 * hh + 8 * g); const f32x4 cv = {bflo(cq.x), bfhi(cq.x), bflo(cq.y), bfhi(cq.y)}; const float m = ok ? 1.f : 0.f;
        o[0] += m * bflo(w.x) * cv[0]; o[1] += m * bfhi(w.x) * cv[1]; o[2] += m * bflo(w.y) * cv[2]; o[3] += m * bfhi(w.y) * cv[3]; }
    return o;
}
template <int G> struct Solve4 {
    static __device__ __forceinline__ void run(float (&Tr)[32], unsigned lbo, int c31) {
        const LAS float* Lb = (const LAS float*)(uintptr_t)lbo;
        float a0 = 0.f, a1 = 0.f, a2 = 0.f, a3 = 0.f;
#pragma unroll
        for (int s = 4 * G + 4; s < 32; ++s) { const f32x4 L4 = *(const LAS f32x4*)(Lb + s * 36 + 4 * G); a0 += Tr[s] * L4[0]; a1 += Tr[s] * L4[1]; a2 += Tr[s] * L4[2]; a3 += Tr[s] * L4[3]; }
        const f32x4 R1 = *(const LAS f32x4*)(Lb + (4 * G + 1) * 36 + 4 * G), R2 = *(const LAS f32x4*)(Lb + (4 * G + 2) * 36 + 4 * G), R3 = *(const LAS f32x4*)(Lb + (4 * G + 3) * 36 + 4 * G);
        const float t3 = ((c31 == 4 * G + 3) ? 1.f : 0.f) + a3;
        const float t2 = ((c31 == 4 * G + 2) ? 1.f : 0.f) + a2 + t3 * R3[2];
        const float t1 = ((c31 == 4 * G + 1) ? 1.f : 0.f) + a1 + t2 * R2[1] + t3 * R3[1];
        float t0 = ((c31 == 4 * G) ? 1.f : 0.f) + a0 + t1 * R1[0] + t2 * R2[0] + t3 * R3[0];
        asm volatile("" : "+v"(lbo), "+v"(t0));
        Tr[4 * G + 3] = t3; Tr[4 * G + 2] = t2; Tr[4 * G + 1] = t1; Tr[4 * G] = t0;
        Solve4<G - 1>::run(Tr, lbo, c31);
    }
};
template <> struct Solve4<-1> { static __device__ __forceinline__ void run(float (&)[32], unsigned, int) {} };

__device__ __forceinline__ void tapply(const f32x16& ntop, const f32x16& nbot, const frag (&T11f)[2], const frag (&T22f)[2], const frag (&fL21)[2], f32x16& ztop, f32x16& zbot) {
    f32x16 z = {}; z = mf(T11f[0], pack8u(ntop, 0), z); z = mf(T11f[1], pack8u(ntop, 1), z); ztop = z;
    f32x16 y = nbot; y = mf(fL21[0], pack8u(z, 0), y); y = mf(fL21[1], pack8u(z, 1), y);
    f32x16 b = {}; b = mf(T22f[0], pack8u(y, 0), b); b = mf(T22f[1], pack8u(y, 1), b); zbot = b;
}
__device__ __forceinline__ void mask_lt(f32x16& a, int st, int tt, int c31, int hh, bool strict) {
    if (st == tt) {
#pragma unroll
        for (int i = 0; i < 16; ++i) { const int sg = crow(i, hh); const bool keep = strict ? (sg < c31) : (sg <= c31); a[i] = keep ? a[i] : 0.f; } }
}
__device__ __forceinline__ int trow_(int c31, int n, int d) { int c = c31; asm volatile("" : "+v"(c)); const int tau = 32 * n + c; return d ? 63 - tau : tau; }
__device__ __forceinline__ void passA3_inst(KARG, Frame& F, int hf, int l, int inst, LAS unsigned char* wl) {
    const int lane = F.lane, c31 = lane & 31, hh = lane >> 5;
    const int d = inst & 1, h = (inst >> 1) % 6, ci = (inst >> 1) / 6; const int rr0 = ci * 64; const int T = hf ? 16384 : 8192; const int sbase = hf ? 0 : (rr0 & ~8191);
    const bf16* PX = WSP(bf16, WS_PX); const bf16* cw = WSP(bf16, WS_SMALL) + SM_CWB + (size_t)l * 3 * 1152;
    LAS float* Ls = (LAS float*)wl; LAS unsigned char* P0 = wl + 9216; LAS unsigned char* P1 = P0 + 8192; LAS unsigned char* P2 = P1 + 8192; LAS unsigned char* P3 = wl; LAS float* dcs = (LAS float*)(wl + 9216 + 3 * 8192);
#define ROWC(n) (rr0 + trow_(c31, (n), d))
#define TLC(n) (rr0 - sbase + trow_(c31, (n), d))
    __builtin_amdgcn_sched_barrier(0);
    float kinv[2];
#pragma unroll
    for (int n = 0; n < 2; ++n) { float ss = 0.f;
#pragma unroll
        for (int q = 0; q < 2; ++q) { const f32x16 kt = conv_tl(PX, cw, 384 + h * 64 + 32 * q, ROWC(n), TLC(n), T, hh);
#pragma unroll
            for (int g = 0; g < 4; ++g) { const v2u kq = *(const GAS v2u*)(WSP(bf16, WS_SMALL) + SM_KKB + l * RW + h * 64 + 32 * q + 4 * hh + 8 * g); const f32x4 kw = {bflo(kq.x), bfhi(kq.x), bflo(kq.y), bfhi(kq.y)};
#pragma unroll
                for (int e = 0; e < 4; ++e) { const float x = kt[4 * g + e] * kw[e]; ss += x * x; } } }
        ss += shx(ss, 32, lane); kinv[n] = 1.0f / fmaxf(sqrtf(ss), 1e-12f); }
    float bon[2] = {0.f, 0.f};
#pragma unroll 1
    for (int q = 0; q < 2; ++q) {
        frag fh[4], fl[4];
        {
    frag aw[8];
#pragma unroll
    for (int n = 0; n < 2; ++n)
#pragma unroll
        for (int ks = 0; ks < 4; ++ks) { const v4u w = *(const GAS v4u*)(PX + (size_t)ROWC(n) * PXW + 1152 + 16 * ks + 8 * hh);
            frag o; o.x = cvtpk(tanhf_(bflo(w.x)), tanhf_(bfhi(w.x))); o.y = cvtpk(tanhf_(bflo(w.y)), tanhf_(bfhi(w.y))); o.z = cvtpk(tanhf_(bflo(w.z)), tanhf_(bfhi(w.z))); o.w = cvtpk(tanhf_(bflo(w.w)), tanhf_(bfhi(w.w))); aw[n * 4 + ks] = o; }
          frag bdu[4];
#pragma unroll
          for (int ks = 0; ks < 4; ++ks) bdu[ks] = *(const GAS v4u*)(WSP(bf16, WS_SMALL) + 98304 + (size_t)(l * 2 + d) * RW * 64 + (size_t)(h * 64 + 32 * q + c31) * 64 + 16 * ks + 8 * hh);
          const float w0c = KA.in[I_DW0][(size_t)(l * 2 + d) * RW + h * 64 + 32 * q + c31];
#pragma unroll
          for (int m = 0; m < 2; ++m) { f32x16 a;
#pragma unroll
              for (int i = 0; i < 16; ++i) a[i] = w0c;
#pragma unroll
              for (int ks = 0; ks < 4; ++ks) a = mf(aw[m * 4 + ks], bdu[ks], a);
              f32x16 lo;
#pragma unroll
              for (int i = 0; i < 16; ++i) { const float ld = -0.6065306597126334f * sigmoidf_(a[i]); const float hi = bf2f(f2bf(ld)); a[i] = hi; lo[i] = ld - hi; }
              fh[m * 2] = pack8u(a, 0); fh[m * 2 + 1] = pack8u(a, 1); fl[m * 2] = pack8u(lo, 0); fl[m * 2 + 1] = pack8u(lo, 1); } }
    __builtin_amdgcn_sched_barrier(0);
#pragma unroll
        for (int n = 0; n < 2; ++n) {
            f32x16 cumt, cumx;
            { int c31o = c31; asm volatile("" : "+v"(c31o));
              const frag ui0 = cfrag(0, hh, c31o, 1), ui1 = cfrag(1, hh, c31o, 1), us0 = cfrag(0, hh, c31o, 2), us1 = cfrag(1, hh, c31o, 2);
              f32x16 cb = {};
              if (n == 1) { const frag ones = {0x3F803F80u, 0x3F803F80u, 0x3F803F80u, 0x3F803F80u}; cb = mf(fh[0], ones, cb); cb = mf(fh[1], ones, cb); cb = mf(fl[0], ones, cb); cb = mf(fl[1], ones, cb); }
              f32x16 c = mf(fh[2 * n], ui0, cb); c = mf(fh[2 * n + 1], ui1, c); c = mf(fl[2 * n], ui0, c); c = mf(fl[2 * n + 1], ui1, c);
              f32x16 x = mf(fh[2 * n], us0, cb); x = mf(fh[2 * n + 1], us1, x); x = mf(fl[2 * n], us0, x); x = mf(fl[2 * n + 1], us1, x);
              cumt = c; cumx = x;
              if (n == 1 && c31 == 31) {
#pragma unroll
                  for (int i = 0; i < 16; ++i) { const float dc = __expf(c[i]); const int g = i >> 2, e = i & 3; dcs[32 * q + crow(i, hh)] = dc;
                      WSP(float, WS_DC)[(size_t)inst * 64 + 32 * (g & 1) + 16 * hh + 8 * q + 4 * (g >> 1) + e] = dc; } } }
            __builtin_amdgcn_sched_barrier(0);
            f32x16 ic;
#pragma unroll
            for (int g = 0; g < 4; ++g) { const f32x4 a0 = *(const GAS f32x4*)(KA.in[I_IA0] + (size_t)(l * 2 + d) * RW + h * 64 + 32 * q + 4 * hh + 8 * g); ic[4 * g] = a0[0]; ic[4 * g + 1] = a0[1]; ic[4 * g + 2] = a0[2]; ic[4 * g + 3] = a0[3]; }
#pragma unroll
            for (int ks = 0; ks < 4; ++ks) { const frag al = *(const GAS v4u*)(PX + (size_t)ROWC(n) * PXW + 1216 + 16 * ks + 8 * hh); const frag iu = *(const GAS v4u*)(WSP(bf16, WS_SMALL) + 2 * 98304 + (size_t)(l * 2 + d) * RW * 64 + (size_t)(h * 64 + 32 * q + c31) * 64 + 16 * ks + 8 * hh); ic = mf(iu, al, ic); }
            float bs = 0.f;
#pragma unroll
            for (int s = 0; s < 2; ++s) { unsigned pa[4], pb[4], pk[4], pr[4];
#pragma unroll
                for (int g2 = 0; g2 < 2; ++g2) { const int g = 2 * s + g2; const int cb = l * RW + h * 64 + 32 * q + 4 * hh + 8 * g;
                    const f32x4 kt = conv_tl4(PX, cw, 384 + h * 64 + 32 * q, ROWC(n), TLC(n), T, hh, g), rt = conv_tl4(PX, cw, h * 64 + 32 * q, ROWC(n), TLC(n), T, hh, g);
                    const v2u q1 = *(const GAS v2u*)(WSP(bf16, WS_SMALL) + SM_KKB + cb), q2 = *(const GAS v2u*)(WSP(bf16, WS_SMALL) + SM_KAB + cb), q3 = *(const GAS v2u*)(WSP(bf16, WS_SMALL) + SM_BRB + cb);
                    const f32x4 kw = {bflo(q1.x), bfhi(q1.x), bflo(q1.y), bfhi(q1.y)}, ka = {bflo(q2.x), bfhi(q2.x), bflo(q2.y), bfhi(q2.y)}, br = {bflo(q3.x), bfhi(q3.x), bflo(q3.y), bfhi(q3.y)};
#pragma unroll
                    for (int e2 = 0; e2 < 2; ++e2) { float va[2], vb[2], vk[2], vr[2];
#pragma unroll
                        for (int e1 = 0; e1 < 2; ++e1) { const int e = 2 * e2 + e1, i = 4 * g + e; const float icl = sigmoidf_(ic[i]); const float kk = kt[e] * kw[e] * kinv[n]; const float keff = kt[e] * (1.0f + (icl - 1.0f) * ka[e]);
                            bs += rt[e] * keff * br[e];
                            const float en = __expf(-cumt[i]);
                            va[e1] = -kk * __expf(cumx[i]); vb[e1] = kk * icl * en; vk[e1] = keff * en; vr[e1] = rt[e] * __expf(cumt[i]); }
                        pa[2 * g2 + e2] = cvtpk(va[0], va[1]); pb[2 * g2 + e2] = cvtpk(vb[0], vb[1]); pk[2 * g2 + e2] = cvtpk(vk[0], vk[1]); pr[2 * g2 + e2] = cvtpk(vr[0], vr[1]); } }
                const int ox = ((q * 2 + n) * 2 + s) * 1024 + lane * 16;
                *(LAS v4u*)(P3 + ox) = (frag){pa[0], pa[1], pa[2], pa[3]}; *(LAS v4u*)(P2 + ox) = (frag){pb[0], pb[1], pb[2], pb[3]};
                *(LAS v4u*)(P1 + ox) = (frag){pk[0], pk[1], pk[2], pk[3]}; *(LAS v4u*)(P0 + ox) = (frag){pr[0], pr[1], pr[2], pr[3]};
                __builtin_amdgcn_sched_barrier(0); }
            bon[n] += bs;
        }
    }
#pragma unroll
    for (int n = 0; n < 2; ++n) { const float b2 = bon[n] + shx(bon[n], 32, lane); if (hh == 0) WSP(float, WS_BON)[(size_t)inst * 64 + (d ? 63 - (32 * n + c31) : (32 * n + c31))] = b2; }
    frag fA[8], fB[8], fK[8], fR[8];
    asm volatile("s_waitcnt lgkmcnt(0)" ::: "memory");
    unpark8(P3, lane, fA); unpark8(P2, lane, fB);
    asm volatile("s_waitcnt lgkmcnt(0)" ::: "memory");
    __builtin_amdgcn_sched_barrier(0);
#define TLIX(q, n, s) (((q) * 2 + (n)) * 2 + (s))
    frag fL21[2];
    { f32x16 z = {};
#pragma unroll
      for (int b = 0; b < 2; ++b) { f32x16 a = z;
#pragma unroll
          for (int q = 0; q < 2; ++q)
#pragma unroll
              for (int s = 0; s < 2; ++s) a = mf(fA[TLIX(q, b, s)], fB[TLIX(q, b, s)], a);
#pragma unroll
          for (int i = 0; i < 16; ++i) Ls[(b * 32 + crow(i, hh)) * 36 + c31] = a[i]; }
      f32x16 a = z;
#pragma unroll
      for (int q = 0; q < 2; ++q)
#pragma unroll
          for (int s = 0; s < 2; ++s) a = mf(fB[TLIX(q, 0, s)], fA[TLIX(q, 1, s)], a);
      fL21[0] = pack8u(a, 0); fL21[1] = pack8u(a, 1); }
    __builtin_amdgcn_sched_barrier(0);
    frag T11f[2], T22f[2];
    { float Tr[32]; asm volatile("s_waitcnt lgkmcnt(0)" ::: "memory");
      Solve4<7>::run(Tr, (unsigned)(uintptr_t)(Ls + hh * 32 * 36), c31);
#pragma unroll
      for (int s = 0; s < 2; ++s) { unsigned x[4] = {cvtpk(Tr[16 * s], Tr[16 * s + 1]), cvtpk(Tr[16 * s + 2], Tr[16 * s + 3]), cvtpk(Tr[16 * s + 8], Tr[16 * s + 9]), cvtpk(Tr[16 * s + 10], Tr[16 * s + 11])};
          unsigned y[4] = {cvtpk(Tr[16 * s + 4], Tr[16 * s + 5]), cvtpk(Tr[16 * s + 6], Tr[16 * s + 7]), cvtpk(Tr[16 * s + 12], Tr[16 * s + 13]), cvtpk(Tr[16 * s + 14], Tr[16 * s + 15])};
#pragma unroll
          for (int p = 0; p < 4; ++p) { const auto r = __builtin_amdgcn_permlane32_swap(x[p], y[p], false, false); x[p] = r[0]; y[p] = r[1]; }
          T11f[s] = (frag){x[0], x[1], x[2], x[3]}; T22f[s] = (frag){y[0], y[1], y[2], y[3]}; } }
    int c31p = c31; asm volatile("" : "+v"(c31p));
    const frag id0 = cfrag(0, hh, c31p, 0), id1 = cfrag(1, hh, c31p, 0);
    __builtin_amdgcn_sched_barrier(0);
    frag Wf[8];
#pragma unroll
    for (int nt = 0; nt < 2; ++nt) { f32x16 z = {}; f32x16 at = mf(fA[TLIX(nt, 0, 0)], id0, z); at = mf(fA[TLIX(nt, 0, 1)], id1, at); f32x16 ab = mf(fA[TLIX(nt, 1, 0)], id0, z); ab = mf(fA[TLIX(nt, 1, 1)], id1, ab);
        f32x16 zt, zb; tapply(at, ab, T11f, T22f, fL21, zt, zb);
        Wf[(0 * 2 + 0) * 2 + nt] = pack8u(zt, 0); Wf[(0 * 2 + 1) * 2 + nt] = pack8u(zt, 1); Wf[(1 * 2 + 0) * 2 + nt] = pack8u(zb, 0); Wf[(1 * 2 + 1) * 2 + nt] = pack8u(zb, 1); }
    __builtin_amdgcn_sched_barrier(0);
    frag fLak[6];
    unpark8(P1, lane, fK);
#pragma unroll
    for (int tix = 0; tix < 3; ++tix) { const int st = tix >> 1, tt = (tix + 1) >> 1; f32x16 a = {};
#pragma unroll
        for (int q = 0; q < 2; ++q)
#pragma unroll
            for (int s = 0; s < 2; ++s) a = mf(fK[TLIX(q, st, s)], fA[TLIX(q, tt, s)], a);
        mask_lt(a, st, tt, c31, hh, true); fLak[tix * 2] = pack8u(a, 0); fLak[tix * 2 + 1] = pack8u(a, 1); }
    __builtin_amdgcn_sched_barrier(0);
    frag Vf[8], U0f[8];
#pragma unroll
    for (int nt = 0; nt < 2; ++nt) { f32x16 z = {}; f32x16 vcl[2];
#pragma unroll
        for (int m = 0; m < 2; ++m) { const f32x16 vt = conv_tl(PX, cw, 768 + h * 64 + 32 * nt, ROWC(m), TLC(m), T, hh); f32x16 a = mf(pack8u(vt, 0), id0, z); a = mf(pack8u(vt, 1), id1, a); vcl[m] = a;
            Vf[(m * 2 + 0) * 2 + nt] = pack8u(a, 0); Vf[(m * 2 + 1) * 2 + nt] = pack8u(a, 1); }
        f32x16 xt = mf(fLak[0], Vf[(0 * 2 + 0) * 2 + nt], z); xt = mf(fLak[1], Vf[(0 * 2 + 1) * 2 + nt], xt);
        f32x16 xb = mf(fLak[2], Vf[(0 * 2 + 0) * 2 + nt], z); xb = mf(fLak[3], Vf[(0 * 2 + 1) * 2 + nt], xb); xb = mf(fLak[4], Vf[(1 * 2 + 0) * 2 + nt], xb); xb = mf(fLak[5], Vf[(1 * 2 + 1) * 2 + nt], xb);
        f32x16 zt, zb; tapply(xt, xb, T11f, T22f, fL21, zt, zb);
        U0f[(0 * 2 + 0) * 2 + nt] = pack8u(zt, 0); U0f[(0 * 2 + 1) * 2 + nt] = pack8u(zt, 1); U0f[(1 * 2 + 0) * 2 + nt] = pack8u(zb, 0); U0f[(1 * 2 + 1) * 2 + nt] = pack8u(zb, 1); }
    __builtin_amdgcn_sched_barrier(0);
    frag BCf[8], KCf[8];
    unpark8(P2, lane, fB); unpark8(P1, lane, fK);
#pragma unroll
    for (int kt = 0; kt < 2; ++kt)
#pragma unroll
        for (int m = 0; m < 2; ++m) { f32x16 z = {}; f32x16 a = mf(fB[TLIX(kt, m, 0)], id0, z); a = mf(fB[TLIX(kt, m, 1)], id1, a); BCf[(m * 2 + 0) * 2 + kt] = pack8u(a, 0); BCf[(m * 2 + 1) * 2 + kt] = pack8u(a, 1);
            f32x16 b = mf(fK[TLIX(kt, m, 0)], id0, z); b = mf(fK[TLIX(kt, m, 1)], id1, b); KCf[(m * 2 + 0) * 2 + kt] = pack8u(b, 0); KCf[(m * 2 + 1) * 2 + kt] = pack8u(b, 1); }
    asm volatile("s_waitcnt lgkmcnt(0)" ::: "memory");
#pragma unroll
    for (int kt = 0; kt < 2; ++kt)
#pragma unroll
        for (int vt = 0; vt < 2; ++vt) { f32x16 a = {};
#pragma unroll
            for (int ms = 0; ms < 4; ++ms) { a = mf(BCf[ms * 2 + kt], U0f[ms * 2 + vt], a); a = mf(KCf[ms * 2 + kt], Vf[ms * 2 + vt], a); }
#pragma unroll
            for (int g = 0; g < 4; ++g) { const f32x4 dc = *(const LAS f32x4*)(dcs + 32 * kt + 8 * g + 4 * hh); v2u o; o.x = cvtpk(a[4 * g] * dc[0], a[4 * g + 1] * dc[1]); o.y = cvtpk(a[4 * g + 2] * dc[2], a[4 * g + 3] * dc[3]);
                *(GAS v2u*)(WSP(bf16, WS_H0T) + (size_t)inst * 4096 + (32 * vt + c31) * 64 + 32 * (g & 1) + 16 * hh + 8 * kt + 4 * (g >> 1)) = o; } }
    __builtin_amdgcn_sched_barrier(0);
#pragma unroll
    for (int ct = 0; ct < 2; ++ct)
#pragma unroll
        for (int kt = 0; kt < 2; ++kt) { f32x16 a = {};
#pragma unroll
            for (int ms = 0; ms < 4; ++ms) a = mf(Wf[ms * 2 + ct], BCf[ms * 2 + kt], a);
            const float dc = dcs[32 * kt + c31];
#pragma unroll
            for (int g = 0; g < 4; ++g) { v2u o; o.x = cvtpk(a[4 * g] * dc, a[4 * g + 1] * dc); o.y = cvtpk(a[4 * g + 2] * dc, a[4 * g + 3] * dc);
                *(GAS v2u*)(WSP(bf16, WS_GP) + (size_t)inst * 4096 + (32 * kt + c31) * 64 + 32 * ct + 16 * (g & 1) + 8 * hh + 4 * (g >> 1)) = o; } }
    __builtin_amdgcn_sched_barrier(0);
    unpark8(P0, lane, fR); unpark8(P2, lane, fB);
    frag fLrb[6];
#pragma unroll
    for (int tix = 0; tix < 3; ++tix) { const int st = tix >> 1, tt = (tix + 1) >> 1; f32x16 a = {};
#pragma unroll
        for (int q = 0; q < 2; ++q)
#pragma unroll
            for (int s = 0; s < 2; ++s) a = mf(fB[TLIX(q, st, s)], fR[TLIX(q, tt, s)], a);
        mask_lt(a, st, tt, c31, hh, false); fLrb[tix * 2] = pack8u(a, 0); fLrb[tix * 2 + 1] = pack8u(a, 1); }
#pragma unroll
    for (int ct = 0; ct < 2; ++ct)
#pragma unroll
        for (int tt = 0; tt < 2; ++tt) { f32x16 a = {}; a = mf(id0, fR[TLIX(ct, tt, 0)], a); a = mf(id1, fR[TLIX(ct, tt, 1)], a);
            a = mf(Wf[(0 * 2 + 0) * 2 + ct], fLrb[(tt == 0 ? 0 : 1) * 2], a); a = mf(Wf[(0 * 2 + 1) * 2 + ct], fLrb[(tt == 0 ? 0 : 1) * 2 + 1], a);
            if (tt == 1) { a = mf(Wf[(1 * 2 + 0) * 2 + ct], fLrb[4], a); a = mf(Wf[(1 * 2 + 1) * 2 + ct], fLrb[5], a); }
            const int tau = 32 * tt + c31, tr = d ? 63 - tau : tau;
#pragma unroll
            for (int g = 0; g < 4; ++g) { v2u o; o.x = cvtpk(a[4 * g], a[4 * g + 1]); o.y = cvtpk(a[4 * g + 2], a[4 * g + 3]);
                *(GAS v2u*)(WSP(bf16, WS_RY) + (size_t)inst * 4096 + tr * 64 + 32 * ct + 8 * g + 4 * hh) = o; } }
    __builtin_amdgcn_sched_barrier(0);
    frag fLrk[6];
    unpark8(P1, lane, fK);
#pragma unroll
    for (int tix = 0; tix < 3; ++tix) { const int st = tix >> 1, tt = (tix + 1) >> 1; f32x16 a = {};
#pragma unroll
        for (int q = 0; q < 2; ++q)
#pragma unroll
            for (int s = 0; s < 2; ++s) a = mf(fK[TLIX(q, st, s)], fR[TLIX(q, tt, s)], a);
        mask_lt(a, st, tt, c31, hh, false); fLrk[tix * 2] = pack8u(a, 0); fLrk[tix * 2 + 1] = pack8u(a, 1); }
#pragma unroll
    for (int jt = 0; jt < 2; ++jt)
#pragma unroll
        for (int tt = 0; tt < 2; ++tt) { f32x16 a = {}; const int t0x = (tt == 0 ? 0 : 1) * 2;
            a = mf(U0f[(0 * 2 + 0) * 2 + jt], fLrb[t0x], a); a = mf(U0f[(0 * 2 + 1) * 2 + jt], fLrb[t0x + 1], a); a = mf(Vf[(0 * 2 + 0) * 2 + jt], fLrk[t0x], a); a = mf(Vf[(0 * 2 + 1) * 2 + jt], fLrk[t0x + 1], a);
            if (tt == 1) { a = mf(U0f[(1 * 2 + 0) * 2 + jt], fLrb[4], a); a = mf(U0f[(1 * 2 + 1) * 2 + jt], fLrb[5], a); a = mf(Vf[(1 * 2 + 0) * 2 + jt], fLrk[4], a); a = mf(Vf[(1 * 2 + 1) * 2 + jt], fLrk[5], a); }
            const int tau = 32 * tt + c31, tr = d ? 63 - tau : tau;
#pragma unroll
            for (int g = 0; g < 4; ++g) { v2u o; o.x = cvtpk(a[4 * g], a[4 * g + 1]); o.y = cvtpk(a[4 * g + 2], a[4 * g + 3]);
                *(GAS v2u*)(WSP(bf16, WS_Y0) + (size_t)inst * 4096 + tr * 64 + 32 * jt + 8 * g + 4 * hh) = o; } }
#undef TLIX
#undef ROWC
#undef TLC
    asm volatile("s_waitcnt lgkmcnt(0)" ::: "memory");
}
__device__ __forceinline__ void phase_passA3(KARG, Frame& F, int hf, int l) {
    if (F.wave >= 4) return;
    LAS unsigned char* wl = F.lds + RING_OFF + F.wave * PA3_WAVE_LDS;
    for (int inst = F.vcu * 4 + F.wave; inst < (MH / 64) * 12; inst += F.G * 4) {
        int tv = F.tid; asm volatile("" : "+v"(tv)); F.lane = tv & 63;
        passA3_inst(KA, F, hf, l, inst, wl);
    }
}
constexpr int PB_SLOT = 14 * 1024;
__device__ __forceinline__ void phase_passB(Frame& F, int hf) {
    const int nchain = hf ? 12 : 24, nck = hf ? 256 : 128;
    const int uu = F.vcu;
    if (uu >= nchain * 4) return;
    const int chain = uu >> 2, cgp = uu & 3; const int d = chain & 1, h = (chain >> 1) % 6, s = (chain >> 1) / 6;
    const int lane = F.lane, c16 = lane & 15, q = lane >> 4, v = 16 * cgp + c16;
    const bf16* GP = WSP(bf16, WS_GP); const bf16* H0T = WSP(bf16, WS_H0T); const float* DC = WSP(float, WS_DC); bf16* HC = WSP(bf16, WS_HC);
    LAS unsigned char* ring = F.lds + RING_OFF;
    volatile LAS int* full = (volatile LAS int*)(F.lds + RING_OFF + 7 * PB_SLOT);
    volatile LAS int* cons = full + 8;
    if (F.tid < 16) full[F.tid] = 0;
    __syncthreads();
    if (F.wave > 0) {
        const int slot = F.wave - 1; LAS unsigned char* sp = ring + slot * PB_SLOT + lane * 16; int k = 0;
        for (int st = slot; st < nck; st += 7, ++k) {
            const int cl_ = d ? nck - 1 - st : st; const size_t in_ = ((size_t)(s * nck + cl_) * 6 + h) * 2 + d;
            v4u x[14];
#pragma unroll
            for (int mo = 0; mo < 4; ++mo) { const bf16* gr = GP + in_ * 4096 + (16 * mo + c16) * 64 + 8 * q; x[2 * mo] = *(const GAS v4u*)(gr); x[2 * mo + 1] = *(const GAS v4u*)(gr + 32);
                x[10 + mo] = *(const GAS v4u*)(DC + in_ * 64 + 16 * q + 4 * mo); }
            x[8] = *(const GAS v4u*)(H0T + in_ * 4096 + v * 64 + 16 * q); x[9] = *(const GAS v4u*)(H0T + in_ * 4096 + v * 64 + 16 * q + 8);
            while (cons[slot] < k) __builtin_amdgcn_s_sleep(1);
            asm volatile("" ::: "memory");
#pragma unroll
            for (int i = 0; i < 14; ++i) *(LAS v4u*)(sp + i * 1024) = x[i];
            asm volatile("s_waitcnt lgkmcnt(0)" ::: "memory");
            if (lane == 0) full[slot] = k + 1;
        }
        return;
    }
    f32x4 hacc[4];
#pragma unroll
    for (int m = 0; m < 4; ++m) hacc[m] = (f32x4){0.f, 0.f, 0.f, 0.f};
    for (int step = 0; step < nck; ++step) {
        const int slot = step % 7, k = step / 7; const int cl = d ? nck - 1 - step : step; const size_t inst = ((size_t)(s * nck + cl) * 6 + h) * 2 + d;
        while (full[slot] < k + 1) __builtin_amdgcn_s_sleep(1);
        asm volatile("" ::: "memory");
        const LAS unsigned char* sp = ring + slot * PB_SLOT + lane * 16; v4u x[14];
#pragma unroll
        for (int i = 0; i < 14; ++i) x[i] = *(const LAS v4u*)(sp + i * 1024);
        asm volatile("s_waitcnt lgkmcnt(0)" ::: "memory");
        if (lane == 0) cons[slot] = k + 1;
        v2u hb[4];
#pragma unroll
        for (int m = 0; m < 4; ++m) { hb[m].x = cvtpk(hacc[m][0], hacc[m][1]); hb[m].y = cvtpk(hacc[m][2], hacc[m][3]); *(GAS v2u*)(HC + inst * 4096 + v * 64 + 16 * m + 4 * q) = hb[m]; }
        bf16x8 bfr[2];
#pragma unroll
        for (int ks = 0; ks < 2; ++ks) { v4u t4; t4.x = hb[2 * ks].x; t4.y = hb[2 * ks].y; t4.z = hb[2 * ks + 1].x; t4.w = hb[2 * ks + 1].y; bfr[ks] = __builtin_bit_cast(bf16x8, t4); }
        const unsigned hw[8] = {x[8].x, x[8].y, x[8].z, x[8].w, x[9].x, x[9].y, x[9].z, x[9].w};
#pragma unroll
        for (int mo = 0; mo < 4; ++mo) { const f32x4 dc = __builtin_bit_cast(f32x4, x[10 + mo]); f32x4 cin;
            cin[0] = dc[0] * hacc[mo][0] + bflo(hw[2 * mo]); cin[1] = dc[1] * hacc[mo][1] + bfhi(hw[2 * mo]); cin[2] = dc[2] * hacc[mo][2] + bflo(hw[2 * mo + 1]); cin[3] = dc[3] * hacc[mo][3] + bfhi(hw[2 * mo + 1]);
            cin = mfma16(__builtin_bit_cast(bf16x8, x[2 * mo]), bfr[0], cin); cin = mfma16(__builtin_bit_cast(bf16x8, x[2 * mo + 1]), bfr[1], cin); hacc[mo] = cin; }
    }
}
__device__ __forceinline__ void passC_unit(KARG, Frame& F, int hf, int l, int unit) {
    const int lane = F.lane, c31 = lane & 31, hh = lane >> 5; const int ci = unit / 6, h = unit % 6; const int rr0 = ci * 64;
    const int T = hf ? 16384 : 8192; const int sbase = hf ? 0 : (rr0 & ~8191);
    const bf16* PX = WSP(bf16, WS_PX); const bf16* RY = WSP(bf16, WS_RY); const bf16* Y0 = WSP(bf16, WS_Y0); const bf16* HC = WSP(bf16, WS_HC);
    f32x16 acc[2][2];
#pragma unroll
    for (int mt = 0; mt < 2; ++mt)
#pragma unroll
        for (int nt = 0; nt < 2; ++nt) { f32x16 a;
#pragma unroll
            for (int g = 0; g < 4; ++g) { float s4[4] = {0.f, 0.f, 0.f, 0.f};
#pragma unroll
                for (int d = 0; d < 2; ++d) { const size_t inst = ((size_t)ci * 6 + h) * 2 + d; const v2u w = *(const GAS v2u*)(Y0 + inst * 4096 + (32 * nt + c31) * 64 + 32 * mt + 8 * g + 4 * hh);
                    s4[0] += bflo(w.x); s4[1] += bfhi(w.x); s4[2] += bflo(w.y); s4[3] += bfhi(w.y); }
                a[4 * g] = s4[0]; a[4 * g + 1] = s4[1]; a[4 * g + 2] = s4[2]; a[4 * g + 3] = s4[3]; }
            acc[mt][nt] = a; }
#pragma unroll
    for (int d = 0; d < 2; ++d) { const size_t inst = ((size_t)ci * 6 + h) * 2 + d;
#pragma unroll
        for (int ks = 0; ks < 4; ++ks) { bf16x8 af[2], bf_[2];
#pragma unroll
            for (int x = 0; x < 2; ++x) { af[x] = *(const GAS bf16x8*)(HC + inst * 4096 + (32 * x + c31) * 64 + 16 * ks + 8 * hh); bf_[x] = *(const GAS bf16x8*)(RY + inst * 4096 + (32 * x + c31) * 64 + 16 * ks + 8 * hh); }
#pragma unroll
            for (int mt = 0; mt < 2; ++mt)
#pragma unroll
                for (int nt = 0; nt < 2; ++nt) acc[mt][nt] = mfma32(af[mt], bf_[nt], acc[mt][nt]); } }
    f32x16 gacc[2][2] = {};
    { const bf16* GUT = WSP(bf16, WS_SMALL) + (size_t)l * RW * 128;
#pragma unroll
      for (int ks = 0; ks < 8; ++ks) { bf16x8 af[2], bf_[2];
#pragma unroll
          for (int x = 0; x < 2; ++x) { af[x] = *(const GAS bf16x8*)(GUT + (size_t)(h * 64 + 32 * x + c31) * 128 + 16 * ks + 8 * hh);
              const v4u w = *(const GAS v4u*)(PX + (size_t)(rr0 + 32 * x + c31) * PXW + 1280 + 16 * ks + 8 * hh); v4u o;
              o.x = cvtpk(sigmoidf_(bflo(w.x)), sigmoidf_(bfhi(w.x))); o.y = cvtpk(sigmoidf_(bflo(w.y)), sigmoidf_(bfhi(w.y))); o.z = cvtpk(sigmoidf_(bflo(w.z)), sigmoidf_(bfhi(w.z))); o.w = cvtpk(sigmoidf_(bflo(w.w)), sigmoidf_(bfhi(w.w)));
              bf_[x] = __builtin_bit_cast(bf16x8, o); }
#pragma unroll
          for (int mt = 0; mt < 2; ++mt)
#pragma unroll
              for (int nt = 0; nt < 2; ++nt) gacc[mt][nt] = mfma32(af[mt], bf_[nt], gacc[mt][nt]); } }
    const float* gng = KA.in[I_GNG] + l * RW + h * 64; const float* gnb = KA.in[I_GNB] + l * RW + h * 64; const float* cw = KA.in[I_CONV] + (size_t)l * 3 * 1152 + 768 + h * 64;
    bf16* MIX = WSP(bf16, WS_MIX);
#pragma unroll
    for (int nt = 0; nt < 2; ++nt) { const int t = 32 * nt + c31; const int tl = rr0 - sbase + t;
        float s1 = 0.f;
#pragma unroll
        for (int mt = 0; mt < 2; ++mt)
#pragma unroll
            for (int i = 0; i < 16; ++i) s1 += acc[mt][nt][i];
        s1 += shx(s1, 32, lane); const float mu = s1 * (1.0f / 64.0f); float s2 = 0.f;
#pragma unroll
        for (int mt = 0; mt < 2; ++mt)
#pragma unroll
            for (int i = 0; i < 16; ++i) { const float dlt = acc[mt][nt][i] - mu; s2 += dlt * dlt; }
        s2 += shx(s2, 32, lane); const float rstd = 1.0f / sqrtf(s2 * (1.0f / 64.0f) + GN_EPS);
        const float bon = USE_PA3 ? (WSP(float, WS_BON)[((size_t)unit * 2) * 64 + t] + WSP(float, WS_BON)[((size_t)unit * 2 + 1) * 64 + t]) : WSP(float, WS_BON)[(size_t)unit * 64 + t];
#pragma unroll
        for (int mt = 0; mt < 2; ++mt)
#pragma unroll
            for (int g = 0; g < 4; ++g) { const int j0 = 32 * mt + 8 * g + 4 * hh; float vv[4] = {0.f, 0.f, 0.f, 0.f};
#pragma unroll
                for (int tap = 0; tap < 3; ++tap) { const int tq = tl + tap - 1; if (tq >= 0 && tq < T) { const v2u w = *(const GAS v2u*)(PX + (size_t)(sbase + tq) * PXW + 768 + h * 64 + j0); const f32x4 cwv = *(const GAS f32x4*)(cw + tap * 1152 + j0);
                    vv[0] += bflo(w.x) * cwv[0]; vv[1] += bfhi(w.x) * cwv[1]; vv[2] += bflo(w.y) * cwv[2]; vv[3] += bfhi(w.y) * cwv[3]; } }
                const f32x4 gg = *(const GAS f32x4*)(gng + j0), gb = *(const GAS f32x4*)(gnb + j0); float o4[4];
#pragma unroll
                for (int e = 0; e < 4; ++e) { const float y = (acc[mt][nt][4 * g + e] - mu) * rstd * gg[e] + gb[e] + bon * vv[e]; o4[e] = y * gacc[mt][nt][4 * g + e]; }
                v2u o; o.x = pk2(o4[0], o4[1]); o.y = pk2(o4[2], o4[3]); *(GAS v2u*)(MIX + (size_t)(rr0 + t) * D + 256 + h * 64 + j0) = o; } }
}
__device__ __forceinline__ void phase_passC(KARG, Frame& F, int hf, int l) {
    const int gw = F.vcu * NWAVES + F.wave, NGW = F.G * NWAVES;
    for (int u = gw; u < (MH / 64) * 6; u += NGW) passC_unit(KA, F, hf, l, u);
}
constexpr int NPHASE = 47;
__global__ void __launch_bounds__(NWAVES * 64, 2) mega_fwd(Args args) {
    const Args& KA = args;
    extern __shared__ __attribute__((aligned(16))) unsigned char lds[];
    Frame F;
    F.lds = (LAS unsigned char*)lds; F.MISC = (volatile LAS unsigned*)(F.lds + MISC_OFF);
    F.tid = threadIdx.x; F.lane = F.tid & 63; F.wave = __builtin_amdgcn_readfirstlane(F.tid >> 6);
    F.G = gridDim.x; { const int bx = blockIdx.x; F.vcu = (F.G % 8 == 0) ? (bx % 8) * (F.G / 8) + bx / 8 : bx; }
    F.ws = args.ws; F.ctl = (gu32*)(args.ws + WS_CTL); F.out = args.out;
    for (int u = F.tid; u < (LDS_BYTES - LDSCTL_OFF) / 4; u += NWAVES * 64) ((LAS unsigned*)(F.lds + LDSCTL_OFF))[u] = 0u;
    __syncthreads();
    XcdBarrier bar; bar.bar = (unsigned*)(F.ctl + CW_BAR) + args.li * XCD_BAR_WORDS; bar.x = 0; bar.st = nullptr;
    const bool multi = (args.ph_hi - args.ph_lo) > 1;
    if (multi) bar = xcd_barrier_post((unsigned*)(F.ctl + CW_BAR) + args.li * XCD_BAR_WORDS, F.MISC + 8);
    for (int p = args.ph_lo; p < args.ph_hi; ++p) {
        { int tv = threadIdx.x; asm volatile("" : "+v"(tv)); F.tid = tv; F.lane = tv & 63; F.wave = __builtin_amdgcn_readfirstlane(tv >> 6); }
        if (p == 0) { if ((PHM >> 11) & 1) phase_weights(args, F); }
        else {
            const int qq = p - 1, hf = qq / 23, r = qq % 23;
            if (r == 0) { if ((PHM >> 12) & 1) phase_xn_init(args, F, hf); }
            else {
                const int l = (r - 1) / 11, k = (r - 1) % 11;
                unsigned char* wl = F.ws + WS_W + (size_t)l * W_LAYER;
                const int nrep = (k == REPK) ? 2 : 1;
                for (int rep = 0; rep < nrep; ++rep) {
                if (rep) xcd_barrier(bar);
                { int tv = threadIdx.x; asm volatile("" : "+v"(tv)); F.tid = tv; F.lane = tv & 63; F.wave = __builtin_amdgcn_readfirstlane(tv >> 6); }
                if (k == 0 || k == 6 || k == 8 || k == 9) {
                    const bf16* Aop; const bf16* Bop; int Nn, Kk; pg8::EpiGen E;
                    if (k == 0) { Aop = WSP(bf16, WS_XN); Bop = (const bf16*)(wl + W_IN); Nn = NIN; Kk = D; E = pg8::EpiGen{WSP(bf16, WS_PY), WSP(bf16, WS_PX), 1408, PXW, PXW, 0}; }
                    else if (k == 6) { Aop = WSP(bf16, WS_MIX); Bop = (const bf16*)(wl + W_OUT); Nn = D; Kk = D; E = pg8::EpiGen{WSP(bf16, WS_F1), WSP(bf16, WS_F1), 1 << 30, D, D, 0}; }
                    else if (k == 8) { Aop = WSP(bf16, WS_XN); Bop = (const bf16*)(wl + W_FFI); Nn = FF; Kk = D; E = pg8::EpiGen{WSP(bf16, WS_H), WSP(bf16, WS_H), 1 << 30, FF, FF, 2}; }
                    else { Aop = WSP(bf16, WS_H); Bop = (const bf16*)(wl + W_FFO); Nn = D; Kk = FF; E = pg8::EpiGen{WSP(bf16, WS_XN), WSP(bf16, WS_XN), 1 << 30, D, D, 0}; }
                    pg8::Gemm g{Aop, Bop, MH, Nn, Kk}; pg8::StaticOrder S; S.init(MH, Nn, F.G, (int)blockIdx.x);
                    pg8::gemm_phase<pg8::EpiGen, pg8::StaticOrder, true, true>(F.lds + RING_OFF, g, S, E, F.tid);
                } else
                switch (k) {
                case 1: if ((PHM >> 1) & 1) phase_pool_attn(args, F, hf, l); break;
                case 2: if ((PHM >> 2) & 1) phase_attn_merge(F); break;
                case 3: if ((PHM >> 3) & 1) { if (USE_PA3) phase_passA3(args, F, hf, l); else phase_passA(args, F, hf, l); } break;
                case 4: if ((PHM >> 4) & 1) phase_passB(F, hf); break;
                case 5: if ((PHM >> 5) & 1) phase_passC(args, F, hf, l); break;
                case 7: if ((PHM >> 7) & 1) { const float* base = (l == 0) ? KA.in[hf ? I_XS : I_XP] : (F.out + (size_t)hf * MH * D);
                          phase_rowpass(args, F, hf, WSP(bf16, WS_F1), base, KA.in[I_NMPOST] + l * D, KA.in[I_NFPRE] + l * D); } break;
                default: if ((PHM >> 10) & 1) { phase_rowpass(args, F, hf, WSP(bf16, WS_XN), F.out + (size_t)hf * MH * D, KA.in[I_NFPOST] + l * D, (l == 0) ? (KA.in[I_NMPRE] + D) : nullptr); } break;
                }
                }
            }
        }
        if (p + 1 < args.ph_hi) xcd_barrier(bar);
    }
}

extern "C" void kernel_launch(void* const* d_in, const int* in_sizes, int n_in, void* d_out, int out_size, void* d_ws, size_t ws_size, hipStream_t stream) {
    static int grid = 0;
    if (grid == 0) {
        if (n_in != 24 || out_size != 2 * MH * D || ws_size < WS_END) { fprintf(stderr, "kernel_launch: unexpected problem shape (n_in %d out %d ws %zu)\n", n_in, out_size, ws_size); grid = -1; return; }
        int dev = 0, cus = 0;
        if (hipGetDevice(&dev) != hipSuccess || hipDeviceGetAttribute(&cus, hipDeviceAttributeMultiprocessorCount, dev) != hipSuccess) { grid = -1; return; }
        if (hipFuncSetAttribute((const void*)mega_fwd, hipFuncAttributeMaxDynamicSharedMemorySize, LDS_BYTES) != hipSuccess) { fprintf(stderr, "kernel_launch: hipFuncSetAttribute failed\n"); grid = -1; return; }
        int per_cu = 0; (void)hipOccupancyMaxActiveBlocksPerMultiprocessor(&per_cu, (const void*)mega_fwd, NWAVES * 64, LDS_BYTES); (void)hipGetLastError();
        grid = cus;
    }
    if (grid < 0) return;
    (void)hipMemsetAsync((char*)d_ws + WS_CTL, 0, CTL_ZERO_BYTES, stream);
    Args a{};
    for (int i = 0; i < 24; ++i) a.in[i] = (const float*)d_in[i];
    a.out = (float*)d_out; a.ws = (unsigned char*)d_ws;
#if MK_N_LAUNCHES == 1
    a.ph_lo = 0; a.ph_hi = NPHASE; a.li = 0;
    hipLaunchKernelGGL(mega_fwd, dim3(grid), dim3(NWAVES * 64), LDS_BYTES, stream, a);
#else
    for (int p = 0; p < NPHASE; ++p) { a.ph_lo = p; a.ph_hi = p + 1; a.li = 0; hipLaunchKernelGGL(mega_fwd, dim3(grid), dim3(NWAVES * 64), LDS_BYTES, stream, a); }
#endif
}
```
